# Optimizing an MI355X kernel written in HIP

```python
import jax, jax.numpy as jnp
from jax import lax
import numpy as np

D_MODEL = 2048
BATCH = 2
SEQ = 4096
DEPTH = 4
DEC_BATCH = 8
DEC_SEQ = 8
PAST_LEN = 16384
PAGE_SIZE = 128

N_EVEN = (DEPTH + 1) // 2
N_ODD = DEPTH // 2
EPS = 1e-6
NEG_BIG = -1e30

H_A = 8
DH_A = 128
W_A = H_A * DH_A
DILATED_GROUPS = ((128, 1), (512, 4), (2048, 16))
WINDOW_MAX = 2048
ATTN_BLOCK = 128

W_B = 1024
H_B = 8
BH_B = W_B // H_B
CONV_B = 4
LRU_C = 8.0

H_C = 8
DK_C = 128
DV_C = 128
KEY_C = H_C * DK_C
W_C = H_C * DV_C

H_D = 4
DK_D = 128
DV_D = 256
KEY_D = H_D * DK_D
W_D = H_D * DV_D
GATE_RANK = 16
GLA_TAU = 16.0
CHUNK = 64

D_FF = 5504
CONV_F = 3

IN_AB = 3 * W_A + 2 * W_B
MIX_AB = W_A + W_B
IN_CD = 2 * KEY_C + 2 * W_C + 2 * KEY_D + 2 * W_D + GATE_RANK
MIX_CD = W_C + W_D

kernel_name = 'hybrid_dilated_rglru_hgrn2_gla_step'

F32 = jnp.float32


def rmsnorm(x, g):
    xf = x.astype(F32)
    y = xf * lax.rsqrt(jnp.mean(xf * xf, axis=-1, keepdims=True) + EPS)
    return (y * g.astype(F32)).astype(x.dtype)


def split_cols(z, sizes):
    idx = np.cumsum(sizes)[:-1].tolist()
    return jnp.split(z, idx, axis=-1)


def causal_dwconv(x, buf, w, b):
    width = w.shape[0]
    T = x.shape[1]
    xp = jnp.concatenate([buf.astype(x.dtype), x], axis=1)
    y = b
    for j in range(width):
        y = y + w[j] * xp[:, j:j + T]
    return y, xp[:, xp.shape[1] - (width - 1):]


def dilated_attn_prompt(q, k, v, window, dilation):
    Bb, S, H, Dh = q.shape
    n = window // dilation
    QB = ATTN_BLOCK
    span = dilation * QB
    Sp = -(-S // span) * span
    NB = Sp // span

    def split(t):
        t = jnp.pad(t, ((0, 0), (0, Sp - S), (0, 0), (0, 0)))
        t = t.reshape(Bb, NB, QB, dilation, H, Dh)
        return jnp.transpose(t, (0, 3, 1, 2, 4, 5))

    def with_prev(t):
        prev = jnp.pad(t, ((0, 0), (0, 0), (1, 0), (0, 0), (0, 0), (0, 0)))[:, :, :-1]
        return jnp.concatenate([prev, t], axis=3)

    qb = split(q)
    kb = with_prev(split(k))
    vb = with_prev(split(v))
    s = jnp.einsum('brnihd,brnjhd->brnhij', qb, kb).astype(F32) * (Dh ** -0.5)
    nb = jnp.arange(NB)[:, None, None]
    ii = jnp.arange(QB)[None, :, None]
    jj = jnp.arange(2 * QB)[None, None, :]
    rel = ii - jj + QB
    valid = (rel >= 0) & (rel <= n) & (nb * QB + jj - QB >= 0)
    s = jnp.where(valid[None, None, :, None], s, NEG_BIG)
    m = jnp.max(s, axis=-1, keepdims=True)
    pr = jnp.where(valid[None, None, :, None], jnp.exp(s - m), 0.0)
    den = jnp.sum(pr, axis=-1)
    o = jnp.einsum('brnhij,brnjhd->brnihd', pr, vb.astype(F32)) / jnp.swapaxes(den, 3, 4)[..., None]
    lse = jnp.swapaxes(m[..., 0] + jnp.log(den), 3, 4)
    o = jnp.transpose(o, (0, 2, 3, 1, 4, 5)).reshape(Bb, Sp, H, Dh)[:, :S]
    lse = jnp.transpose(lse, (0, 2, 3, 1, 4)).reshape(Bb, Sp, H)[:, :S]
    return o, lse


def dilated_attn_step(q, kc, vc, window, dilation, L):
    T = q.shape[1]
    Dh = q.shape[-1]
    n = window // dilation
    idx = L + jnp.arange(T)[:, None] - dilation * jnp.arange(n + 1)[None, :]
    valid = idx >= 0
    idx = jnp.maximum(idx, 0)
    kg = jnp.take(kc, idx, axis=1)
    vg = jnp.take(vc, idx, axis=1)
    s = jnp.einsum('bthd,btjhd->bthj', q, kg).astype(F32) * (Dh ** -0.5)
    s = jnp.where(valid[None, :, None, :], s, NEG_BIG)
    m = jnp.max(s, axis=-1, keepdims=True)
    pr = jnp.where(valid[None, :, None, :], jnp.exp(s - m), 0.0)
    den = jnp.sum(pr, axis=-1)
    o = jnp.einsum('bthj,btjhd->bthd', pr, vg.astype(F32)) / den[..., None]
    return o, m[..., 0] + jnp.log(den)


def combine_dilations(res):
    outs = jnp.stack([o for o, _ in res])
    w = jax.nn.softmax(jnp.stack([l for _, l in res]), axis=0)
    return jnp.sum(w[..., None] * outs, axis=0)


def _lin_combine(left, right):
    a_l, u_l = left
    a_r, u_r = right
    return a_l * a_r, a_r * u_l + u_r


def rg_lru(x, h0, wa, ba, wx, bx, lam):
    Bb, T, _ = x.shape
    xf = x.astype(F32)
    xh = xf.reshape(Bb, T, H_B, BH_B)
    r = jax.nn.sigmoid(jnp.einsum('bthi,hij->bthj', xh, wa.astype(F32)).reshape(Bb, T, W_B) + ba)
    ig = jax.nn.sigmoid(jnp.einsum('bthi,hij->bthj', xh, wx.astype(F32)).reshape(Bb, T, W_B) + bx)
    log_a = -LRU_C * r * jax.nn.softplus(-lam.astype(F32))
    a = jnp.exp(log_a)
    u = jnp.sqrt(-jnp.expm1(2.0 * log_a)) * (ig * xf)
    u = u.at[:, 0].add(a[:, 0] * h0.astype(F32))
    _, h = lax.associative_scan(_lin_combine, (a, u), axis=1)
    return h, h[:, -1]


def chunk_gla(q, k, v, lg, s0):
    Bb, T, H, K = q.shape
    V = v.shape[-1]
    c = min(CHUNK, T)
    Tp = -(-T // c) * c

    def to_chunks(t):
        t = jnp.pad(t.astype(F32), ((0, 0), (0, Tp - T), (0, 0), (0, 0)))
        return jnp.moveaxis(t.reshape(Bb, Tp // c, c, H, t.shape[-1]), 1, 0)

    tri = jnp.tril(jnp.ones((c, c), bool))[None, :, :, None, None]

    def step(S, inp):
        qc, kc, vc, gc = inp
        b = jnp.cumsum(gc, axis=1)
        o_inter = jnp.einsum('bthk,bhkv->bthv', qc * jnp.exp(b), S)
        diff = b[:, :, None] - b[:, None, :]
        decay = jnp.where(tri, jnp.exp(jnp.where(tri, diff, 0.0)), 0.0)
        A = jnp.einsum('bthk,bshk,btshk->bhts', qc, kc, decay)
        o_intra = jnp.einsum('bhts,bshv->bthv', A, vc)
        b_last = b[:, -1]
        kdec = kc * jnp.exp(b_last[:, None] - b)
        S_new = jnp.exp(b_last)[..., None] * S + jnp.einsum('bshk,bshv->bhkv', kdec, vc)
        return S_new, o_inter + o_intra

    s_T, o = lax.scan(step, s0.astype(F32), (to_chunks(q), to_chunks(k), to_chunks(v), to_chunks(lg)))
    o = jnp.moveaxis(o, 0, 1).reshape(Bb, Tp, H, V)[:, :T]
    return o, s_T


def mix_ab(hn, p, i, kv_buf, conv_buf, h0):
    Bb, T, _ = hn.shape
    q, k, v, xb, gb = split_cols(hn @ p['w_in_ab'][i], (W_A, W_A, W_A, W_B, W_B))
    q = rmsnorm(q.reshape(Bb, T, H_A, DH_A), p['q_norm'][i])
    k = rmsnorm(k.reshape(Bb, T, H_A, DH_A), p['k_norm'][i])
    v = v.reshape(Bb, T, H_A, DH_A)
    if kv_buf is None:
        res = [dilated_attn_prompt(q, k, v, w, d) for (w, d) in DILATED_GROUPS]
        new_kv = jnp.stack([k, v], axis=2)[:, T - min(WINDOW_MAX, T):]
    else:
        L = kv_buf.shape[1]
        kc = jnp.concatenate([kv_buf[:, :, 0].astype(k.dtype), k], axis=1)
        vc = jnp.concatenate([kv_buf[:, :, 1].astype(v.dtype), v], axis=1)
        res = [dilated_attn_step(q, kc, vc, w, d, L) for (w, d) in DILATED_GROUPS]
        new_kv = jnp.stack([k, v], axis=2)
    o_a = combine_dilations(res).reshape(Bb, T, W_A)
    xc, new_conv = causal_dwconv(xb, conv_buf, p['lru_conv_w'][i], p['lru_conv_b'][i])
    hs, h_last = rg_lru(xc, h0, p['lru_wa'][i], p['lru_ba'][i], p['lru_wx'][i], p['lru_bx'][i], p['lru_lambda'][i])
    o_b = hs * jax.nn.gelu(gb.astype(F32))
    y = jnp.concatenate([o_a, o_b], axis=-1).astype(hn.dtype) @ p['w_out_ab'][i]
    return y, new_kv, new_conv, h_last


def mix_cd(hn, p, i, lb, s_c0, s_d0):
    Bb, T, _ = hn.shape
    qc, fc, ic, gc, qd, kd, vd, rd, ad = split_cols(
        hn @ p['w_in_cd'][i], (KEY_C, KEY_C, W_C, W_C, KEY_D, KEY_D, W_D, W_D, GATE_RANK))
    zf = fc.astype(F32).reshape(Bb, T, H_C, DK_C)
    lbh = lb.reshape(H_C, DK_C)
    log_f = jnp.log(lbh + (1.0 - lbh) * jax.nn.sigmoid(zf))
    k_c = (1.0 - lbh) * jax.nn.sigmoid(-zf)
    o_c, s_c = chunk_gla(qc.reshape(Bb, T, H_C, DK_C), k_c, ic.reshape(Bb, T, H_C, DV_C), log_f, s_c0)
    o_c = rmsnorm(o_c, p['hgrn_norm'][i]) * jax.nn.silu(gc.astype(F32).reshape(Bb, T, H_C, DV_C))
    z_a = ad.astype(F32) @ p['gla_wg2'][i].astype(F32) + p['gla_bg'][i]
    log_alpha = (jax.nn.log_sigmoid(z_a) / GLA_TAU).reshape(Bb, T, H_D, DK_D)
    o_d, s_d = chunk_gla(qd.reshape(Bb, T, H_D, DK_D) * (DK_D ** -0.5), kd.reshape(Bb, T, H_D, DK_D),
                         vd.reshape(Bb, T, H_D, DV_D), log_alpha, s_d0)
    o_d = rmsnorm(o_d, p['gla_norm'][i]) * jax.nn.silu(rd.astype(F32).reshape(Bb, T, H_D, DV_D))
    y = jnp.concatenate([o_c.reshape(Bb, T, W_C), o_d.reshape(Bb, T, W_D)], axis=-1).astype(hn.dtype) @ p['w_out_cd'][i]
    return y, s_c, s_d


def conv_ffn(hn, p, layer, buf):
    g, u = split_cols(hn @ p['ffn_w_up'][layer], (D_FF, D_FF))
    gc, new_buf = causal_dwconv(g, buf, p['ffn_conv_w'][layer], p['ffn_conv_b'][layer])
    return (jax.nn.silu(gc) * u) @ p['ffn_w_down'][layer], new_buf


def run_trunk(x, p, st):
    Bb = x.shape[0]
    dt = x.dtype
    pr = jax.nn.softmax(p['hgrn_lb_logits'].astype(F32), axis=0)
    lower_bounds = jnp.cumsum(pr, axis=0) - pr[0]
    kvs, convs, hs, shg, sgl, ffs = [], [], [], [], [], []
    for layer in range(DEPTH):
        i = layer // 2
        hn = rmsnorm(x, p['norm_mix'][layer])
        if layer % 2 == 0:
            if st is None:
                kv_buf = None
                conv_buf = jnp.zeros((Bb, CONV_B - 1, W_B), dt)
                h0 = jnp.zeros((Bb, W_B), F32)
            else:
                kv_buf, conv_buf, h0 = st[0][i], st[1][i], st[2][i]
            y, n_kv, n_conv, n_h = mix_ab(hn, p, i, kv_buf, conv_buf, h0)
            kvs.append(n_kv)
            convs.append(n_conv)
            hs.append(n_h)
        else:
            if st is None:
                s_c0 = jnp.zeros((Bb, H_C, DK_C, DV_C), F32)
                s_d0 = jnp.zeros((Bb, H_D, DK_D, DV_D), F32)
            else:
                s_c0, s_d0 = st[3][i], st[4][i]
            y, n_c, n_d = mix_cd(hn, p, i, lower_bounds[i], s_c0, s_d0)
            shg.append(n_c)
            sgl.append(n_d)
        x = x + y.astype(dt)
        hn = rmsnorm(x, p['norm_ffn'][layer])
        fbuf = jnp.zeros((Bb, CONV_F - 1, D_FF), dt) if st is None else st[5][layer]
        y, n_f = conv_ffn(hn, p, layer, fbuf)
        ffs.append(n_f)
        x = x + y.astype(dt)
    return x, jnp.stack(kvs), jnp.stack(convs), jnp.stack(hs), jnp.stack(shg), jnp.stack(sgl), jnp.stack(ffs)


def setup_inputs(seed: int = 0) -> dict:
    key = jax.random.key(seed)
    ks = iter(jax.random.split(key, 48))

    def nrm(shape, scale):
        return scale * jax.random.normal(next(ks), shape, F32)

    l_a = min(WINDOW_MAX, PAST_LEN)
    a_init = jax.random.uniform(next(ks), (N_EVEN, W_B), F32, 0.9, 0.999)
    s = a_init ** (1.0 / LRU_C)
    lru_lambda = jnp.log(s) - jnp.log1p(-s)
    return {
        'x_prompt': nrm((BATCH, SEQ, D_MODEL), 1.0),
        'x_sample': nrm((DEC_BATCH, DEC_SEQ, D_MODEL), 1.0),
        'cache_attn_kv': nrm((N_EVEN, DEC_BATCH, l_a, 2, H_A, DH_A), 1.0),
        'state_lru_conv': nrm((N_EVEN, DEC_BATCH, CONV_B - 1, W_B), 1.0),
        'state_lru_h': nrm((N_EVEN, DEC_BATCH, W_B), 0.5),
        'state_hgrn': nrm((N_ODD, DEC_BATCH, H_C, DK_C, DV_C), 1.0),
        'state_gla': nrm((N_ODD, DEC_BATCH, H_D, DK_D, DV_D), 1.0),
        'state_ffn_conv': nrm((DEPTH, DEC_BATCH, CONV_F - 1, D_FF), 1.0),
        'norm_mix': 1.0 + nrm((DEPTH, D_MODEL), 0.02),
        'norm_ffn': 1.0 + nrm((DEPTH, D_MODEL), 0.02),
        'w_in_ab': nrm((N_EVEN, D_MODEL, IN_AB), D_MODEL ** -0.5),
        'q_norm': 1.0 + nrm((N_EVEN, DH_A), 0.02),
        'k_norm': 1.0 + nrm((N_EVEN, DH_A), 0.02),
        'lru_conv_w': nrm((N_EVEN, CONV_B, W_B), CONV_B ** -0.5),
        'lru_conv_b': nrm((N_EVEN, W_B), 0.01),
        'lru_wa': nrm((N_EVEN, H_B, BH_B, BH_B), BH_B ** -0.5),
        'lru_ba': nrm((N_EVEN, W_B), 0.01),
        'lru_wx': nrm((N_EVEN, H_B, BH_B, BH_B), BH_B ** -0.5),
        'lru_bx': nrm((N_EVEN, W_B), 0.01),
        'lru_lambda': lru_lambda,
        'w_out_ab': nrm((N_EVEN, MIX_AB, D_MODEL), MIX_AB ** -0.5),
        'w_in_cd': nrm((N_ODD, D_MODEL, IN_CD), D_MODEL ** -0.5),
        'hgrn_lb_logits': nrm((N_ODD, KEY_C), 1.0),
        'hgrn_norm': 1.0 + nrm((N_ODD, DV_C), 0.02),
        'gla_wg2': nrm((N_ODD, GATE_RANK, KEY_D), GATE_RANK ** -0.5),
        'gla_bg': nrm((N_ODD, KEY_D), 0.01),
        'gla_norm': 1.0 + nrm((N_ODD, DV_D), 0.02),
        'w_out_cd': nrm((N_ODD, MIX_CD, D_MODEL), MIX_CD ** -0.5),
        'ffn_w_up': nrm((DEPTH, D_MODEL, 2 * D_FF), D_MODEL ** -0.5),
        'ffn_conv_w': nrm((DEPTH, CONV_F, D_FF), CONV_F ** -0.5),
        'ffn_conv_b': nrm((DEPTH, D_FF), 0.01),
        'ffn_w_down': nrm((DEPTH, D_FF, D_MODEL), D_FF ** -0.5),
    }


def reference(x_prompt, x_sample, cache_attn_kv, state_lru_conv, state_lru_h, state_hgrn, state_gla,
              state_ffn_conv, norm_mix, norm_ffn, w_in_ab, q_norm, k_norm, lru_conv_w, lru_conv_b, lru_wa,
              lru_ba, lru_wx, lru_bx, lru_lambda, w_out_ab, w_in_cd, hgrn_lb_logits, hgrn_norm, gla_wg2, gla_bg,
              gla_norm, w_out_cd, ffn_w_up, ffn_conv_w, ffn_conv_b, ffn_w_down):
    p = {
        'norm_mix': norm_mix, 'norm_ffn': norm_ffn, 'w_in_ab': w_in_ab, 'q_norm': q_norm, 'k_norm': k_norm,
        'lru_conv_w': lru_conv_w, 'lru_conv_b': lru_conv_b, 'lru_wa': lru_wa, 'lru_ba': lru_ba,
        'lru_wx': lru_wx, 'lru_bx': lru_bx, 'lru_lambda': lru_lambda, 'w_out_ab': w_out_ab,
        'w_in_cd': w_in_cd, 'hgrn_lb_logits': hgrn_lb_logits, 'hgrn_norm': hgrn_norm, 'gla_wg2': gla_wg2,
        'gla_bg': gla_bg, 'gla_norm': gla_norm, 'w_out_cd': w_out_cd, 'ffn_w_up': ffn_w_up,
        'ffn_conv_w': ffn_conv_w, 'ffn_conv_b': ffn_conv_b, 'ffn_w_down': ffn_w_down,
    }
    y_prompt, p_kv, p_conv, p_h, p_hgrn, p_gla, p_ffn = run_trunk(x_prompt, p, None)
    st = (cache_attn_kv, state_lru_conv, state_lru_h, state_hgrn, state_gla, state_ffn_conv)
    y_sample, s_kv, s_conv, s_h, s_hgrn, s_gla, s_ffn = run_trunk(x_sample, p, st)
    return (y_prompt, y_sample, p_kv, s_kv, p_conv, s_conv, p_h, s_h, p_hgrn, s_hgrn, p_gla, s_gla, p_ffn, s_ffn)
```

```cpp
#include <hip/hip_runtime.h>
namespace mk {
#define MK_LAS __attribute__((address_space(3)))
#define MK_GAS __attribute__((address_space(1)))
typedef unsigned short bf16_t;
typedef short bf16x8 __attribute__((ext_vector_type(8)));
typedef short s16x4 __attribute__((ext_vector_type(4)));
typedef float f32x4 __attribute__((ext_vector_type(4)));
typedef float f32x2 __attribute__((ext_vector_type(2)));
typedef unsigned u32x4 __attribute__((ext_vector_type(4)));
typedef unsigned u32x2 __attribute__((ext_vector_type(2)));

constexpr int D = 2048, NB = 2, SEQ = 4096, MP = NB * SEQ, SB = 8, ST = 8, MS = SB * ST, MT = MP + MS;
constexpr int HA = 8, DH = 128, WA = 1024, WB = 1024, HB_ = 8, LA = 2048;
constexpr int N_AB = 5120, N_CD = 7680, N_CD_SRC = 7184, N_CDZ = 7168, FF = 5504, N_UP = 2 * FF;
constexpr int HC = 8, HD_ = 4, DK = 128, DVC = 128, DVD = 256;
constexpr float EPS = 1e-6f;
constexpr int NCHUNK = SEQ / 64;
constexpr int ZC_QC = 0, ZC_KC = 1024, ZC_IC = 2048, ZC_GC = 3072, ZC_QD = 4096, ZC_KD = 4608, ZC_VD = 5120, ZC_RD = 6144;

constexpr size_t MiB = 1u << 20;
constexpr size_t WS_CTL = 0, CTL_BYTES = 1 * MiB;
constexpr size_t WS_WINAB = 1 * MiB, SZ_WINAB = (size_t)N_AB * D * 2;
constexpr size_t WS_WOUTAB = WS_WINAB + 2 * SZ_WINAB, SZ_WOUT = (size_t)D * D * 2;
constexpr size_t WS_WINCD = WS_WOUTAB + 2 * SZ_WOUT, SZ_WINCD = (size_t)N_CD * D * 2;
constexpr size_t WS_WOUTCD = WS_WINCD + 2 * SZ_WINCD;
constexpr size_t WS_WUP = WS_WOUTCD + 2 * SZ_WOUT, SZ_WUP = (size_t)N_UP * D * 2;
constexpr size_t WS_WDN = WS_WUP + 4 * SZ_WUP, SZ_WDN = (size_t)D * FF * 2;
constexpr size_t WS_WLRU = WS_WDN + 4 * SZ_WDN, SZ_WLRU = (size_t)2 * 8 * 2 * 128 * 128 * 2;
constexpr size_t WS_LB = WS_WLRU + SZ_WLRU;
constexpr size_t WS_XB16 = WS_LB + 64 * 1024;
constexpr size_t WS_Z = WS_XB16 + 33 * MiB;
constexpr size_t WS_LG = WS_Z + 112 * MiB;
constexpr size_t WS_SC = WS_LG + 48 * MiB;
constexpr size_t WS_MIX = WS_SC + 64 * MiB;
constexpr size_t WS_ZS = WS_MIX + 33 * MiB;
constexpr size_t WS_GUS = WS_ZS + 2 * MiB;
constexpr size_t WS_GHEAD = WS_GUS + 3 * MiB;
constexpr size_t WS_GTAIL = WS_GHEAD + 3 * MiB;
constexpr size_t WS_RSS = WS_GTAIL + 2 * MiB;
constexpr size_t RSS_P_FLOATS = (size_t)9 * MP * 8, RSS_S_FLOATS = (size_t)9 * MS * 128;
constexpr size_t WS_END = WS_RSS + 3 * MiB;
static_assert((RSS_P_FLOATS + RSS_S_FLOATS) * 4 <= 3 * MiB && (size_t)MT * FF * 2 <= 112 * MiB && (size_t)MP * N_CDZ * 2 <= 112 * MiB && (size_t)MT * D * 2 <= 33 * MiB, "ws map");
constexpr int CW_TMO = 0, CW_CODE = 1, CW_BAR = 4096, CW_Q = 8192;
constexpr int RING_BYTES = 131072, EPI_OFF = RING_BYTES, EPI_BYTES = 12288, MISC_OFF = EPI_OFF + EPI_BYTES, LDS_BYTES = 147456;
static_assert(MISC_OFF + 256 <= LDS_BYTES, "lds");

__device__ __forceinline__ unsigned f2bf(float f) { unsigned u = __builtin_bit_cast(unsigned, f); return (u + 0x7fffu + ((u >> 16) & 1u)) >> 16; }
__device__ __forceinline__ unsigned pk2(float lo, float hi) { return f2bf(lo) | (f2bf(hi) << 16); }
__device__ __forceinline__ float bf2f(unsigned short b) { return __builtin_bit_cast(float, ((unsigned)b) << 16); }
__device__ __forceinline__ float bflo(unsigned w) { return __builtin_bit_cast(float, w << 16); }
__device__ __forceinline__ float bfhi(unsigned w) { return __builtin_bit_cast(float, w & 0xffff0000u); }
__device__ __forceinline__ unsigned cvt_pk_bf16(float lo, float hi) { unsigned r; asm volatile("v_cvt_pk_bf16_f32 %0, %1, %2" : "=v"(r) : "v"(lo), "v"(hi)); return r; }
__device__ __forceinline__ float fast_exp2(float x) { return __builtin_amdgcn_exp2f(x); }
__device__ __forceinline__ float fast_exp(float x) { return __builtin_amdgcn_exp2f(x * 1.44269504089f); }
__device__ __forceinline__ float fast_rcp(float x) { return __builtin_amdgcn_rcpf(x); }
__device__ __forceinline__ float sigmoid_f(float x) { return fast_rcp(1.0f + fast_exp(-x)); }
__device__ __forceinline__ float silu_f(float x) { return x * sigmoid_f(x); }
__device__ __forceinline__ float gelu_tanh_f(float x) { const float u = 0.7978845608028654f * (x + 0.044715f * x * x * x); return x * sigmoid_f(2.0f * u); }
template <class T> __device__ __forceinline__ MK_GAS T* launder(T* p) { MK_GAS T* q = (MK_GAS T*)p; asm volatile("" : "+v"(q)); return q; }
template <class T> __device__ __forceinline__ MK_GAS T* launder(MK_GAS T* q) { asm volatile("" : "+v"(q)); return q; }
__device__ __forceinline__ int opaque_bid() { int b = (int)blockIdx.x; asm volatile("" : "+s"(b)); return b; }
__device__ __forceinline__ int lane_id() { int l; asm volatile("v_mbcnt_lo_u32_b32 %0, -1, 0\n\tv_mbcnt_hi_u32_b32 %0, -1, %0" : "=v"(l)); return l; }
__device__ __forceinline__ int opaque_tid(int wave) { int l; asm volatile("v_mbcnt_lo_u32_b32 %0, -1, 0\n\tv_mbcnt_hi_u32_b32 %0, -1, %0" : "=v"(l)); return wave * 64 + l; }
__device__ __forceinline__ float fast_rsq(float x) { return __builtin_amdgcn_rsqf(x); }
__device__ __forceinline__ float fast_sqrt(float x) { return __builtin_amdgcn_sqrtf(x); }
__device__ __forceinline__ float fast_ln(float x) { return 0.69314718056f * __builtin_amdgcn_logf(x); }
__device__ __forceinline__ float softplus_acc(float x) { if (x > 20.f) return x; const float e = fast_exp(x); const float ser = e * (1.0f + e * (-0.5f + e * (0.33333333f + e * (-0.25f + e * 0.2f)))); return e < 0.06f ? ser : fast_ln(1.0f + e); }
__device__ __forceinline__ float one_minus_exp(float x) { const float ser = -x * (1.0f + x * (0.5f + x * (0.16666667f + x * (0.041666668f + x * 0.0083333338f)))); return x > -0.3f ? ser : 1.0f - fast_exp(x); }
__device__ __forceinline__ float rss_p(const float* part, int row) { const f32x4 a = *(const f32x4*)(part + (size_t)row * 8), b = *(const f32x4*)(part + (size_t)row * 8 + 4); return ((a[0] + a[1]) + (a[2] + a[3])) + ((b[0] + b[1]) + (b[2] + b[3])); }
__device__ __forceinline__ float rss_s(const float* part, int row) { float s = 0.f; const f32x4* p = (const f32x4*)(part + (size_t)row * 128);
#pragma unroll 8
    for (int j = 0; j < 32; ++j) { const f32x4 a = p[j]; s += (a[0] + a[1]) + (a[2] + a[3]); } return s; }
__device__ __forceinline__ float bperm(int srclane, float v) { return __builtin_bit_cast(float, __builtin_amdgcn_ds_bpermute(srclane << 2, __builtin_bit_cast(int, v))); }
#define SHX(v, mask) bperm(lane ^ (mask), (v))
#define SHUP(v, d) bperm(lane >= (d) ? lane - (d) : lane, (v))
#define SHL(v, src) bperm((src), (v))
#define LDS_WAIT() asm volatile("s_waitcnt lgkmcnt(0)" ::: "memory")
#define VM_WAIT() asm volatile("s_waitcnt vmcnt(0)" ::: "memory")

#define XB_TMO      128
#define XB_XCNT(j)  (256  + 64 * (j))
#define XB_XSUB(j)  (1280 + 64 * (j))
#define XB_XGEN(j)  (2304 + 64 * (j))
#define XB_TOP      3328
#define XB_TOPGEN   3392
#define XCD_BAR_WORDS 3456
#define XB_SPIN_CAP (1u << 22)
__device__ __forceinline__ unsigned xb_ld(unsigned* p)              { return __hip_atomic_load(p, __ATOMIC_RELAXED, __HIP_MEMORY_SCOPE_AGENT); }
__device__ __forceinline__ unsigned xb_add(unsigned* p, unsigned v) { return __hip_atomic_fetch_add(p, v, __ATOMIC_RELAXED, __HIP_MEMORY_SCOPE_AGENT); }
__device__ __forceinline__ unsigned xb_xcc_id() { return (unsigned)__builtin_amdgcn_s_getreg((3 << 11) | 20) & 0xFu; }
#define XB_SPIN(cond, bar) do { unsigned _sp = 0; while (cond) { __builtin_amdgcn_s_sleep(1); \
    if ((++_sp & 255u) == 0u) { if (xb_ld(&(bar)[XB_TMO])) break; if (_sp > XB_SPIN_CAP) { atomicAdd(&(bar)[XB_TMO], 1u); break; } } } } while (0)
struct XcdBarrier { unsigned* bar; unsigned x; volatile MK_LAS unsigned* st; };
__device__ __forceinline__ XcdBarrier xcd_barrier_post(unsigned* bar, volatile MK_LAS unsigned* st, int wave) {
    XcdBarrier b; b.bar = bar; b.x = xb_xcc_id(); b.st = st;
    if (wave == 0 && lane_id() == 0) (void)xb_add(&bar[XB_XCNT(b.x)], 1u);
    return b;
}
__device__ __forceinline__ void xcd_barrier_complete(unsigned* bar, unsigned x, unsigned& nloc, unsigned& nx) {
    const unsigned G = gridDim.x * gridDim.y * gridDim.z;
    unsigned sum, cnt, mine, sp = 0u;
    for (;;) {
        sum = 0u; cnt = 0u; mine = 0u;
#pragma unroll
        for (unsigned j = 0; j < 16; ++j) { const unsigned c = xb_ld(&bar[XB_XCNT(j)]); sum += c; cnt += (c > 0u) ? 1u : 0u; mine = (j == x) ? c : mine; }
        if (sum == G) break;
        __builtin_amdgcn_s_sleep(1);
        if ((++sp & 255u) == 0u) { if (xb_ld(&bar[XB_TMO])) break; if (sp > XB_SPIN_CAP) { atomicAdd(&bar[XB_TMO], 1u); break; } }
    }
    nloc = mine > 0u ? mine : 1u; nx = cnt > 0u ? cnt : 1u;
}
__device__ __forceinline__ void xcd_barrier(const XcdBarrier& b, int wave) {
    asm volatile("s_waitcnt vmcnt(0)" ::: "memory");
    __syncthreads();
    if (wave == 0 && lane_id() == 0) {
        unsigned* bar = b.bar; unsigned bx = xb_xcc_id(); asm volatile("" : "+s"(bx));
        __builtin_amdgcn_s_waitcnt(0);
        unsigned nloc = b.st[0], nx = b.st[1];
        if (nloc == 0u) { xcd_barrier_complete(bar, bx, nloc, nx); b.st[0] = nloc; b.st[1] = nx; }
        const unsigned old = xb_add(&bar[XB_XSUB(bx)], 1u);
        const unsigned gen = old / nloc;
        if (old + 1u == (gen + 1u) * nloc) {
            __builtin_amdgcn_fence(__ATOMIC_RELEASE, "agent");
            asm volatile("s_waitcnt vmcnt(0)" ::: "memory");
            const unsigned og = xb_add(&bar[XB_TOP], 1u);
            const unsigned tg = og / nx;
            if (og + 1u == (tg + 1u) * nx) xb_add(&bar[XB_TOPGEN], 1u);
            else XB_SPIN(xb_ld(&bar[XB_TOPGEN]) == tg, bar);
            __builtin_amdgcn_fence(__ATOMIC_ACQUIRE, "agent");
            xb_add(&bar[XB_XGEN(bx)], 1u);
            asm volatile("s_waitcnt vmcnt(0)" ::: "memory");
        } else {
            XB_SPIN(xb_ld(&bar[XB_XGEN(bx)]) == gen, bar);
            __builtin_amdgcn_fence(__ATOMIC_ACQUIRE, "agent");
            asm volatile("s_waitcnt vmcnt(0)" ::: "memory");
        }
    }
    __syncthreads();
}

constexpr int BM = 256, BK = 64, HALF = 128, HTB = HALF * BK * 2, STAGE_BYTES = 8 * HTB, NXCD = 8, WGM = 8;
__host__ __device__ __forceinline__ int lds_byte(int r, int c) { const int st = (r >> 4) * 2 + (c >> 5), rr = r & 15, cc = c & 31, ob = rr * 64 + cc * 2; return st * 1024 + (ob ^ (((ob >> 9) & 1) << 5)); }
__host__ __device__ __forceinline__ void stage_rc(int b, int& R, int& C) { const int st = b / 1024, sb = b % 1024, swz = sb ^ (((sb >> 9) & 1) << 5); R = (st >> 1) * 16 + swz / 64; C = (st & 1) * 32 + (swz % 64) / 2; }
__host__ __device__ __forceinline__ int perm32(int rho) { const int n = rho >> 4, i = rho & 15; return 8 * (i >> 2) + 4 * n + (i & 3); }
struct Unit { int pm, pn; };
struct Gemm { const bf16_t* A; const bf16_t* Bt; int M, N, K; };
struct StaticOrder {
    int nM, nN, nwg, G, c;
    __device__ __forceinline__ void init(int M, int N, int G_, int c_) { nM = M / BM; nN = N / BM; nwg = nM * nN; G = G_; c = c_; }
    __device__ __forceinline__ bool next(int i, Unit& u) const {
        const long L = (long)i * G + c; if (L >= nwg) return false;
        int wgid = (int)L; { const int q = nwg / NXCD, r = nwg % NXCD, xcd = wgid % NXCD, off = wgid / NXCD; wgid = (xcd < r ? xcd * (q + 1) : r * (q + 1) + (xcd - r) * q) + off; }
        const int nig = WGM * nN, gid = wgid / nig, fm = gid * WGM, gsz = (nM - fm) < WGM ? (nM - fm) : WGM;
        u.pm = fm + ((wgid % nig) % gsz); u.pn = (wgid % nig) / gsz; return true;
    }
};
template <class Epi>
__device__ __forceinline__ void gemm_phase(MK_LAS unsigned char* lds, const Gemm g, const StaticOrder& S, const Epi& E, int wave_id) {
    const int tid = opaque_tid(wave_id), wid = wave_id, lane = tid & 63, wr = wid >> 2, wc = wid & 3, fr = lane & 15, fq = lane >> 4;
    const int K = g.K, nt = K / BK;
    unsigned voffA[2], voffB[2];
#pragma unroll
    for (int i = 0; i < 2; ++i) { int R, C; stage_rc(tid * 16 + i * 8192, R, C); const int Rb = Epi::PERM ? ((R & ~31) + perm32(R & 31)) : R;
        voffA[i] = (unsigned)(R * K + C) * 2u; voffB[i] = (unsigned)(Rb * K + C) * 2u; }
    const size_t kstep = (size_t)(BK * 2);
    const size_t hstep = (size_t)HALF * K * 2;
    const size_t tstep = 2 * hstep;
    const unsigned ldsw = (unsigned)wid * 1024u;
    const int aoff = lds_byte(wr * 64 + fr, fq * 8), boff = lds_byte(wc * 32 + fr, fq * 8);
#define PG8_SA(b, h) (((b) * 2 + (h)) * HTB)
#define PG8_SB(b, h) ((4 + (b) * 2 + (h)) * HTB)
#define PG8_STAGE(bufoff, gbase, voff) do { _Pragma("unroll") for (int _i = 0; _i < 2; ++_i) \
        __builtin_amdgcn_global_load_lds((const unsigned*)((const char*)(gbase) + (voff)[_i]), (MK_LAS unsigned*)(lds + (bufoff) + ldsw + _i * 8192), 16, 0, 0); } while (0)
#define PG8_LDA(dst, b, h) do { _Pragma("unroll") for (int m = 0; m < 4; ++m) _Pragma("unroll") for (int k = 0; k < 2; ++k) dst[m][k] = *(const MK_LAS bf16x8*)(lds + PG8_SA(b, h) + aoff + m * 2048 + k * 1024); } while (0)
#define PG8_LDB(dst, b, h) do { _Pragma("unroll") for (int n = 0; n < 2; ++n) _Pragma("unroll") for (int k = 0; k < 2; ++k) dst[n][k] = *(const MK_LAS bf16x8*)(lds + PG8_SB(b, h) + boff + n * 2048 + k * 1024); } while (0)
#define PG8_MMA(ai, bj, At, Bt) do { __builtin_amdgcn_s_setprio(1); _Pragma("unroll") for (int m = 0; m < 4; ++m) _Pragma("unroll") for (int n = 0; n < 2; ++n) _Pragma("unroll") for (int k = 0; k < 2; ++k) \
        acc[ai][bj][m][n] = __builtin_amdgcn_mfma_f32_16x16x32_bf16(Bt[n][k], At[m][k], acc[ai][bj][m][n], 0, 0, 0); __builtin_amdgcn_s_setprio(0); } while (0)
#define PG8_WAIT_V(n) asm volatile("s_waitcnt vmcnt(" #n ")" ::: "memory")
#define PG8_WAIT_L(n) asm volatile("s_waitcnt lgkmcnt(" #n ")" ::: "memory")
#define PG8_BAR __builtin_amdgcn_s_barrier()
#define PG8_SCHED __builtin_amdgcn_sched_barrier(0)
    Unit cur, nxt; int ui = 0;
    if (!S.next(0, cur)) return;
    f32x4 acc[2][2][4][2];
#pragma unroll
    for (int a = 0; a < 2; ++a)
#pragma unroll
        for (int b = 0; b < 2; ++b)
#pragma unroll
            for (int m = 0; m < 4; ++m)
#pragma unroll
                for (int n = 0; n < 2; ++n) acc[a][b][m][n] = (f32x4){0.f, 0.f, 0.f, 0.f};
    bf16x8 At[4][2], B0[2][2], B1[2][2];
    const char* cA = (const char*)g.A + (size_t)cur.pm * tstep; const char* cB = (const char*)g.Bt + (size_t)cur.pn * tstep;
    PG8_STAGE(PG8_SB(0, 0), cB, voffB); PG8_STAGE(PG8_SB(0, 1), cB + hstep, voffB); PG8_STAGE(PG8_SA(0, 0), cA, voffA); PG8_STAGE(PG8_SA(0, 1), cA + hstep, voffA);
    if (wr == 1) PG8_BAR;
    PG8_WAIT_V(2); PG8_BAR;
    PG8_STAGE(PG8_SB(1, 0), cB + kstep, voffB); PG8_STAGE(PG8_SA(1, 0), cA + kstep, voffA); PG8_STAGE(PG8_SB(1, 1), cB + hstep + kstep, voffB);
    PG8_WAIT_V(6); PG8_BAR;
    for (;;) {
        const bool has_next = S.next(ui + 1, nxt);
        const char* nA = has_next ? (const char*)g.A + (size_t)nxt.pm * tstep : cA; const char* nB = has_next ? (const char*)g.Bt + (size_t)nxt.pn * tstep : cB;
        for (int t = 0; t < nt; t += 2) {
            const bool last = (t == nt - 2);
            const char* a1 = cA + (size_t)(t + 1) * kstep;
            const char* a2 = last ? nA : cA + (size_t)(t + 2) * kstep; const char* b2 = last ? nB : cB + (size_t)(t + 2) * kstep;
            const char* a3 = a2 + kstep; const char* b3 = b2 + kstep;
            PG8_LDB(B0, 0, 0); PG8_LDB(B1, 0, 1); PG8_SCHED; PG8_LDA(At, 0, 0); PG8_STAGE(PG8_SA(1, 1), a1 + hstep, voffA);
            PG8_WAIT_V(8); PG8_WAIT_L(0); PG8_BAR; PG8_MMA(0, 0, At, B0); PG8_MMA(0, 1, At, B1); PG8_BAR; PG8_SCHED;
            PG8_LDA(At, 0, 1); PG8_STAGE(PG8_SB(0, 0), b2, voffB); PG8_STAGE(PG8_SB(0, 1), b2 + hstep, voffB); PG8_STAGE(PG8_SA(0, 0), a2, voffA);
            PG8_WAIT_V(8); PG8_WAIT_L(0); PG8_BAR; PG8_MMA(1, 0, At, B0); PG8_MMA(1, 1, At, B1); PG8_BAR; PG8_SCHED;
            PG8_LDB(B0, 1, 0); PG8_LDB(B1, 1, 1); PG8_SCHED; PG8_LDA(At, 1, 0); PG8_STAGE(PG8_SA(0, 1), a2 + hstep, voffA);
            PG8_WAIT_V(8); PG8_WAIT_L(0); PG8_BAR; PG8_MMA(0, 0, At, B0); PG8_MMA(0, 1, At, B1); PG8_BAR; PG8_SCHED;
            PG8_LDA(At, 1, 1); PG8_STAGE(PG8_SB(1, 0), b3, voffB); PG8_STAGE(PG8_SB(1, 1), b3 + hstep, voffB); PG8_STAGE(PG8_SA(1, 0), a3, voffA);
            PG8_WAIT_V(8); PG8_WAIT_L(0); PG8_BAR; PG8_MMA(1, 0, At, B0); PG8_MMA(1, 1, At, B1); PG8_BAR; PG8_SCHED;
        }
        if (wr == 0) PG8_BAR;
        E(acc, cur, wr, wc, fr, fq, lds + EPI_OFF);
        if (!has_next) break;
#pragma unroll
        for (int a = 0; a < 2; ++a)
#pragma unroll
            for (int b = 0; b < 2; ++b)
#pragma unroll
                for (int m = 0; m < 4; ++m)
#pragma unroll
                    for (int n = 0; n < 2; ++n) acc[a][b][m][n] = (f32x4){0.f, 0.f, 0.f, 0.f};
        cur = nxt; cA = nA; cB = nB; ++ui;
        if (wr == 1) PG8_BAR;
    }
    PG8_WAIT_V(0);
    PG8_BAR;
#undef PG8_SA
#undef PG8_SB
#undef PG8_STAGE
#undef PG8_LDA
#undef PG8_LDB
#undef PG8_MMA
#undef PG8_WAIT_V
#undef PG8_WAIT_L
#undef PG8_SCHED
}
}
namespace mk {
typedef f32x4 Acc[2][2][4][2];

struct EpiRes {
    static constexpr bool PERM = false;
    const float* base; float* xout; bf16_t* xb16; float* rssp;
    __device__ __forceinline__ void operator()(Acc& acc, const Unit& u, int wr, int wc, int fr, int fq, MK_LAS unsigned char* lds) const {
        asm volatile("" : "+v"(fr), "+v"(fq)); const int lane = fq * 16 + fr;
        const int row0 = u.pm * BM + wr * 64 + fr, col0 = u.pn * BM + wc * 32 + 4 * fq;
        MK_LAS float* P = (MK_LAS float*)lds;
#pragma unroll
        for (int ai = 0; ai < 2; ++ai)
#pragma unroll
            for (int m = 0; m < 4; ++m) { const int row = row0 + ai * HALF + m * 16; const unsigned off = (unsigned)row * D + col0; float ss = 0.f;
#pragma unroll
                for (int bj = 0; bj < 2; ++bj)
#pragma unroll
                    for (int n = 0; n < 2; ++n) { const unsigned o = off + bj * HALF + n * 16; const f32x4 v = acc[ai][bj][m][n] + *(const f32x4*)(base + o);
                        *(f32x4*)(xout + o) = v; u32x2 w; w.x = cvt_pk_bf16(v[0], v[1]); w.y = cvt_pk_bf16(v[2], v[3]); *(u32x2*)(xb16 + o) = w;
                        ss += (v[0] * v[0] + v[1] * v[1]) + (v[2] * v[2] + v[3] * v[3]); }
                ss += SHX(ss, 16); ss += SHX(ss, 32);
                if (fq == 0) P[(ai * HALF + wr * 64 + m * 16 + fr) * 4 + wc] = ss;
                asm volatile("" ::: "memory"); }
        LDS_WAIT(); __builtin_amdgcn_s_barrier(); asm volatile("" ::: "memory");
        if (fq == 0) {
#pragma unroll
            for (int ai = 0; ai < 2; ++ai)
#pragma unroll
                for (int m = 0; m < 4; ++m) if (((ai * 4 + m) >> 1) == wc) { const int rl = ai * HALF + wr * 64 + m * 16 + fr; const f32x4 p = *(const MK_LAS f32x4*)(P + rl * 4);
                    rssp[(unsigned)(u.pm * BM + rl) * 8 + u.pn] = (p[0] + p[1]) + (p[2] + p[3]); } }
    }
};

struct EpiInAB {
    static constexpr bool PERM = true;
    bf16_t* Z; const float* rss; const float* qn; const float* kn; float* kv_out; float* conv_out;
    __device__ __forceinline__ void operator()(Acc& acc, const Unit& u, int wr, int wc, int fr, int fq, MK_LAS unsigned char* lds) const {
        asm volatile("" : "+v"(fr), "+v"(fq)); const int lane = fq * 16 + fr;
        const int kind = u.pn >> 2; const int row0 = u.pm * BM + wr * 64 + fr; const int cw = (u.pn & 3) * 256 + wc * 32 + 8 * fq;
        MK_LAS float* P = (MK_LAS float*)lds;
#pragma unroll
        for (int ai = 0; ai < 2; ++ai)
#pragma unroll
            for (int m = 0; m < 4; ++m) { const float rs = fast_rsq(rss_p(rss, row0 + ai * HALF + m * 16) * (1.0f / D) + EPS);
#pragma unroll
                for (int bj = 0; bj < 2; ++bj) { acc[ai][bj][m][0] = acc[ai][bj][m][0] * rs; acc[ai][bj][m][1] = acc[ai][bj][m][1] * rs;
                    if (kind <= 1) { const f32x4 v = acc[ai][bj][m][0], x = acc[ai][bj][m][1]; float s = ((v[0] * v[0] + v[1] * v[1]) + (v[2] * v[2] + v[3] * v[3])) + ((x[0] * x[0] + x[1] * x[1]) + (x[2] * x[2] + x[3] * x[3]));
                        s += SHX(s, 16); s += SHX(s, 32);
                        if (fq == 0) P[((ai * HALF + wr * 64 + m * 16 + fr) * 2 + bj) * 4 + wc] = s; } }
                asm volatile("" ::: "memory"); }
        f32x4 g0 = (f32x4){1.f, 1.f, 1.f, 1.f}, g1 = g0;
        if (kind <= 1) { LDS_WAIT(); __builtin_amdgcn_s_barrier(); asm volatile("" ::: "memory");
            const float* gp = (kind == 0 ? qn : kn) + wc * 32 + 8 * fq; g0 = *(const f32x4*)gp; g1 = *(const f32x4*)(gp + 4); }
#pragma unroll
        for (int ai = 0; ai < 2; ++ai)
#pragma unroll
            for (int m = 0; m < 4; ++m) { const int row = row0 + ai * HALF + m * 16; const int t = row & (SEQ - 1), b = row >> 12;
#pragma unroll
                for (int bj = 0; bj < 2; ++bj) { f32x4 v0 = acc[ai][bj][m][0], v1 = acc[ai][bj][m][1];
                    if (kind <= 1) { const f32x4 p = *(const MK_LAS f32x4*)(P + ((ai * HALF + wr * 64 + m * 16 + fr) * 2 + bj) * 4);
                        const float hs = fast_rsq(((p[0] + p[1]) + (p[2] + p[3])) * (1.0f / DH) + EPS); v0 = v0 * hs * g0; v1 = v1 * hs * g1; }
                    u32x4 w; w.x = cvt_pk_bf16(v0[0], v0[1]); w.y = cvt_pk_bf16(v0[2], v0[3]); w.z = cvt_pk_bf16(v1[0], v1[1]); w.w = cvt_pk_bf16(v1[2], v1[3]);
                    *(u32x4*)(Z + (unsigned)row * N_AB + kind * 1024 + cw + bj * HALF) = w;
                    if ((kind == 1 || kind == 2) && t >= SEQ - LA) { float* o = kv_out + (((unsigned)b * LA + (t - (SEQ - LA))) * 2 + (kind - 1)) * WA + cw + bj * HALF; *(f32x4*)o = v0; *(f32x4*)(o + 4) = v1; }
                    if (kind == 3 && t >= SEQ - 3) { float* o = conv_out + ((unsigned)b * 3 + (t - (SEQ - 3))) * WB + cw + bj * HALF; *(f32x4*)o = v0; *(f32x4*)(o + 4) = v1; } }
                asm volatile("" ::: "memory"); }
    }
};

struct EpiInCD {
    static constexpr bool PERM = true;
    bf16_t* Z; const float* rss; const float* lb; const float* bg; float* lgc; float* lgd;
    __device__ __forceinline__ void operator()(Acc& acc, const Unit& u, int wr, int wc, int fr, int fq, MK_LAS unsigned char*) const {
        asm volatile("" : "+v"(fr), "+v"(fq));
        const int pn = u.pn; const int row0 = u.pm * BM + wr * 64 + fr; const int c8 = wc * 32 + 8 * fq;
        const int mode = (pn >= 4 && pn < 8) ? 1 : (pn >= 28 ? 2 : 0);
        const float sc = (pn == 16 || pn == 17) ? 0.08838834764831845f : 1.0f;
#pragma unroll
        for (int ai = 0; ai < 2; ++ai)
#pragma unroll
            for (int m = 0; m < 4; ++m) { const int row = row0 + ai * HALF + m * 16; const float rs = sc * fast_rsq(rss_p(rss, row) * (1.0f / D) + EPS);
#pragma unroll
                for (int bj = 0; bj < 2; ++bj) { f32x4 v0 = acc[ai][bj][m][0] * rs, v1 = acc[ai][bj][m][1] * rs; const int ct = c8 + bj * HALF;
                    if (mode == 1) { const int ck = (pn - 4) * 256 + ct; const f32x4 l0 = *(const f32x4*)(lb + ck), l1 = *(const f32x4*)(lb + ck + 4); f32x4 g0, g1;
#pragma unroll
                        for (int j = 0; j < 4; ++j) { const float s0 = sigmoid_f(v0[j]), s1 = sigmoid_f(v1[j]);
                            g0[j] = fmaxf(fast_ln(l0[j] + (1.0f - l0[j]) * s0), -60.0f); g1[j] = fmaxf(fast_ln(l1[j] + (1.0f - l1[j]) * s1), -60.0f);
                            v0[j] = (1.0f - l0[j]) * (1.0f - s0); v1[j] = (1.0f - l1[j]) * (1.0f - s1); }
                        float* o = lgc + (unsigned)row * 1024 + ck; *(f32x4*)o = g0; *(f32x4*)(o + 4) = g1; }
                    if (mode == 2) { const int ck = (pn - 28) * 256 + ct; const f32x4 b0 = *(const f32x4*)(bg + ck), b1 = *(const f32x4*)(bg + ck + 4); f32x4 g0, g1;
#pragma unroll
                        for (int j = 0; j < 4; ++j) { const float x0 = v0[j] + b0[j], x1 = v1[j] + b1[j];
                            g0[j] = (fminf(x0, 0.f) - fast_ln(1.0f + fast_exp(-fabsf(x0)))) * 0.0625f;
                            g1[j] = (fminf(x1, 0.f) - fast_ln(1.0f + fast_exp(-fabsf(x1)))) * 0.0625f; }
                        float* o = lgd + (unsigned)row * 512 + ck; *(f32x4*)o = g0; *(f32x4*)(o + 4) = g1; }
                    else { u32x4 w; w.x = cvt_pk_bf16(v0[0], v0[1]); w.y = cvt_pk_bf16(v0[2], v0[3]); w.z = cvt_pk_bf16(v1[0], v1[1]); w.w = cvt_pk_bf16(v1[2], v1[3]);
                        *(u32x4*)(Z + (unsigned)row * N_CDZ + pn * 256 + ct) = w; } } }
    }
};

struct EpiUp {
    static constexpr bool PERM = true;
    bf16_t* HB; const float* rss; const float* cw; const float* cb; float* ghead; float* gtail; float* ffn_out;
    __device__ __forceinline__ void operator()(Acc& acc, const Unit& u, int wr, int wc, int fr, int fq, MK_LAS unsigned char* lds) const {
        asm volatile("" : "+v"(fr), "+v"(fq));
        const int lane = fq * 16 + fr; const int row0 = u.pm * BM + wr * 64 + fr; const int c8 = wc * 32 + 8 * fq, cg = u.pn * 128 + c8;
        MK_LAS float* T = (MK_LAS float*)lds;
#pragma unroll
        for (int ai = 0; ai < 2; ++ai)
#pragma unroll
            for (int m = 0; m < 4; ++m) { const float rs = fast_rsq(rss_p(rss, row0 + ai * HALF + m * 16) * (1.0f / D) + EPS);
#pragma unroll
                for (int bj = 0; bj < 2; ++bj) { acc[ai][bj][m][0] = acc[ai][bj][m][0] * rs; acc[ai][bj][m][1] = acc[ai][bj][m][1] * rs; } }
        if (fr >= 14) {
#pragma unroll
            for (int ai = 0; ai < 2; ++ai) { MK_LAS float* t = T + ((2 * ai + wr) * 2 + (fr - 14)) * 128 + c8; *(MK_LAS f32x4*)t = acc[ai][0][3][0]; *(MK_LAS f32x4*)(t + 4) = acc[ai][0][3][1]; }
        }
        LDS_WAIT(); __builtin_amdgcn_s_barrier(); asm volatile("" ::: "memory");
        const int s1 = (lane & 48) | ((fr + 15) & 15), s2 = (lane & 48) | ((fr + 14) & 15);
        const bool first_tile = (u.pm & 15) == 0;
#pragma unroll
        for (int n = 0; n < 2; ++n) {
            const f32x4 w0 = *(const f32x4*)(cw + cg + 4 * n), w1 = *(const f32x4*)(cw + FF + cg + 4 * n), w2 = *(const f32x4*)(cw + 2 * FF + cg + 4 * n), bb = *(const f32x4*)(cb + cg + 4 * n);
#pragma unroll
            for (int ai = 0; ai < 2; ++ai) { const int grp = 2 * ai + wr; f32x4 prev1, prev2;
                if (grp == 0) { prev1 = (f32x4){0.f, 0.f, 0.f, 0.f}; prev2 = prev1; }
                else { const f32x4 r63 = *(const MK_LAS f32x4*)(T + ((grp - 1) * 2 + 1) * 128 + c8 + 4 * n), r62 = *(const MK_LAS f32x4*)(T + ((grp - 1) * 2 + 0) * 128 + c8 + 4 * n); prev1 = r63; prev2 = (fr == 0) ? r62 : r63; }
#pragma unroll
                for (int m = 0; m < 4; ++m) { const int row = row0 + ai * HALF + m * 16; const f32x4 x = acc[ai][0][m][n]; f32x4 r1, r2, hv;
#pragma unroll
                    for (int j = 0; j < 4; ++j) { r1[j] = SHL(x[j], s1); r2[j] = SHL(x[j], s2); }
                    const f32x4 p1 = (fr >= 1) ? r1 : prev1, p2 = (fr >= 2) ? r2 : prev2;
                    prev1 = r1; prev2 = r2;
                    const f32x4 gc = bb + w0 * p2 + w1 * p1 + w2 * x; const f32x4 uu = acc[ai][1][m][n];
#pragma unroll
                    for (int j = 0; j < 4; ++j) hv[j] = silu_f(gc[j]) * uu[j];
                    const bool deferred = (grp == 0) && (m == 0) && (fr < 2) && !first_tile;
                    if (!deferred) { u32x2 w; w.x = cvt_pk_bf16(hv[0], hv[1]); w.y = cvt_pk_bf16(hv[2], hv[3]); *(u32x2*)(HB + (unsigned)row * FF + cg + 4 * n) = w; }
                    else { float* o = ghead + ((unsigned)u.pm * 2 + fr) * (2 * FF) + cg + 4 * n; *(f32x4*)o = x; *(f32x4*)(o + FF) = uu; }
                    if (grp == 3 && m == 3 && fr >= 14) { *(f32x4*)(gtail + ((unsigned)u.pm * 2 + (fr - 14)) * FF + cg + 4 * n) = x;
                        if ((u.pm & 15) == 15) *(f32x4*)(ffn_out + ((unsigned)(u.pm >> 4) * 2 + (fr - 14)) * FF + cg + 4 * n) = x; }
                    asm volatile("" ::: "memory"); } } }
    }
};

template <int NT> struct SgLd { static constexpr int LDR = 16 * NT + 4, SLAB = 64 * LDR; };
template <int NT> __device__ __forceinline__ float sred4(const MK_LAS float* red, int row, int col) { constexpr int LDR = SgLd<NT>::LDR, SLAB = SgLd<NT>::SLAB; const MK_LAS float* p = red + row * LDR + col; return (p[0] + p[SLAB]) + (p[2 * SLAB] + p[3 * SLAB]); }
template <int NT> __device__ __forceinline__ void sgemm_tile(MK_LAS float* red, const bf16_t* A, const bf16_t* Bt, int K, int n0, int wave, int lane) {
    constexpr int LDR = SgLd<NT>::LDR, SLAB = SgLd<NT>::SLAB;
    f32x4 acc[4][NT];
#pragma unroll
    for (int a = 0; a < 4; ++a)
#pragma unroll
        for (int b = 0; b < NT; ++b) acc[a][b] = (f32x4){0.f, 0.f, 0.f, 0.f};
    const int fr = lane & 15, g = lane >> 4;
    const bf16_t* ap = A + (size_t)fr * K + 8 * g; const bf16_t* bp = Bt + (size_t)(n0 + fr) * K + 8 * g;
    for (int ks = wave; ks < K / 32; ks += 8) { bf16x8 a[4], b[NT];
#pragma unroll
        for (int mt = 0; mt < 4; ++mt) a[mt] = *(const bf16x8*)(ap + (size_t)(16 * mt) * K + 32 * ks);
#pragma unroll
        for (int nt = 0; nt < NT; ++nt) b[nt] = *(const bf16x8*)(bp + (size_t)(16 * nt) * K + 32 * ks);
#pragma unroll
        for (int mt = 0; mt < 4; ++mt)
#pragma unroll
            for (int nt = 0; nt < NT; ++nt) acc[mt][nt] = __builtin_amdgcn_mfma_f32_16x16x32_bf16(a[mt], b[nt], acc[mt][nt], 0, 0, 0); }
    MK_LAS float* slab = red + (wave & 3) * SLAB;
    if (wave < 4) {
#pragma unroll
        for (int mt = 0; mt < 4; ++mt)
#pragma unroll
            for (int nt = 0; nt < NT; ++nt)
#pragma unroll
                for (int e = 0; e < 4; ++e) slab[(16 * mt + 4 * g + e) * LDR + 16 * nt + fr] = acc[mt][nt][e]; }
    LDS_WAIT(); __syncthreads();
    if (wave >= 4) {
#pragma unroll
        for (int mt = 0; mt < 4; ++mt)
#pragma unroll
            for (int nt = 0; nt < NT; ++nt)
#pragma unroll
                for (int e = 0; e < 4; ++e) slab[(16 * mt + 4 * g + e) * LDR + 16 * nt + fr] += acc[mt][nt][e]; }
    LDS_WAIT(); __syncthreads();
}
}
namespace mk {
struct Args { const float* in[32]; float* out; unsigned char* ws; int nlayers; int pad; };
struct Frame {
    MK_LAS unsigned char* lds; unsigned* ctl; unsigned char* ws; float* out; const float* const* in;
    int tid, lane, wave, vcu, G;
};
constexpr size_t O_YP = 0, O_YS = O_YP + (size_t)MP * D, O_KVP = O_YS + (size_t)MS * D, O_KVS = O_KVP + (size_t)2 * NB * LA * 2 * WA, O_CONVP = O_KVS + (size_t)2 * SB * ST * 2 * WA,
    O_CONVS = O_CONVP + (size_t)2 * NB * 3 * WB, O_HP = O_CONVS + (size_t)2 * SB * 3 * WB, O_HS = O_HP + (size_t)2 * NB * WB, O_HGP = O_HS + (size_t)2 * SB * WB,
    O_HGS = O_HGP + (size_t)2 * NB * HC * DK * DVC, O_GLP = O_HGS + (size_t)2 * SB * HC * DK * DVC, O_GLS = O_GLP + (size_t)2 * NB * HD_ * DK * DVD, O_FFP = O_GLS + (size_t)2 * SB * HD_ * DK * DVD,
    O_FFS = O_FFP + (size_t)4 * NB * 2 * FF, O_END = O_FFS + (size_t)4 * SB * 2 * FF;
enum { I_XP = 0, I_XS, I_KV, I_SCONV, I_SH, I_SHG, I_SGL, I_SFF, I_NMIX, I_NFFN, I_WINAB, I_QN, I_KN, I_LCW, I_LCB, I_LWA, I_LBA, I_LWX, I_LBX, I_LLAM, I_WOUTAB, I_WINCD, I_LBL, I_HGN, I_WG2, I_BG, I_GLN, I_WOUTCD, I_WUP, I_FCW, I_FCB, I_WDN };

__device__ __forceinline__ float* rss_ptr(Frame& F, int idx) { return (float*)(F.ws + WS_RSS) + (size_t)idx * MP * 8; }
__device__ __forceinline__ float* rss_sptr(Frame& F, int idx) { return (float*)(F.ws + WS_RSS) + RSS_P_FLOATS + (size_t)idx * MS * 128; }
__device__ __forceinline__ float wave_sum(float v, int lane) {
#pragma unroll
    for (int o = 1; o < 64; o <<= 1) v += SHX(v, o);
    return v;
}
__device__ __forceinline__ int q_next(Frame& F, int q) {
    volatile MK_LAS int* slot = (volatile MK_LAS int*)(F.lds + MISC_OFF + 64);
    __syncthreads();
    if (F.tid == 0) *slot = (int)__hip_atomic_fetch_add(F.ctl + CW_Q + 64 * q, 1u, __ATOMIC_RELAXED, __HIP_MEMORY_SCOPE_AGENT);
    __syncthreads();
    return *slot;
}

__device__ __forceinline__ void p0_item(const float* W, int K, int ldw, int n_src0, bf16_t* WT, int n_dst0, int k0, const float* gain, MK_LAS float* scr, int lane) {
#pragma unroll 8
    for (int i = 0; i < 32; ++i) { const int kk = 2 * i + (lane >> 5); const float gv = gain ? gain[k0 + kk] : 1.0f; scr[kk * 33 + (lane & 31)] = W[(size_t)(k0 + kk) * ldw + n_src0 + (lane & 31)] * gv; }
    LDS_WAIT(); asm volatile("" ::: "memory");
    const int c = lane & 7;
#pragma unroll
    for (int j = 0; j < 4; ++j) { const int n = (lane >> 3) + 8 * j; const MK_LAS float* s = scr + (8 * c) * 33 + n;
        u32x4 o; o.x = pk2(s[0 * 33], s[1 * 33]); o.y = pk2(s[2 * 33], s[3 * 33]); o.z = pk2(s[4 * 33], s[5 * 33]); o.w = pk2(s[6 * 33], s[7 * 33]);
        *(u32x4*)(WT + (size_t)(n_dst0 + n) * K + k0 + 8 * c) = o; }
    LDS_WAIT(); asm volatile("" ::: "memory");
}
__device__ __forceinline__ void p0_prologue(Frame& F) {
    MK_LAS float* scr = (MK_LAS float*)(F.lds + F.wave * 16384);
    const int gw = F.vcu * 8 + F.wave, NGW = F.G * 8; const int lane = F.lane;
    constexpr int I_AB = 32 * 160, I_O = 32 * 64, I_CD = 32 * 224, I_UP = 32 * 344, I_DN = 86 * 64;
    constexpr int PER_PAIR = I_AB + I_O + I_CD + I_O, PER_LAYER = I_UP + I_DN, NITEMS = 2 * PER_PAIR + 4 * PER_LAYER;
    for (int it = gw; it < NITEMS; it += NGW) {
        int r = it;
        if (r < 2 * PER_PAIR) { const int i = r / PER_PAIR; r -= i * PER_PAIR;
            if (r < I_AB) { const int kb = r / 160, nb = r % 160; p0_item(F.in[I_WINAB] + (size_t)i * D * N_AB, D, N_AB, 32 * nb, (bf16_t*)(F.ws + WS_WINAB + i * SZ_WINAB), 32 * nb, 64 * kb, F.in[I_NMIX] + (2 * i) * D, scr, lane); continue; } r -= I_AB;
            if (r < I_O) { const int kb = r / 64, nb = r % 64; p0_item(F.in[I_WOUTAB] + (size_t)i * D * D, D, D, 32 * nb, (bf16_t*)(F.ws + WS_WOUTAB + i * SZ_WOUT), 32 * nb, 64 * kb, nullptr, scr, lane); continue; } r -= I_O;
            if (r < I_CD) { const int kb = r / 224, nb = r % 224; p0_item(F.in[I_WINCD] + (size_t)i * D * N_CD_SRC, D, N_CD_SRC, 32 * nb, (bf16_t*)(F.ws + WS_WINCD + i * SZ_WINCD), 32 * nb, 64 * kb, F.in[I_NMIX] + (2 * i + 1) * D, scr, lane); continue; } r -= I_CD;
            { const int kb = r / 64, nb = r % 64; p0_item(F.in[I_WOUTCD] + (size_t)i * D * D, D, D, 32 * nb, (bf16_t*)(F.ws + WS_WOUTCD + i * SZ_WOUT), 32 * nb, 64 * kb, nullptr, scr, lane); continue; }
        }
        r -= 2 * PER_PAIR; const int l = r / PER_LAYER; r -= l * PER_LAYER;
        if (r < I_UP) { const int kb = r / 344, nb = r % 344; const int tile = nb >> 3, j32 = nb & 7;
            const int nsrc = (j32 < 4) ? tile * 128 + 32 * j32 : FF + tile * 128 + 32 * (j32 - 4);
            p0_item(F.in[I_WUP] + (size_t)l * D * N_UP, D, N_UP, nsrc, (bf16_t*)(F.ws + WS_WUP + l * SZ_WUP), 32 * nb, 64 * kb, F.in[I_NFFN] + l * D, scr, lane); continue; } r -= I_UP;
        { const int kb = r / 64, nb = r % 64; p0_item(F.in[I_WDN] + (size_t)l * FF * D, FF, D, 32 * nb, (bf16_t*)(F.ws + WS_WDN + l * SZ_WDN), 32 * nb, 64 * kb, nullptr, scr, lane); }
    }
    const int gt = F.vcu * 512 + F.tid, NGT = F.G * 512;
    for (int it = gt; it < 2 * 512 * (D / 8); it += NGT) { const int k8 = it % (D / 8), n = (it / (D / 8)) % 512, i = it / (512 * (D / 8));
        const float* W = F.in[I_WINCD] + (size_t)i * D * N_CD_SRC; const float* g2 = F.in[I_WG2] + (size_t)i * 16 * 512; const float* gn = F.in[I_NMIX] + (2 * i + 1) * D; float v[8];
#pragma unroll
        for (int j = 0; j < 8; ++j) { const int k = 8 * k8 + j; float s = 0.f;
#pragma unroll
            for (int r = 0; r < 16; ++r) s += W[(size_t)k * N_CD_SRC + N_CDZ + r] * g2[r * 512 + n];
            v[j] = s * gn[k]; }
        u32x4 o; o.x = pk2(v[0], v[1]); o.y = pk2(v[2], v[3]); o.z = pk2(v[4], v[5]); o.w = pk2(v[6], v[7]);
        *(u32x4*)((bf16_t*)(F.ws + WS_WINCD + i * SZ_WINCD) + (size_t)(N_CDZ + n) * D + 8 * k8) = o; }
    for (int it = gt; it < 2 * 8 * 2 * 128 * 16; it += NGT) { const int i8 = it % 16, o_ = (it / 16) % 128, gate = (it / 2048) % 2, h = (it / 4096) % 8, i = it / 32768;
        const float* W = F.in[gate ? I_LWX : I_LWA] + ((size_t)(i * 8 + h) * 128) * 128; float v[8];
#pragma unroll
        for (int j = 0; j < 8; ++j) v[j] = W[(size_t)(8 * i8 + j) * 128 + o_];
        u32x4 o; o.x = pk2(v[0], v[1]); o.y = pk2(v[2], v[3]); o.z = pk2(v[4], v[5]); o.w = pk2(v[6], v[7]);
        *(u32x4*)((bf16_t*)(F.ws + WS_WLRU) + ((size_t)((i * 8 + h) * 2 + gate) * 128 + o_) * 128 + 8 * i8) = o; }
    for (int k = gt; k < 1024; k += NGT) { const float a = F.in[I_LBL][k], b = F.in[I_LBL][1024 + k]; const float m = fmaxf(a, b), ea = expf(a - m), eb = expf(b - m), p0 = ea / (ea + eb), p1 = eb / (ea + eb);
        float* lb = (float*)(F.ws + WS_LB); lb[k] = p0 - p0; lb[1024 + k] = (p0 + p1) - p0; }
    for (int m = gw; m < MT; m += NGW) { const float* xr = (m < MP) ? F.in[I_XP] + (size_t)m * D : F.in[I_XS] + (size_t)(m - MP) * D; bf16_t* orow = (bf16_t*)(F.ws + WS_XB16) + (size_t)m * D; float s = 0.f;
#pragma unroll
        for (int j = 0; j < 8; ++j) { const f32x4 v = *(const f32x4*)(xr + 4 * lane + 256 * j); s += (v[0] * v[0] + v[1] * v[1]) + (v[2] * v[2] + v[3] * v[3]);
            u32x2 w; w.x = pk2(v[0], v[1]); w.y = pk2(v[2], v[3]); *(u32x2*)(orow + 4 * lane + 256 * j) = w; }
        s = wave_sum(s, lane);
        if (m < MP) { if (lane < 8) rss_ptr(F, 0)[(size_t)m * 8 + lane] = lane == 0 ? s : 0.f; } else { rss_sptr(F, 0)[(size_t)(m - MP) * 128 + lane] = lane == 0 ? s : 0.f; rss_sptr(F, 0)[(size_t)(m - MP) * 128 + 64 + lane] = 0.f; } }
}

__device__ __forceinline__ void sample_units_range(Frame& F, int nwg_main, int nsu, int& s0, int& sstep) {
    const int rem = nwg_main % F.G; const int c = opaque_bid();
    if (rem == 0) { s0 = c; sstep = F.G; } else if (c >= rem) { s0 = c - rem; sstep = F.G - rem; } else { s0 = nsu; sstep = 1; }
}
__device__ __forceinline__ void sample_in_ab(Frame& F, int i, const bf16_t* Wt, const float* rss) {
    MK_LAS float* red = (MK_LAS float*)F.lds; int s0, sstep; sample_units_range(F, 32 * (N_AB / 256), N_AB / 128, s0, sstep);
    const bf16_t* A = (const bf16_t*)(F.ws + WS_XB16) + (size_t)MP * D; float* zs = (float*)(F.ws + WS_ZS);
    for (int su = s0; su < N_AB / 128; su += sstep) {
        sgemm_tile<8>(red, A, Wt, D, 128 * su, F.wave, F.lane);
        const int lane = F.lane; const int row = F.tid >> 3, part = F.tid & 7, kind = su >> 3, cw = (su & 7) * 128 + 16 * part; const float rs = fast_rsq(rss_s(rss, row) * (1.0f / D) + EPS);
        float v[16]; float ss = 0.f;
#pragma unroll
        for (int j = 0; j < 16; ++j) { v[j] = sred4<8>(red, row, 16 * part + j) * rs; ss += v[j] * v[j]; }
        if (kind <= 1) { ss += SHX(ss, 1); ss += SHX(ss, 2); ss += SHX(ss, 4); const float hs = fast_rsq(ss * (1.0f / DH) + EPS); const float* gp = F.in[kind ? I_KN : I_QN] + i * DH + 16 * part;
#pragma unroll
            for (int j = 0; j < 16; ++j) v[j] = v[j] * hs * gp[j]; }
        float* zo = zs + (size_t)row * N_CD + 128 * su + 16 * part;
#pragma unroll
        for (int j = 0; j < 16; ++j) zo[j] = v[j];
        if (kind == 1 || kind == 2) { float* o = F.out + O_KVS + (((size_t)i * MS + row) * 2 + (kind - 1)) * WA + cw;
#pragma unroll
            for (int j = 0; j < 16; ++j) o[j] = v[j]; }
        if (kind == 3 && (row & 7) >= 5) { float* o = F.out + O_CONVS + (((size_t)i * SB + (row >> 3)) * 3 + ((row & 7) - 5)) * WB + cw;
#pragma unroll
            for (int j = 0; j < 16; ++j) o[j] = v[j]; }
        __syncthreads();
    }
}
__device__ __forceinline__ void sample_plain(Frame& F, const bf16_t* Wt, const float* rss, int N, int nwg_main, float* dst, int ldd, bool up_map) {
    MK_LAS float* red = (MK_LAS float*)F.lds; int s0, sstep; sample_units_range(F, nwg_main, N / 128, s0, sstep);
    const bf16_t* A = (const bf16_t*)(F.ws + WS_XB16) + (size_t)MP * D;
    for (int su = s0; su < N / 128; su += sstep) {
        sgemm_tile<8>(red, A, Wt, D, 128 * su, F.wave, F.lane);
        const int row = F.tid >> 3, part = F.tid & 7; const float rs = fast_rsq(rss_s(rss, row) * (1.0f / D) + EPS);
        const int col = up_map ? ((su & 1) * FF + (su >> 1) * 128) : 128 * su;
        float* o = dst + (size_t)row * ldd + col + 16 * part;
#pragma unroll
        for (int j = 0; j < 16; ++j) o[j] = sred4<8>(red, row, 16 * part + j) * rs;
        __syncthreads();
    }
}
__device__ __forceinline__ void sample_res(Frame& F, const bf16_t* A, const bf16_t* Wt, int K, const float* base, float* rss_next) {
    MK_LAS float* red = (MK_LAS float*)F.lds; int s0, sstep; sample_units_range(F, 256, D / 16, s0, sstep);
    float* xout = F.out + O_YS; bf16_t* xb = (bf16_t*)(F.ws + WS_XB16) + (size_t)MP * D;
    for (int su = s0; su < D / 16; su += sstep) {
        sgemm_tile<1>(red, A, Wt, K, 16 * su, F.wave, F.lane);
        const int lane = F.lane; const int row = F.tid >> 3, c2 = 2 * (F.tid & 7); const size_t o = (size_t)row * D + 16 * su + c2;
        const float v0 = base[o] + sred4<1>(red, row, c2), v1 = base[o + 1] + sred4<1>(red, row, c2 + 1);
        xout[o] = v0; xout[o + 1] = v1; *(unsigned*)(xb + o) = pk2(v0, v1);
        float ss = v0 * v0 + v1 * v1; ss += SHX(ss, 1); ss += SHX(ss, 2); ss += SHX(ss, 4);
        if ((F.tid & 7) == 0) rss_next[(size_t)row * 128 + su] = ss;
        __syncthreads();
    }
}

__device__ __forceinline__ void ffn_fixup(Frame& F, int layer) {
    const int gt = F.vcu * 512 + F.tid, NGT = F.G * 512;
    const float* cw = F.in[I_FCW] + (size_t)layer * 3 * FF; const float* cb = F.in[I_FCB] + (size_t)layer * FF;
    const float* ghead = (const float*)(F.ws + WS_GHEAD); const float* gtail = (const float*)(F.ws + WS_GTAIL); bf16_t* HBp = (bf16_t*)(F.ws + WS_Z);
    for (int it = gt; it < 30 * 2 * FF; it += NGT) { const int f = it % FF, r = (it / FF) & 1, ti = it / (2 * FF); const int pm = ti + 1 + (ti >= 15 ? 1 : 0);
        const float g0 = ghead[((size_t)pm * 2 + 0) * (2 * FF) + f], t0 = gtail[((size_t)(pm - 1) * 2 + 0) * FF + f], t1 = gtail[((size_t)(pm - 1) * 2 + 1) * FF + f];
        float gc, uu;
        if (r == 0) { gc = cb[f] + cw[f] * t0 + cw[FF + f] * t1 + cw[2 * FF + f] * g0; uu = ghead[((size_t)pm * 2 + 0) * (2 * FF) + FF + f]; }
        else { const float g1 = ghead[((size_t)pm * 2 + 1) * (2 * FF) + f]; gc = cb[f] + cw[f] * t1 + cw[FF + f] * g0 + cw[2 * FF + f] * g1; uu = ghead[((size_t)pm * 2 + 1) * (2 * FF) + FF + f]; }
        HBp[(size_t)(pm * 256 + r) * FF + f] = (bf16_t)f2bf(silu_f(gc) * uu); }
    const float* gus = (const float*)(F.ws + WS_GUS); const float* sbuf = F.in[I_SFF] + (size_t)layer * SB * 2 * FF;
    for (int it = gt; it < MS * FF; it += NGT) { const int f = it % FF, row = it / FF, t = row & 7, b = row >> 3;
        const float x0 = gus[(size_t)row * N_UP + f];
        const float x1 = (t >= 1) ? gus[(size_t)(row - 1) * N_UP + f] : sbuf[((size_t)b * 2 + 1) * FF + f];
        const float x2 = (t >= 2) ? gus[(size_t)(row - 2) * N_UP + f] : sbuf[((size_t)b * 2 + t) * FF + f];
        const float gc = cb[f] + cw[f] * x2 + cw[FF + f] * x1 + cw[2 * FF + f] * x0;
        HBp[(size_t)(MP + row) * FF + f] = (bf16_t)f2bf(silu_f(gc) * gus[(size_t)row * N_UP + FF + f]);
        if (t >= 6) F.out[O_FFS + (((size_t)layer * SB + b) * 2 + (t - 6)) * FF + f] = x0; }
}
}
namespace mk {
__device__ __forceinline__ s16x4 tr_read4(unsigned addr) { s16x4 r; asm volatile("ds_read_b64_tr_b16 %0, %1\n\ts_waitcnt lgkmcnt(0)" : "=&v"(r) : "v"(addr) : "memory"); return r; }

constexpr int ATT_VSTRIDE = 288;
__device__ __forceinline__ void attn_item(Frame& F, const bf16_t* Z, bf16_t* MIX, int item, MK_LAS unsigned char* vt) {
    const int lane = F.lane, qi = lane & 15, g = lane >> 4;
    const int rho = item & 15, blk = (item >> 4) & 15, h = (item >> 8) & 7, b = item >> 11;
    const int t0 = 256 * blk + rho, tq = t0 + 16 * qi;
    const bf16_t* Zb = Z + (size_t)b * SEQ * N_AB;
    bf16x8 qf[4];
#pragma unroll
    for (int s = 0; s < 4; ++s) qf[s] = *(const bf16x8*)(Zb + (size_t)tq * N_AB + h * DH + 32 * s + 8 * g);
    f32x4 o[8];
#pragma unroll
    for (int d = 0; d < 8; ++d) o[d] = (f32x4){0.f, 0.f, 0.f, 0.f};
    float mrun = -1e30f, lrun = 0.f;
    const float sc = 0.08838834764831845f * 1.44269504089f;
    const unsigned vbase = (unsigned)(size_t)vt;
    for (int st = 0; st < 23; ++st) {
        int base, dil, win;
        if (st < 12) { base = t0 - 128 + 32 * st; dil = 1; win = 128; } else if (st < 18) { base = t0 - 512 + 4 * 32 * (st - 12); dil = 4; win = 512; } else { base = t0 - 2048 + 16 * 32 * (st - 18); dil = 16; win = 2048; }
        bf16x8 kf[2][4];
#pragma unroll
        for (int kt = 0; kt < 2; ++kt) { int s = base + dil * (16 * kt + qi); s = s < 0 ? 0 : (s > SEQ - 1 ? SEQ - 1 : s); const bf16_t* kp = Zb + (size_t)s * N_AB + WA + h * DH + 8 * g;
#pragma unroll
            for (int q = 0; q < 4; ++q) kf[kt][q] = *(const bf16x8*)(kp + 32 * q); }
        u32x4 vv[8];
#pragma unroll
        for (int j = 0; j < 8; ++j) { const int c = lane + 64 * j, r = c >> 4, ch = c & 15; int s = base + dil * r; s = s < 0 ? 0 : (s > SEQ - 1 ? SEQ - 1 : s);
            vv[j] = *(const u32x4*)(Zb + (size_t)s * N_AB + 2 * WA + h * DH + 8 * ch); }
#pragma unroll
        for (int j = 0; j < 8; ++j) { const int c = lane + 64 * j, r = c >> 4, ch = c & 15; *(MK_LAS u32x4*)(vt + r * ATT_VSTRIDE + 16 * ch) = vv[j]; }
        f32x4 sv[2];
#pragma unroll
        for (int kt = 0; kt < 2; ++kt) { sv[kt] = (f32x4){0.f, 0.f, 0.f, 0.f};
#pragma unroll
            for (int q = 0; q < 4; ++q) sv[kt] = __builtin_amdgcn_mfma_f32_16x16x32_bf16(kf[kt][q], qf[q], sv[kt], 0, 0, 0); }
        float mx = -1e30f; bool val[2][4];
#pragma unroll
        for (int kt = 0; kt < 2; ++kt)
#pragma unroll
            for (int e = 0; e < 4; ++e) { const int s = base + dil * (16 * kt + 4 * g + e); const int dist = tq - s; val[kt][e] = (s >= 0) && (dist >= 0) && (dist <= win);
                sv[kt][e] = val[kt][e] ? sv[kt][e] * sc : -1e30f; mx = fmaxf(mx, sv[kt][e]); }
        mx = fmaxf(mx, SHX(mx, 16)); mx = fmaxf(mx, SHX(mx, 32));
        const float mnew = fmaxf(mrun, mx), alpha = fast_exp2(mrun - mnew); mrun = mnew;
        float ps = 0.f; float p[2][4];
#pragma unroll
        for (int kt = 0; kt < 2; ++kt)
#pragma unroll
            for (int e = 0; e < 4; ++e) { p[kt][e] = val[kt][e] ? fast_exp2(sv[kt][e] - mnew) : 0.f; ps += p[kt][e]; }
        lrun = lrun * alpha + ps;
        union { bf16x8 v; unsigned u[4]; } pf; pf.u[0] = cvt_pk_bf16(p[0][0], p[0][1]); pf.u[1] = cvt_pk_bf16(p[0][2], p[0][3]); pf.u[2] = cvt_pk_bf16(p[1][0], p[1][1]); pf.u[3] = cvt_pk_bf16(p[1][2], p[1][3]);
        LDS_WAIT();
        asm volatile("" ::: "memory");
        const int q4 = qi >> 2, p4 = qi & 3;
#pragma unroll
        for (int d = 0; d < 8; ++d) { const unsigned a0 = vbase + (4 * g + q4) * ATT_VSTRIDE + (16 * d + 4 * p4) * 2, a1 = a0 + 16 * ATT_VSTRIDE;
            union { bf16x8 v; s16x4 h[2]; } vf; vf.h[0] = tr_read4(a0); vf.h[1] = tr_read4(a1);
            o[d] = o[d] * alpha; o[d] = __builtin_amdgcn_mfma_f32_16x16x32_bf16(vf.v, pf.v, o[d], 0, 0, 0); }
        asm volatile("" ::: "memory");
    }
    lrun += SHX(lrun, 16); lrun += SHX(lrun, 32);
    const float inv = fast_rcp(lrun);
    bf16_t* op = MIX + ((size_t)b * SEQ + tq) * D + h * DH + 4 * g;
#pragma unroll
    for (int d = 0; d < 8; ++d) { u32x2 w; w.x = cvt_pk_bf16(o[d][0] * inv, o[d][1] * inv); w.y = cvt_pk_bf16(o[d][2] * inv, o[d][3] * inv); *(u32x2*)(op + 16 * d) = w; }
}

__device__ __forceinline__ void sattn_item(Frame& F, int i, int item) {
    const int lane = F.lane, li = lane & 15, g = lane >> 4; const int h = item & 7, t = (item >> 3) & 7, b = item >> 6; const int row = b * 8 + t;
    const float* zs = (const float*)(F.ws + WS_ZS); const float* cache = F.in[I_KV] + (size_t)(i * SB + b) * LA * 2 * WA; const float* kvn = F.out + O_KVS + (size_t)(i * SB + b) * ST * 2 * WA;
    float q[8]; { const f32x4 a = *(const f32x4*)(zs + (size_t)row * N_CD + h * DH + 8 * li), c = *(const f32x4*)(zs + (size_t)row * N_CD + h * DH + 8 * li + 4);
#pragma unroll
        for (int j = 0; j < 4; ++j) { q[j] = a[j]; q[4 + j] = c[j]; } }
    float m = -1e30f, l = 0.f, acc[8];
#pragma unroll
    for (int j = 0; j < 8; ++j) acc[j] = 0.f;
    const float sc = 0.08838834764831845f;
    for (int kk = g; kk < 3 * 129; kk += 4) { const int grp = kk / 129, j = kk - grp * 129; const int dil = grp == 0 ? 1 : (grp == 1 ? 4 : 16); const int idx = LA + t - dil * j;
        const float* kp = (idx < LA) ? cache + ((size_t)idx * 2) * WA + h * DH + 8 * li : kvn + ((size_t)(idx - LA) * 2) * WA + h * DH + 8 * li;
        const f32x4 k0 = *(const f32x4*)kp, k1 = *(const f32x4*)(kp + 4), v0 = *(const f32x4*)(kp + WA), v1 = *(const f32x4*)(kp + WA + 4);
        float s = (q[0] * k0[0] + q[1] * k0[1]) + (q[2] * k0[2] + q[3] * k0[3]) + (q[4] * k1[0] + q[5] * k1[1]) + (q[6] * k1[2] + q[7] * k1[3]);
        s += SHX(s, 1); s += SHX(s, 2); s += SHX(s, 4); s += SHX(s, 8); s *= sc;
        const float mn = fmaxf(m, s), al = fast_exp(m - mn), pw = fast_exp(s - mn); l = l * al + pw; m = mn;
#pragma unroll
        for (int jj = 0; jj < 4; ++jj) { acc[jj] = acc[jj] * al + pw * v0[jj]; acc[4 + jj] = acc[4 + jj] * al + pw * v1[jj]; } }
    float mm = fmaxf(m, SHX(m, 16)); mm = fmaxf(mm, SHX(mm, 32)); const float f = fast_exp(m - mm); l *= f; l += SHX(l, 16); l += SHX(l, 32);
#pragma unroll
    for (int j = 0; j < 8; ++j) { acc[j] *= f; acc[j] += SHX(acc[j], 16); acc[j] += SHX(acc[j], 32); }
    if (g == 0) { const float inv = fast_rcp(l); u32x4 w; w.x = pk2(acc[0] * inv, acc[1] * inv); w.y = pk2(acc[2] * inv, acc[3] * inv); w.z = pk2(acc[4] * inv, acc[5] * inv); w.w = pk2(acc[6] * inv, acc[7] * inv);
        *(u32x4*)((bf16_t*)(F.ws + WS_MIX) + (size_t)(MP + row) * D + h * DH + 8 * li) = w; }
}

__device__ __forceinline__ void lru_unit(Frame& F, int i, int unit, const bf16_t* Z, bf16_t* MIX) {
    const int b = unit >> 3, hB = unit & 7; const int tid = F.tid, lane = F.lane, w = F.wave, fr = lane & 15, g = lane >> 4;
    MK_LAS float* xc = (MK_LAS float*)F.lds; constexpr int LDX = 132;
    const int ch0 = hB * 128; const int c = ch0 + 16 * w + fr;
    const bf16_t* Wl = (const bf16_t*)(F.ws + WS_WLRU) + (size_t)((i * 8 + hB) * 2) * 128 * 128;
    bf16x8 wf[2][4];
#pragma unroll
    for (int gt = 0; gt < 2; ++gt)
#pragma unroll
        for (int s = 0; s < 4; ++s) wf[gt][s] = *(const bf16x8*)(Wl + ((size_t)gt * 128 + 16 * w + fr) * 128 + 32 * s + 8 * g);
    const float ba = F.in[I_LBA][i * WB + c], bx = F.in[I_LBX][i * WB + c]; const float lam = F.in[I_LLAM][i * WB + c];
    const float dk = -8.0f * softplus_acc(-lam);
    const int sc8 = 8 * (tid & 15), stl = tid >> 4;
    float cwv[4][8], cbv[8];
#pragma unroll
    for (int j = 0; j < 8; ++j) { cbv[j] = F.in[I_LCB][i * WB + ch0 + sc8 + j];
#pragma unroll
        for (int tp = 0; tp < 4; ++tp) cwv[tp][j] = F.in[I_LCW][((size_t)i * 4 + tp) * WB + ch0 + sc8 + j]; }
    float hcar = 0.f;
    const bf16_t* Zb = Z + (size_t)b * SEQ * N_AB;
    for (int ck = 0; ck < SEQ / 128; ++ck) { const int tb = 128 * ck;
#pragma unroll
        for (int ps = 0; ps < 4; ++ps) { const int tl = stl + 32 * ps, t = tb + tl; float a[8];
#pragma unroll
            for (int j = 0; j < 8; ++j) a[j] = cbv[j];
#pragma unroll
            for (int tp = 0; tp < 4; ++tp) { const int tt = t - 3 + tp; if (tt >= 0) { const u32x4 v = *(const u32x4*)(Zb + (size_t)tt * N_AB + 3 * WA + ch0 + sc8);
                    a[0] += cwv[tp][0] * bflo(v.x); a[1] += cwv[tp][1] * bfhi(v.x); a[2] += cwv[tp][2] * bflo(v.y); a[3] += cwv[tp][3] * bfhi(v.y);
                    a[4] += cwv[tp][4] * bflo(v.z); a[5] += cwv[tp][5] * bfhi(v.z); a[6] += cwv[tp][6] * bflo(v.w); a[7] += cwv[tp][7] * bfhi(v.w); } }
            *(MK_LAS f32x4*)(xc + tl * LDX + sc8) = (f32x4){a[0], a[1], a[2], a[3]}; *(MK_LAS f32x4*)(xc + tl * LDX + sc8 + 4) = (f32x4){a[4], a[5], a[6], a[7]}; }
        LDS_WAIT(); __syncthreads();
#pragma unroll 1
        for (int mt = 0; mt < 8; ++mt) {
            f32x4 cr = (f32x4){0.f, 0.f, 0.f, 0.f}, ci = (f32x4){0.f, 0.f, 0.f, 0.f};
#pragma unroll
            for (int s = 0; s < 4; ++s) { const MK_LAS float* xp = xc + (16 * mt + fr) * LDX + 32 * s + 8 * g; const f32x4 x0 = *(const MK_LAS f32x4*)xp, x1 = *(const MK_LAS f32x4*)(xp + 4);
                union { bf16x8 v; unsigned u[4]; } af; af.u[0] = cvt_pk_bf16(x0[0], x0[1]); af.u[1] = cvt_pk_bf16(x0[2], x0[3]); af.u[2] = cvt_pk_bf16(x1[0], x1[1]); af.u[3] = cvt_pk_bf16(x1[2], x1[3]);
                cr = __builtin_amdgcn_mfma_f32_16x16x32_bf16(af.v, wf[0][s], cr, 0, 0, 0); ci = __builtin_amdgcn_mfma_f32_16x16x32_bf16(af.v, wf[1][s], ci, 0, 0, 0); }
            float P[4], H[4]; float pa = 1.f, hh = 0.f;
#pragma unroll
            for (int e = 0; e < 4; ++e) { const float r = sigmoid_f(cr[e] + ba), ig = sigmoid_f(ci[e] + bx); const float la = dk * r; const float a = fast_exp(la);
                const float xv = xc[(16 * mt + 4 * g + e) * LDX + 16 * w + fr]; const float u = fast_sqrt(one_minus_exp(2.0f * la)) * ig * xv;
                pa = pa * a; hh = a * hh + u; P[e] = pa; H[e] = hh; }
            float ip = pa, ih = hh;
            { const float pp = SHUP(ip, 16), ph = SHUP(ih, 16); if (g >= 1) { ih = ip * ph + ih; ip = ip * pp; } }
            { const float pp = SHUP(ip, 32), ph = SHUP(ih, 32); if (g >= 2) { ih = ip * ph + ih; ip = ip * pp; } }
            float ep = SHUP(ip, 16), eh = SHUP(ih, 16); if (g == 0) { ep = 1.f; eh = 0.f; }
            const float hin = ep * hcar + eh;
            const float tot_p = SHL(ip, 48 + fr), tot_h = SHL(ih, 48 + fr);
            hcar = tot_p * hcar + tot_h;
#pragma unroll
            for (int e = 0; e < 4; ++e) { const float hv = P[e] * hin + H[e]; const size_t row = (size_t)b * SEQ + tb + 16 * mt + 4 * g + e;
                const float gb = bf2f(Zb[(size_t)(tb + 16 * mt + 4 * g + e) * N_AB + 3 * WA + WB + c]);
                MIX[row * D + WA + c] = (bf16_t)f2bf(hv * gelu_tanh_f(gb)); }
        }
        __syncthreads();
    }
    if (g == 0) F.out[O_HP + ((size_t)i * NB + b) * WB + c] = hcar;
}

__device__ __forceinline__ void slru_unit(Frame& F, int i, int unit) {
    const int b = unit >> 3, hB = unit & 7, tid = F.tid; const float* zs = (const float*)(F.ws + WS_ZS);
    MK_LAS float* xc = (MK_LAS float*)F.lds;
    MK_LAS float* gr = xc + 1024;
    MK_LAS float* gi = gr + 1024;
    const int ch0 = hB * 128;
    for (int e = tid; e < 1024; e += 512) { const int cc = e & 127, t = e >> 7; const int c = ch0 + cc; float y = F.in[I_LCB][i * WB + c];
#pragma unroll
        for (int tp = 0; tp < 4; ++tp) { const int tt = t - 3 + tp; const float v = (tt >= 0) ? zs[(size_t)(b * 8 + tt) * N_CD + 3 * WA + c] : F.in[I_SCONV][(((size_t)i * SB + b) * 3 + (tt + 3)) * WB + c];
            y += F.in[I_LCW][((size_t)i * 4 + tp) * WB + c] * v; }
        xc[t * 128 + cc] = y; }
    __syncthreads();
    for (int e = tid; e < 2048; e += 512) { const int cc = e & 127, t = (e >> 7) & 7, gate = e >> 10; const float* W = F.in[gate ? I_LWX : I_LWA] + (size_t)(i * 8 + hB) * 128 * 128; float s = 0.f;
        for (int k = 0; k < 128; ++k) s += xc[t * 128 + k] * W[(size_t)k * 128 + cc];
        const int c = ch0 + cc; s += F.in[gate ? I_LBX : I_LBA][i * WB + c]; (gate ? gi : gr)[t * 128 + cc] = sigmoid_f(s); }
    __syncthreads();
    if (tid < 128) { const int cc = tid, c = ch0 + cc; const float lam = F.in[I_LLAM][i * WB + c]; const float spl = softplus_acc(-lam);
        float h = F.in[I_SH][((size_t)i * SB + b) * WB + c];
        for (int t = 0; t < 8; ++t) { const float la = -8.0f * gr[t * 128 + cc] * spl, a = fast_exp(la); const float u = fast_sqrt(one_minus_exp(2.0f * la)) * gi[t * 128 + cc] * xc[t * 128 + cc];
            h = a * h + u; const float gb = zs[(size_t)(b * 8 + t) * N_CD + 3 * WA + WB + c];
            const float ge = gelu_tanh_f(gb);
            ((bf16_t*)(F.ws + WS_MIX))[(size_t)(MP + b * 8 + t) * D + WA + c] = (bf16_t)f2bf(h * ge); }
        F.out[O_HS + ((size_t)i * SB + b) * WB + c] = h; }
    __syncthreads();
}

__device__ __forceinline__ void mixer_ab(Frame& F, int i, int qid) {
    const bf16_t* Z = (const bf16_t*)(F.ws + WS_Z); bf16_t* MIX = (bf16_t*)(F.ws + WS_MIX);
    constexpr int N_LRU = 16, N_SLRU = 64, N_SATT = 64, N_ATT = 512, N_ALL = N_LRU + N_SLRU + N_SATT + N_ATT;
    for (;;) { const int u = q_next(F, qid); if (u >= N_ALL) break;
        if (u < N_LRU) lru_unit(F, i, u, Z, MIX);
        else if (u < N_LRU + N_SLRU) slru_unit(F, i, u - N_LRU);
        else if (u < N_LRU + N_SLRU + N_SATT) sattn_item(F, i, (u - N_LRU - N_SLRU) * 8 + F.wave);
        else attn_item(F, Z, MIX, (u - N_LRU - N_SLRU - N_SATT) * 8 + F.wave, F.lds + F.wave * (32 * ATT_VSTRIDE)); }
}
}
namespace mk {
struct GlaCfg { int H, V, qcol, kcol, vcol, gcol, lgld, mixcol; const float* lg; const float* gain; bf16_t* sc; };
__device__ __forceinline__ GlaCfg gla_cfg(Frame& F, int i, int kind) {
    GlaCfg c;
    if (kind == 0) { c.H = HC; c.V = DVC; c.qcol = ZC_QC; c.kcol = ZC_KC; c.vcol = ZC_IC; c.gcol = ZC_GC; c.lgld = 1024; c.mixcol = 0; c.lg = (const float*)(F.ws + WS_LG); c.gain = F.in[I_HGN] + i * DVC; c.sc = (bf16_t*)(F.ws + WS_SC); }
    else { c.H = HD_; c.V = DVD; c.qcol = ZC_QD; c.kcol = ZC_KD; c.vcol = ZC_VD; c.gcol = ZC_RD; c.lgld = 512; c.mixcol = 1024; c.lg = (const float*)(F.ws + WS_LG) + (size_t)MP * 1024; c.gain = F.in[I_GLN] + i * DVD; c.sc = (bf16_t*)(F.ws + WS_SC) + (size_t)NB * HC * NCHUNK * DVC * 128; }
    return c;
}
__device__ __forceinline__ void x2_unit(Frame& F, int i, int unit) {
    const int kind = unit >> 7; const int u = unit & 127; const GlaCfg c = gla_cfg(F, i, kind);
    const int nvs = c.V / 16; const int vs = u % nvs, hd = (u / nvs) % c.H, b = u / (nvs * c.H);
    const int lane = F.lane, w = F.wave, fr = lane & 15, g = lane >> 4;
    const bf16_t* Z = (const bf16_t*)(F.ws + WS_Z) + (size_t)b * SEQ * N_CDZ; const float* LG = c.lg + (size_t)b * SEQ * c.lgld + hd * 128 + 16 * w + fr;
    const bf16_t* Kp = Z + c.kcol + hd * 128 + 16 * w + fr; const bf16_t* Vp = Z + c.vcol + hd * c.V + 16 * vs + fr;
    bf16_t* SCp = c.sc + ((size_t)(b * c.H + hd) * NCHUNK) * c.V * 128 + (size_t)(16 * vs + fr) * 128 + 16 * w + 4 * g;
    f32x4 S = (f32x4){0.f, 0.f, 0.f, 0.f};
    float nlg[2][8]; unsigned short nkv[2][8], nvv[2][8];
#pragma unroll
    for (int ks = 0; ks < 2; ++ks)
#pragma unroll
        for (int j = 0; j < 8; ++j) { const size_t t = 32 * ks + 8 * g + j; nlg[ks][j] = LG[t * c.lgld]; nkv[ks][j] = Kp[t * N_CDZ]; nvv[ks][j] = Vp[t * N_CDZ]; }
#pragma unroll 1
    for (int ck = 0; ck < NCHUNK; ++ck) {
        float lg[2][8]; unsigned short kv[2][8], vv[2][8];
#pragma unroll
        for (int ks = 0; ks < 2; ++ks)
#pragma unroll
            for (int j = 0; j < 8; ++j) { lg[ks][j] = nlg[ks][j]; kv[ks][j] = nkv[ks][j]; vv[ks][j] = nvv[ks][j]; }
        if (ck + 1 < NCHUNK) { const size_t t0 = 64 * (ck + 1) + 8 * g;
            auto pl = launder(LG + t0 * c.lgld); auto pk = launder(Kp + t0 * N_CDZ); auto pv = launder(Vp + t0 * N_CDZ);
#pragma unroll
            for (int ks = 0; ks < 2; ++ks) {
#pragma unroll
                for (int j = 0; j < 8; ++j) { nlg[ks][j] = pl[(size_t)j * c.lgld]; nkv[ks][j] = pk[(size_t)j * N_CDZ]; nvv[ks][j] = pv[(size_t)j * N_CDZ]; }
                pl = launder(pl + (size_t)32 * c.lgld); pk = launder(pk + (size_t)32 * N_CDZ); pv = launder(pv + (size_t)32 * N_CDZ); } }
        { u32x2 wv; wv.x = cvt_pk_bf16(S[0], S[1]); wv.y = cvt_pk_bf16(S[2], S[3]); *(u32x2*)(SCp + (size_t)ck * c.V * 128) = wv; }
        float tot[2];
#pragma unroll
        for (int ks = 0; ks < 2; ++ks) {
#pragma unroll
            for (int j = 1; j < 8; ++j) lg[ks][j] += lg[ks][j - 1];
            float inc = lg[ks][7];
            { const float p = SHUP(inc, 16); if (g >= 1) inc += p; }
            { const float p = SHUP(inc, 32); if (g >= 2) inc += p; }
            float ex = SHUP(inc, 16); if (g == 0) ex = 0.f;
            tot[ks] = SHL(inc, 48 + fr);
#pragma unroll
            for (int j = 0; j < 8; ++j) lg[ks][j] += ex + (ks ? tot[0] : 0.f);
        }
        const float blast = tot[0] + tot[1];
        union { bf16x8 v; unsigned u[4]; } af[2], bf[2];
#pragma unroll
        for (int ks = 0; ks < 2; ++ks) { float kd[8];
#pragma unroll
            for (int j = 0; j < 8; ++j) kd[j] = bf2f(kv[ks][j]) * fast_exp(blast - lg[ks][j]);
#pragma unroll
            for (int j = 0; j < 4; ++j) { af[ks].u[j] = cvt_pk_bf16(kd[2 * j], kd[2 * j + 1]); bf[ks].u[j] = (unsigned)vv[ks][2 * j] | ((unsigned)vv[ks][2 * j + 1] << 16); } }
#pragma unroll
        for (int e = 0; e < 4; ++e) S[e] *= fast_exp(SHL(blast, 4 * g + e));
        S = __builtin_amdgcn_mfma_f32_16x16x32_bf16(af[0].v, bf[0].v, S, 0, 0, 0);
        S = __builtin_amdgcn_mfma_f32_16x16x32_bf16(af[1].v, bf[1].v, S, 0, 0, 0);
    }
    float* so = F.out + (kind == 0 ? O_HGP : O_GLP) + (((size_t)i * NB + b) * c.H + hd) * 128 * c.V + (size_t)(16 * w + 4 * g) * c.V + 16 * vs + fr;
#pragma unroll
    for (int e = 0; e < 4; ++e) so[(size_t)e * c.V] = S[e];
}

template <int V> __device__ __forceinline__ void scd_unit_t(Frame& F, int i, int kind, int b, int hd) {
    constexpr int KQ = 512 / V, KN = 128 / KQ;
    const int tid = F.tid; const float* zs = (const float*)(F.ws + WS_ZS);
    MK_LAS float* sq = (MK_LAS float*)F.lds;
    MK_LAS float* sk = sq + 1024;
    MK_LAS float* sl = sk + 1024;
    MK_LAS float* sv = sl + 1024;
    MK_LAS float* po = sv + 8 * V;
    MK_LAS float* rsd = po + KQ * 8 * V;
    const float* lb = (const float*)(F.ws + WS_LB) + i * 1024;
    for (int e = tid; e < 1024; e += 512) { const int k = e & 127, t = e >> 7; const float* zr = zs + (size_t)(b * 8 + t) * N_CD;
        if (kind == 0) { const float z = zr[ZC_KC + hd * 128 + k], l = lb[hd * 128 + k]; const float sg = sigmoid_f(z); sq[e] = zr[ZC_QC + hd * 128 + k]; sk[e] = (1.0f - l) * (1.0f - sg); sl[e] = l + (1.0f - l) * sg; }
        else { const float x = zr[N_CDZ + hd * 128 + k] + F.in[I_BG][i * 512 + hd * 128 + k]; const float ls = fminf(x, 0.f) - fast_ln(1.0f + fast_exp(-fabsf(x))); sq[e] = zr[ZC_QD + hd * 128 + k] * 0.08838834764831845f; sk[e] = zr[ZC_KD + hd * 128 + k]; sl[e] = fast_exp(ls * 0.0625f); } }
    for (int e = tid; e < 8 * V; e += 512) { const int v = e % V, t = e / V; sv[e] = zs[(size_t)(b * 8 + t) * N_CD + (kind == 0 ? ZC_IC : ZC_VD) + hd * V + v]; }
    __syncthreads();
    const int v = tid % V, kq = tid / V; const float* s0 = F.in[kind == 0 ? I_SHG : I_SGL] + ((((size_t)i * SB + b) * (kind == 0 ? HC : HD_) + hd) * 128) * V;
    float S[KN];
    { auto sp = launder(s0 + (size_t)(kq * KN) * V + v);
#pragma unroll
      for (int kk = 0; kk < KN; ++kk) { S[kk] = *sp; sp = launder(sp + V); } }
    for (int t = 0; t < 8; ++t) { const float vt = sv[t * V + v]; float acc = 0.f;
#pragma unroll
        for (int kk = 0; kk < KN; ++kk) { const int k = kq * KN + kk; S[kk] = sl[t * 128 + k] * S[kk] + sk[t * 128 + k] * vt; acc += sq[t * 128 + k] * S[kk]; }
        po[(kq * 8 + t) * V + v] = acc; }
    float* so = F.out + (kind == 0 ? O_HGS : O_GLS) + ((((size_t)i * SB + b) * (kind == 0 ? HC : HD_) + hd) * 128) * V;
    { auto sp = launder(so + (size_t)(kq * KN) * V + v);
#pragma unroll
      for (int kk = 0; kk < KN; ++kk) { *sp = S[kk]; sp = launder(sp + V); } }
    __syncthreads();
    for (int e = tid; e < 8 * V; e += 512) { float a = 0.f;
#pragma unroll
        for (int q = 0; q < KQ; ++q) a += po[q * 8 * V + e];
        po[e] = a; }
    __syncthreads();
    if (tid < 8) { float s = 0.f; for (int vv = 0; vv < V; ++vv) s += po[tid * V + vv] * po[tid * V + vv]; rsd[tid] = fast_rsq(s * (1.0f / V) + EPS); }
    __syncthreads();
    const float* gain = F.in[kind == 0 ? I_HGN : I_GLN] + i * V;
    for (int e = tid; e < 8 * V; e += 512) { const int vv = e % V, t = e / V; const float gt = zs[(size_t)(b * 8 + t) * N_CD + (kind == 0 ? ZC_GC : ZC_RD) + hd * V + vv];
        const float y = po[e] * rsd[t] * gain[vv] * silu_f(gt);
        ((bf16_t*)(F.ws + WS_MIX))[(size_t)(MP + b * 8 + t) * D + (kind == 0 ? 0 : 1024) + hd * V + vv] = (bf16_t)f2bf(y); }
    __syncthreads();
}
__device__ __forceinline__ void scd_unit(Frame& F, int i, int unit) {
    if (unit < 64) scd_unit_t<DVC>(F, i, 0, unit >> 3, unit & 7); else { const int u = unit - 64; scd_unit_t<DVD>(F, i, 1, u >> 2, u & 3); }
}

template <int V> __device__ __forceinline__ void x3_unit_t(Frame& F, const GlaCfg& c, int b, int hd, int ck) {
    constexpr int LDQ = 272, LDV = 2 * V + 32, LDA = 144;
    constexpr int NT = V / 32;
    MK_LAS unsigned char* QE = F.lds; MK_LAS unsigned char* QH = QE + 64 * LDQ; MK_LAS unsigned char* KH = QH + 64 * LDQ; MK_LAS unsigned char* VT = KH + 64 * LDQ;
    MK_LAS unsigned char* AM = VT + 64 * LDV; MK_LAS float* QT = (MK_LAS float*)(AM + 64 * LDA);
    MK_LAS float* SS = QT + 512;
    const int tid = F.tid, lane = F.lane, w = F.wave, fr = lane & 15, g = lane >> 4; const int tb = 64 * ck;
    const bf16_t* Z = (const bf16_t*)(F.ws + WS_Z) + ((size_t)b * SEQ + tb) * N_CDZ; const float* LG = c.lg + ((size_t)b * SEQ + tb) * c.lgld + hd * 128;
    { const int ch = tid & 127, tq = tid >> 7; float cum[16]; float run = 0.f;
        { auto pl = launder(LG + (size_t)(16 * tq) * c.lgld + ch);
#pragma unroll
          for (int j = 0; j < 16; ++j) { run += *pl; cum[j] = run; pl = launder(pl + c.lgld); } }
        QT[tq * 128 + ch] = run;
        unsigned short qv[16], kv[16];
        { auto pq = launder(Z + (size_t)(16 * tq) * N_CDZ + c.qcol + hd * 128 + ch); const int kdelta = c.kcol - c.qcol;
#pragma unroll
          for (int j = 0; j < 16; ++j) { qv[j] = pq[0]; kv[j] = pq[kdelta]; pq = launder(pq + N_CDZ); } }
        LDS_WAIT(); __syncthreads();
        const float q0 = QT[ch], q1 = QT[128 + ch], q2 = QT[256 + ch]; const float off = tq == 0 ? 0.f : (tq == 1 ? q0 : (tq == 2 ? q0 + q1 : q0 + q1 + q2)); const float bmid = q0 + q1;
#pragma unroll
        for (int j = 0; j < 16; ++j) { const float bb = cum[j] + off; const float qf = bf2f(qv[j]), kf = bf2f(kv[j]); const int t = 16 * tq + j;
            *(MK_LAS unsigned short*)(QE + t * LDQ + 2 * ch) = (unsigned short)f2bf(qf * fast_exp(bb));
            *(MK_LAS unsigned short*)(QH + t * LDQ + 2 * ch) = (unsigned short)f2bf(qf * fast_exp(fminf(bb - bmid, 80.f)));
            *(MK_LAS unsigned short*)(KH + t * LDQ + 2 * ch) = (unsigned short)f2bf(kf * fast_exp(fminf(bmid - bb, 80.f))); }
        constexpr int CPR = V / 8;
        for (int e = tid; e < 64 * CPR; e += 512) { const int t = e / CPR, chk = e % CPR; *(MK_LAS u32x4*)(VT + t * LDV + 16 * chk) = *(const u32x4*)(Z + (size_t)t * N_CDZ + c.vcol + hd * V + 8 * chk); }
    }
    LDS_WAIT(); __syncthreads();
    { const int ti = w >> 1;
#pragma unroll
        for (int jj = 0; jj < 2; ++jj) { const int sj = 2 * (w & 1) + jj; f32x4 a = (f32x4){0.f, 0.f, 0.f, 0.f};
            if (sj <= ti) {
#pragma unroll
                for (int ks = 0; ks < 4; ++ks) { const bf16x8 qa = *(const MK_LAS bf16x8*)(QH + (16 * ti + fr) * LDQ + 64 * ks + 16 * g), kb = *(const MK_LAS bf16x8*)(KH + (16 * sj + fr) * LDQ + 64 * ks + 16 * g);
                    a = __builtin_amdgcn_mfma_f32_16x16x32_bf16(qa, kb, a, 0, 0, 0); } }
#pragma unroll
            for (int e = 0; e < 4; ++e) { const int t = 16 * ti + 4 * g + e, s = 16 * sj + fr; *(MK_LAS unsigned short*)(AM + t * LDA + 2 * s) = (unsigned short)f2bf(s <= t ? a[e] : 0.f); } } }
    LDS_WAIT(); __syncthreads();
    const int mt = w & 3, vh = w >> 2; f32x4 o[NT];
#pragma unroll
    for (int n = 0; n < NT; ++n) o[n] = (f32x4){0.f, 0.f, 0.f, 0.f};
    const unsigned vtb = (unsigned)(size_t)VT; const int q4 = fr >> 2, p4 = fr & 3;
#pragma unroll
    for (int ks = 0; ks < 2; ++ks) { if (32 * ks <= 16 * mt + 15) { const bf16x8 aa = *(const MK_LAS bf16x8*)(AM + (16 * mt + fr) * LDA + 64 * ks + 16 * g);
#pragma unroll
            for (int n = 0; n < NT; ++n) { const int vc = (V / 2) * vh + 16 * n; const unsigned a0 = vtb + (32 * ks + 8 * g + q4) * LDV + (vc + 4 * p4) * 2, a1 = a0 + 4 * LDV;
                union { bf16x8 v; s16x4 h[2]; } vf; vf.h[0] = tr_read4(a0); vf.h[1] = tr_read4(a1);
                o[n] = __builtin_amdgcn_mfma_f32_16x16x32_bf16(aa, vf.v, o[n], 0, 0, 0); } } }
    { const bf16_t* SCp = c.sc + (((size_t)(b * c.H + hd) * NCHUNK + ck) * V) * 128;
#pragma unroll
        for (int ks = 0; ks < 4; ++ks) { const bf16x8 qa = *(const MK_LAS bf16x8*)(QE + (16 * mt + fr) * LDQ + 64 * ks + 16 * g);
#pragma unroll
            for (int n = 0; n < NT; ++n) { const int vc = (V / 2) * vh + 16 * n + fr; const bf16x8 sb = *(const bf16x8*)(SCp + (size_t)vc * 128 + 32 * ks + 8 * g);
                o[n] = __builtin_amdgcn_mfma_f32_16x16x32_bf16(qa, sb, o[n], 0, 0, 0); } } }
    float ss[4];
#pragma unroll
    for (int e = 0; e < 4; ++e) { float s = 0.f;
#pragma unroll
        for (int n = 0; n < NT; ++n) s += o[n][e] * o[n][e];
        s += SHX(s, 1); s += SHX(s, 2); s += SHX(s, 4); s += SHX(s, 8); ss[e] = s; }
    if (fr == 0) {
#pragma unroll
        for (int e = 0; e < 4; ++e) SS[vh * 64 + 16 * mt + 4 * g + e] = ss[e]; }
    LDS_WAIT(); __syncthreads();
    bf16_t* MIX = (bf16_t*)(F.ws + WS_MIX) + ((size_t)b * SEQ + tb) * D + c.mixcol + hd * V;
#pragma unroll
    for (int e = 0; e < 4; ++e) { const int t = 16 * mt + 4 * g + e; const float rs = fast_rsq((SS[t] + SS[64 + t]) * (1.0f / V) + EPS);
#pragma unroll
        for (int n = 0; n < NT; ++n) { const int vc = (V / 2) * vh + 16 * n + fr; const float gt = bf2f(Z[(size_t)t * N_CDZ + c.gcol + hd * V + vc]);
            MIX[(size_t)t * D + vc] = (bf16_t)f2bf(o[n][e] * rs * c.gain[vc] * silu_f(gt)); } }
    __syncthreads();
}
__device__ __forceinline__ void x3_unit(Frame& F, int i, int unit) {
    if (unit < NB * HC * NCHUNK) { const GlaCfg c = gla_cfg(F, i, 0); x3_unit_t<DVC>(F, c, unit / (HC * NCHUNK), (unit / NCHUNK) % HC, unit % NCHUNK); }
    else { const int u = unit - NB * HC * NCHUNK; const GlaCfg c = gla_cfg(F, i, 1); x3_unit_t<DVD>(F, c, u / (HD_ * NCHUNK), (u / NCHUNK) % HD_, u % NCHUNK); }
}
__device__ __forceinline__ void mixer_cd_x2(Frame& F, int i, int qid) {
    for (;;) { const int u = q_next(F, qid); if (u >= 256 + 96) break; if (u < 256) x2_unit(F, i, u); else scd_unit(F, i, u - 256); }
}
__device__ __forceinline__ void mixer_cd_x3(Frame& F, int i, int qid) {
    constexpr int NU = NB * HC * NCHUNK + NB * HD_ * NCHUNK;
    for (;;) { const int u = q_next(F, qid); if (u >= NU) break; x3_unit(F, i, u); }
}
}
namespace mk {
#define PHASE_FRAME(Fp) Frame Fp = F0; asm volatile("" : "+s"(Fp.wave)); Fp.tid = opaque_tid(Fp.wave); Fp.lane = Fp.tid & 63
__device__ __forceinline__ void ffn_part(Frame& F0, const XcdBarrier& bar, int layer) {
    { PHASE_FRAME(F); Gemm g{(const bf16_t*)(F.ws + WS_XB16), (const bf16_t*)(F.ws + WS_WUP + layer * SZ_WUP), MP, N_UP, D}; StaticOrder S; S.init(MP, N_UP, F.G, opaque_bid());
      EpiUp E{(bf16_t*)(F.ws + WS_Z), rss_ptr(F, 2 * layer + 1), F.in[I_FCW] + (size_t)layer * 3 * FF, F.in[I_FCB] + (size_t)layer * FF, (float*)(F.ws + WS_GHEAD), (float*)(F.ws + WS_GTAIL), F.out + O_FFP + (size_t)layer * NB * 2 * FF};
      gemm_phase<EpiUp>(F.lds, g, S, E, F.wave);
      sample_plain(F, g.Bt, rss_sptr(F, 2 * layer + 1), N_UP, 32 * (N_UP / 256), (float*)(F.ws + WS_GUS), N_UP, true); }
    xcd_barrier(bar, F0.wave);
    { PHASE_FRAME(F); ffn_fixup(F, layer); }
    xcd_barrier(bar, F0.wave);
    { PHASE_FRAME(F); Gemm g{(const bf16_t*)(F.ws + WS_Z), (const bf16_t*)(F.ws + WS_WDN + layer * SZ_WDN), MP, D, FF}; StaticOrder S; S.init(MP, D, F.G, opaque_bid());
      EpiRes E{F.out + O_YP, F.out + O_YP, (bf16_t*)(F.ws + WS_XB16), rss_ptr(F, 2 * layer + 2)};
      gemm_phase<EpiRes>(F.lds, g, S, E, F.wave);
      sample_res(F, (const bf16_t*)(F.ws + WS_Z) + (size_t)MP * FF, g.Bt, FF, F.out + O_YS, rss_sptr(F, 2 * layer + 2)); }
    xcd_barrier(bar, F0.wave);
}
__device__ __forceinline__ void out_part(Frame& F0, const XcdBarrier& bar, int layer, const bf16_t* Wt) {
    PHASE_FRAME(F);
    Gemm g{(const bf16_t*)(F.ws + WS_MIX), Wt, MP, D, D}; StaticOrder S; S.init(MP, D, F.G, opaque_bid());
    const float* baseP = layer == 0 ? F.in[I_XP] : F.out + O_YP; const float* baseS = layer == 0 ? F.in[I_XS] : F.out + O_YS;
    EpiRes E{baseP, F.out + O_YP, (bf16_t*)(F.ws + WS_XB16), rss_ptr(F, 2 * layer + 1)};
    gemm_phase<EpiRes>(F.lds, g, S, E, F.wave);
    sample_res(F, (const bf16_t*)(F.ws + WS_MIX) + (size_t)MP * D, Wt, D, baseS, rss_sptr(F, 2 * layer + 1));
    xcd_barrier(bar, F0.wave);
}

__global__ void __launch_bounds__(512, 2) mega_fwd(Args args) {
    extern __shared__ __attribute__((aligned(16))) unsigned char lds_raw[];
    Frame F0; Frame& F = F0; F.lds = (MK_LAS unsigned char*)lds_raw; F.ws = args.ws; F.out = args.out; F.in = args.in; F.ctl = (unsigned*)(args.ws + WS_CTL);
    F.wave = __builtin_amdgcn_readfirstlane((int)threadIdx.x >> 6); asm volatile("" : "+s"(F.wave));
    F.tid = opaque_tid(F.wave); F.lane = F.tid & 63;
    F.G = gridDim.x; { const int bx = opaque_bid(); F.vcu = (F.G % 8 == 0) ? (bx % 8) * (F.G / 8) + bx / 8 : bx; }
    for (int u = F.tid; u < (LDS_BYTES - MISC_OFF) / 4; u += 512) ((MK_LAS unsigned*)(F.lds + MISC_OFF))[u] = 0u;
    __syncthreads();
    const XcdBarrier bar = xcd_barrier_post(F.ctl + CW_BAR, (volatile MK_LAS unsigned*)(F.lds + MISC_OFF), F0.wave);
    p0_prologue(F);
    xcd_barrier(bar, F0.wave);
    const int nl = args.nlayers;
    for (int lp = 0; lp < 2; ++lp) {
        { const int layer = 2 * lp, i = lp; if (layer >= nl) break;
          { PHASE_FRAME(F); Gemm g{(const bf16_t*)(F.ws + WS_XB16), (const bf16_t*)(F.ws + WS_WINAB + i * SZ_WINAB), MP, N_AB, D}; StaticOrder S; S.init(MP, N_AB, F.G, opaque_bid());
            EpiInAB E{(bf16_t*)(F.ws + WS_Z), rss_ptr(F, 2 * layer), F.in[I_QN] + i * DH, F.in[I_KN] + i * DH, F.out + O_KVP + (size_t)i * NB * LA * 2 * WA, F.out + O_CONVP + (size_t)i * NB * 3 * WB};
            gemm_phase<EpiInAB>(F.lds, g, S, E, F.wave);
            sample_in_ab(F, i, g.Bt, rss_sptr(F, 2 * layer)); }
          xcd_barrier(bar, F0.wave);
          { PHASE_FRAME(F); mixer_ab(F, i, 2 * layer); }
          xcd_barrier(bar, F0.wave);
          if (args.pad && layer == nl - 1) return;
          out_part(F0, bar, layer, (const bf16_t*)(F.ws + WS_WOUTAB + i * SZ_WOUT));
          ffn_part(F0, bar, layer); }
        { const int layer = 2 * lp + 1, i = lp; if (layer >= nl) break;
          { PHASE_FRAME(F); Gemm g{(const bf16_t*)(F.ws + WS_XB16), (const bf16_t*)(F.ws + WS_WINCD + i * SZ_WINCD), MP, N_CD, D}; StaticOrder S; S.init(MP, N_CD, F.G, opaque_bid());
            EpiInCD E{(bf16_t*)(F.ws + WS_Z), rss_ptr(F, 2 * layer), (const float*)(F.ws + WS_LB) + i * 1024, F.in[I_BG] + i * 512, (float*)(F.ws + WS_LG), (float*)(F.ws + WS_LG) + (size_t)MP * 1024};
            gemm_phase<EpiInCD>(F.lds, g, S, E, F.wave);
            sample_plain(F, g.Bt, rss_sptr(F, 2 * layer), N_CD, 32 * (N_CD / 256), (float*)(F.ws + WS_ZS), N_CD, false); }
          xcd_barrier(bar, F0.wave);
          { PHASE_FRAME(F); mixer_cd_x2(F, i, 2 * layer); }
          xcd_barrier(bar, F0.wave);
          { PHASE_FRAME(F); mixer_cd_x3(F, i, 2 * layer + 1); }
          xcd_barrier(bar, F0.wave);
          if (args.pad && layer == nl - 1) return;
          out_part(F0, bar, layer, (const bf16_t*)(F.ws + WS_WOUTCD + i * SZ_WOUT));
          ffn_part(F0, bar, layer); }
    }
}

static int g_grid = 0;
inline void launch_mega(void* const* d_in, float* out, unsigned char* ws, int nlayers, hipStream_t stream, int stop_after_mixer = 0) {
    if (g_grid == 0) {
        int dev = 0, cus = 0;
        if (hipGetDevice(&dev) != hipSuccess || hipDeviceGetAttribute(&cus, hipDeviceAttributeMultiprocessorCount, dev) != hipSuccess) { g_grid = -1; return; }
        if (hipFuncSetAttribute((const void*)mega_fwd, hipFuncAttributeMaxDynamicSharedMemorySize, LDS_BYTES) != hipSuccess) { g_grid = -1; return; }
        int per_cu = 0; (void)hipOccupancyMaxActiveBlocksPerMultiprocessor(&per_cu, (const void*)mega_fwd, 512, LDS_BYTES); (void)hipGetLastError();
        g_grid = (per_cu >= 1) ? cus : -1;
    }
    if (g_grid < 0) return;
    (void)hipMemsetAsync(ws + WS_CTL, 0, CTL_BYTES, stream);
    Args a{}; for (int k = 0; k < 32; ++k) a.in[k] = (const float*)d_in[k];
    a.out = out; a.ws = ws; a.nlayers = nlayers; a.pad = stop_after_mixer;
    hipLaunchKernelGGL(mega_fwd, dim3(g_grid), dim3(512), LDS_BYTES, stream, a);
}
}
extern "C" void kernel_launch(void* const* d_in, const int* in_sizes, int n_in, void* d_out, int out_size, void* d_ws, size_t ws_size, hipStream_t stream) {
    if (n_in != 32 || ws_size < mk::WS_END || (size_t)out_size != mk::O_END) return;
    mk::launch_mega(d_in, (float*)d_out, (unsigned char*)d_ws, 4, stream);
}
```

```cpp
#include <hip/hip_runtime.h>
namespace mk {
#define MK_LAS __attribute__((address_space(3)))
#define MK_GAS __attribute__((address_space(1)))
typedef unsigned short bf16_t;
typedef short bf16x8 __attribute__((ext_vector_type(8)));
typedef short s16x4 __attribute__((ext_vector_type(4)));
typedef float f32x4 __attribute__((ext_vector_type(4)));
typedef float f32x2 __attribute__((ext_vector_type(2)));
typedef unsigned u32x4 __attribute__((ext_vector_type(4)));
typedef unsigned u32x2 __attribute__((ext_vector_type(2)));

constexpr int D = 2048, NB = 2, SEQ = 4096, MP = NB * SEQ, SB = 8, ST = 8, MS = SB * ST, MT = MP + MS;
constexpr int HA = 8, DH = 128, WA = 1024, WB = 1024, HB_ = 8, LA = 2048;
constexpr int N_AB = 5120, N_CD = 7680, N_CD_SRC = 7184, N_CDZ = 7168, FF = 5504, N_UP = 2 * FF;
constexpr int HC = 8, HD_ = 4, DK = 128, DVC = 128, DVD = 256;
constexpr float EPS = 1e-6f;
constexpr int NCHUNK = SEQ / 64;
constexpr int ZC_QC = 0, ZC_KC = 1024, ZC_IC = 2048, ZC_GC = 3072, ZC_QD = 4096, ZC_KD = 4608, ZC_VD = 5120, ZC_RD = 6144;

constexpr size_t MiB = 1u << 20;
constexpr size_t WS_CTL = 0, CTL_BYTES = 1 * MiB;
constexpr size_t WS_WINAB = 1 * MiB, SZ_WINAB = (size_t)N_AB * D * 2;
constexpr size_t WS_WOUTAB = WS_WINAB + 2 * SZ_WINAB, SZ_WOUT = (size_t)D * D * 2;
constexpr size_t WS_WINCD = WS_WOUTAB + 2 * SZ_WOUT, SZ_WINCD = (size_t)N_CD * D * 2;
constexpr size_t WS_WOUTCD = WS_WINCD + 2 * SZ_WINCD;
constexpr size_t WS_WUP = WS_WOUTCD + 2 * SZ_WOUT, SZ_WUP = (size_t)N_UP * D * 2;
constexpr size_t WS_WDN = WS_WUP + 4 * SZ_WUP, SZ_WDN = (size_t)D * FF * 2;
constexpr size_t WS_WLRU = WS_WDN + 4 * SZ_WDN, SZ_WLRU = (size_t)2 * 8 * 2 * 128 * 128 * 2;
constexpr size_t WS_LB = WS_WLRU + SZ_WLRU;
constexpr size_t WS_XB16 = WS_LB + 64 * 1024;
constexpr size_t WS_Z = WS_XB16 + 33 * MiB;
constexpr size_t WS_LG = WS_Z + 112 * MiB;
constexpr size_t WS_SC = WS_LG + 48 * MiB;
constexpr size_t WS_MIX = WS_SC + 64 * MiB;
constexpr size_t WS_ZS = WS_MIX + 33 * MiB;
constexpr size_t WS_GUS = WS_ZS + 2 * MiB;
constexpr size_t WS_GHEAD = WS_GUS + 3 * MiB;
constexpr size_t WS_GTAIL = WS_GHEAD + 3 * MiB;
constexpr size_t WS_RSS = WS_GTAIL + 2 * MiB;
constexpr size_t RSS_P_FLOATS = (size_t)9 * MP * 8, RSS_S_FLOATS = (size_t)9 * MS * 128;
constexpr size_t WS_END = WS_RSS + 3 * MiB;
static_assert((RSS_P_FLOATS + RSS_S_FLOATS) * 4 <= 3 * MiB && (size_t)MT * FF * 2 <= 112 * MiB && (size_t)MP * N_CDZ * 2 <= 112 * MiB && (size_t)MT * D * 2 <= 33 * MiB, "ws map");
constexpr int CW_TMO = 0, CW_CODE = 1, CW_BAR = 4096, CW_Q = 8192;
constexpr int RING_BYTES = 131072, EPI_OFF = RING_BYTES, EPI_BYTES = 12288, MISC_OFF = EPI_OFF + EPI_BYTES, LDS_BYTES = 147456;
static_assert(MISC_OFF + 256 <= LDS_BYTES, "lds");

__device__ __forceinline__ unsigned f2bf(float f) { unsigned u = __builtin_bit_cast(unsigned, f); return (u + 0x7fffu + ((u >> 16) & 1u)) >> 16; }
__device__ __forceinline__ unsigned pk2(float lo, float hi) { return f2bf(lo) | (f2bf(hi) << 16); }
__device__ __forceinline__ float bf2f(unsigned short b) { return __builtin_bit_cast(float, ((unsigned)b) << 16); }
__device__ __forceinline__ float bflo(unsigned w) { return __builtin_bit_cast(float, w << 16); }
__device__ __forceinline__ float bfhi(unsigned w) { return __builtin_bit_cast(float, w & 0xffff0000u); }
__device__ __forceinline__ unsigned cvt_pk_bf16(float lo, float hi) { unsigned r; asm volatile("v_cvt_pk_bf16_f32 %0, %1, %2" : "=v"(r) : "v"(lo), "v"(hi)); return r; }
__device__ __forceinline__ float fast_exp2(float x) { return __builtin_amdgcn_exp2f(x); }
__device__ __forceinline__ float fast_exp(float x) { return __builtin_amdgcn_exp2f(x * 1.44269504089f); }
__device__ __forceinline__ float fast_rcp(float x) { return __builtin_amdgcn_rcpf(x); }
__device__ __forceinline__ float sigmoid_f(float x) { return fast_rcp(1.0f + fast_exp(-x)); }
__device__ __forceinline__ float silu_f(float x) { return x * sigmoid_f(x); }
__device__ __forceinline__ float gelu_tanh_f(float x) { const float u = 0.7978845608028654f * (x + 0.044715f * x * x * x); return x * sigmoid_f(2.0f * u); }
template <class T> __device__ __forceinline__ MK_GAS T* launder(T* p) { MK_GAS T* q = (MK_GAS T*)p; asm volatile("" : "+v"(q)); return q; }
template <class T> __device__ __forceinline__ MK_GAS T* launder(MK_GAS T* q) { asm volatile("" : "+v"(q)); return q; }
__device__ __forceinline__ int opaque_bid() { int b = (int)blockIdx.x; asm volatile("" : "+s"(b)); return b; }
__device__ __forceinline__ int lane_id() { int l; asm volatile("v_mbcnt_lo_u32_b32 %0, -1, 0\n\tv_mbcnt_hi_u32_b32 %0, -1, %0" : "=v"(l)); return l; }
__device__ __forceinline__ int opaque_tid(int wave) { int l; asm volatile("v_mbcnt_lo_u32_b32 %0, -1, 0\n\tv_mbcnt_hi_u32_b32 %0, -1, %0" : "=v"(l)); return wave * 64 + l; }
__device__ __forceinline__ float fast_rsq(float x) { return __builtin_amdgcn_rsqf(x); }
__device__ __forceinline__ float fast_sqrt(float x) { return __builtin_amdgcn_sqrtf(x); }
__device__ __forceinline__ float fast_ln(float x) { return 0.69314718056f * __builtin_amdgcn_logf(x); }
__device__ __forceinline__ float softplus_acc(float x) { if (x > 20.f) return x; const float e = fast_exp(x); const float ser = e * (1.0f + e * (-0.5f + e * (0.33333333f + e * (-0.25f + e * 0.2f)))); return e < 0.06f ? ser : fast_ln(1.0f + e); }
__device__ __forceinline__ float one_minus_exp(float x) { const float ser = -x * (1.0f + x * (0.5f + x * (0.16666667f + x * (0.041666668f + x * 0.0083333338f)))); return x > -0.3f ? ser : 1.0f - fast_exp(x); }
__device__ __forceinline__ float rss_p(const float* part, int row) { const f32x4 a = *(const f32x4*)(part + (size_t)row * 8), b = *(const f32x4*)(part + (size_t)row * 8 + 4); return ((a[0] + a[1]) + (a[2] + a[3])) + ((b[0] + b[1]) + (b[2] + b[3])); }
__device__ __forceinline__ float rss_s(const float* part, int row) { float s = 0.f; const f32x4* p = (const f32x4*)(part + (size_t)row * 128);
#pragma unroll 8
    for (int j = 0; j < 32; ++j) { const f32x4 a = p[j]; s += (a[0] + a[1]) + (a[2] + a[3]); } return s; }
__device__ __forceinline__ float bperm(int srclane, float v) { return __builtin_bit_cast(float, __builtin_amdgcn_ds_bpermute(srclane << 2, __builtin_bit_cast(int, v))); }
#define SHX(v, mask) bperm(lane ^ (mask), (v))
#define SHUP(v, d) bperm(lane >= (d) ? lane - (d) : lane, (v))
#define SHL(v, src) bperm((src), (v))
#define LDS_WAIT() asm volatile("s_waitcnt lgkmcnt(0)" ::: "memory")
#define VM_WAIT() asm volatile("s_waitcnt vmcnt(0)" ::: "memory")

#define XB_TMO      128
#define XB_XCNT(j)  (256  + 64 * (j))
#define XB_XSUB(j)  (1280 + 64 * (j))
#define XB_XGEN(j)  (2304 + 64 * (j))
#define XB_TOP      3328
#define XB_TOPGEN   3392
#define XCD_BAR_WORDS 3456
#define XB_SPIN_CAP (1u << 22)
__device__ __forceinline__ unsigned xb_ld(unsigned* p)              { return __hip_atomic_load(p, __ATOMIC_RELAXED, __HIP_MEMORY_SCOPE_AGENT); }
__device__ __forceinline__ unsigned xb_add(unsigned* p, unsigned v) { return __hip_atomic_fetch_add(p, v, __ATOMIC_RELAXED, __HIP_MEMORY_SCOPE_AGENT); }
__device__ __forceinline__ unsigned xb_xcc_id() { return (unsigned)__builtin_amdgcn_s_getreg((3 << 11) | 20) & 0xFu; }
#define XB_SPIN(cond, bar) do { unsigned _sp = 0; while (cond) { __builtin_amdgcn_s_sleep(1); \
    if ((++_sp & 255u) == 0u) { if (xb_ld(&(bar)[XB_TMO])) break; if (_sp > XB_SPIN_CAP) { atomicAdd(&(bar)[XB_TMO], 1u); break; } } } } while (0)
struct XcdBarrier { unsigned* bar; unsigned x; volatile MK_LAS unsigned* st; };
__device__ __forceinline__ XcdBarrier xcd_barrier_post(unsigned* bar, volatile MK_LAS unsigned* st, int wave) {
    XcdBarrier b; b.bar = bar; b.x = xb_xcc_id(); b.st = st;
    if (wave == 0 && lane_id() == 0) (void)xb_add(&bar[XB_XCNT(b.x)], 1u);
    return b;
}
__device__ __forceinline__ void xcd_barrier_complete(unsigned* bar, unsigned x, unsigned& nloc, unsigned& nx) {
    const unsigned G = gridDim.x * gridDim.y * gridDim.z;
    unsigned sum, cnt, mine, sp = 0u;
    for (;;) {
        sum = 0u; cnt = 0u; mine = 0u;
#pragma unroll
        for (unsigned j = 0; j < 16; ++j) { const unsigned c = xb_ld(&bar[XB_XCNT(j)]); sum += c; cnt += (c > 0u) ? 1u : 0u; mine = (j == x) ? c : mine; }
        if (sum == G) break;
        __builtin_amdgcn_s_sleep(1);
        if ((++sp & 255u) == 0u) { if (xb_ld(&bar[XB_TMO])) break; if (sp > XB_SPIN_CAP) { atomicAdd(&bar[XB_TMO], 1u); break; } }
    }
    nloc = mine > 0u ? mine : 1u; nx = cnt > 0u ? cnt : 1u;
}
__device__ __forceinline__ void xcd_barrier(const XcdBarrier& b, int wave) {
    asm volatile("s_waitcnt vmcnt(0)" ::: "memory");
    __syncthreads();
    if (wave == 0 && lane_id() == 0) {
        unsigned* bar = b.bar; unsigned bx = xb_xcc_id(); asm volatile("" : "+s"(bx));
        __builtin_amdgcn_s_waitcnt(0);
        unsigned nloc = b.st[0], nx = b.st[1];
        if (nloc == 0u) { xcd_barrier_complete(bar, bx, nloc, nx); b.st[0] = nloc; b.st[1] = nx; }
        const unsigned old = xb_add(&bar[XB_XSUB(bx)], 1u);
        const unsigned gen = old / nloc;
        if (old + 1u == (gen + 1u) * nloc) {
            __builtin_amdgcn_fence(__ATOMIC_RELEASE, "agent");
            asm volatile("s_waitcnt vmcnt(0)" ::: "memory");
            const unsigned og = xb_add(&bar[XB_TOP], 1u);
            const unsigned tg = og / nx;
            if (og + 1u == (tg + 1u) * nx) xb_add(&bar[XB_TOPGEN], 1u);
            else XB_SPIN(xb_ld(&bar[XB_TOPGEN]) == tg, bar);
            __builtin_amdgcn_fence(__ATOMIC_ACQUIRE, "agent");
            xb_add(&bar[XB_XGEN(bx)], 1u);
            asm volatile("s_waitcnt vmcnt(0)" ::: "memory");
        } else {
            XB_SPIN(xb_ld(&bar[XB_XGEN(bx)]) == gen, bar);
            __builtin_amdgcn_fence(__ATOMIC_ACQUIRE, "agent");
            asm volatile("s_waitcnt vmcnt(0)" ::: "memory");
        }
    }
    __syncthreads();
}

constexpr int BM = 256, BK = 64, HALF = 128, HTB = HALF * BK * 2, STAGE_BYTES = 8 * HTB, NXCD = 8, WGM = 8;
__host__ __device__ __forceinline__ int lds_byte(int r, int c) { const int st = (r >> 4) * 2 + (c >> 5), rr = r & 15, cc = c & 31, ob = rr * 64 + cc * 2; return st * 1024 + (ob ^ (((ob >> 9) & 1) << 5)); }
__host__ __device__ __forceinline__ void stage_rc(int b, int& R, int& C) { const int st = b / 1024, sb = b % 1024, swz = sb ^ (((sb >> 9) & 1) << 5); R = (st >> 1) * 16 + swz / 64; C = (st & 1) * 32 + (swz % 64) / 2; }
__host__ __device__ __forceinline__ int perm32(int rho) { const int n = rho >> 4, i = rho & 15; return 8 * (i >> 2) + 4 * n + (i & 3); }
struct Unit { int pm, pn; };
struct Gemm { const bf16_t* A; const bf16_t* Bt; int M, N, K; };
struct StaticOrder {
    int nM, nN, nwg, G, c;
    __device__ __forceinline__ void init(int M, int N, int G_, int c_) { nM = M / BM; nN = N / BM; nwg = nM * nN; G = G_; c = c_; }
    __device__ __forceinline__ bool next(int i, Unit& u) const {
        const long L = (long)i * G + c; if (L >= nwg) return false;
        int wgid = (int)L; { const int q = nwg / NXCD, r = nwg % NXCD, xcd = wgid % NXCD, off = wgid / NXCD; wgid = (xcd < r ? xcd * (q + 1) : r * (q + 1) + (xcd - r) * q) + off; }
        const int nig = WGM * nN, gid = wgid / nig, fm = gid * WGM, gsz = (nM - fm) < WGM ? (nM - fm) : WGM;
        u.pm = fm + ((wgid % nig) % gsz); u.pn = (wgid % nig) / gsz; return true;
    }
};
template <class Epi>
__device__ __forceinline__ void gemm_phase(MK_LAS unsigned char* lds, const Gemm g, const StaticOrder& S, const Epi& E, int wave_id) {
    const int tid = opaque_tid(wave_id), wid = wave_id, lane = tid & 63, wr = wid >> 2, wc = wid & 3, fr = lane & 15, fq = lane >> 4;
    const int K = g.K, nt = K / BK;
    unsigned voffA[2], voffB[2];
#pragma unroll
    for (int i = 0; i < 2; ++i) { int R, C; stage_rc(tid * 16 + i * 8192, R, C); const int Rb = Epi::PERM ? ((R & ~31) + perm32(R & 31)) : R;
        voffA[i] = (unsigned)(R * K + C) * 2u; voffB[i] = (unsigned)(Rb * K + C) * 2u; }
    const size_t kstep = (size_t)(BK * 2);
    const size_t hstep = (size_t)HALF * K * 2;
    const size_t tstep = 2 * hstep;
    const unsigned ldsw = (unsigned)wid * 1024u;
    const int aoff = lds_byte(wr * 64 + fr, fq * 8), boff = lds_byte(wc * 32 + fr, fq * 8);
#define PG8_SA(b, h) (((b) * 2 + (h)) * HTB)
#define PG8_SB(b, h) ((4 + (b) * 2 + (h)) * HTB)
#define PG8_STAGE(bufoff, gbase, voff) do { _Pragma("unroll") for (int _i = 0; _i < 2; ++_i) \
        __builtin_amdgcn_global_load_lds((const unsigned*)((const char*)(gbase) + (voff)[_i]), (MK_LAS unsigned*)(lds + (bufoff) + ldsw + _i * 8192), 16, 0, 0); } while (0)
#define PG8_LDA(dst, b, h) do { _Pragma("unroll") for (int m = 0; m < 4; ++m) _Pragma("unroll") for (int k = 0; k < 2; ++k) dst[m][k] = *(const MK_LAS bf16x8*)(lds + PG8_SA(b, h) + aoff + m * 2048 + k * 1024); } while (0)
#define PG8_LDB(dst, b, h) do { _Pragma("unroll") for (int n = 0; n < 2; ++n) _Pragma("unroll") for (int k = 0; k < 2; ++k) dst[n][k] = *(const MK_LAS bf16x8*)(lds + PG8_SB(b, h) + boff + n * 2048 + k * 1024); } while (0)
#define PG8_MMA(ai, bj, At, Bt) do { __builtin_amdgcn_s_setprio(1); _Pragma("unroll") for (int m = 0; m < 4; ++m) _Pragma("unroll") for (int n = 0; n < 2; ++n) _Pragma("unroll") for (int k = 0; k < 2; ++k) \
        acc[ai][bj][m][n] = __builtin_amdgcn_mfma_f32_16x16x32_bf16(Bt[n][k], At[m][k], acc[ai][bj][m][n], 0, 0, 0); __builtin_amdgcn_s_setprio(0); } while (0)
#define PG8_WAIT_V(n) asm volatile("s_waitcnt vmcnt(" #n ")" ::: "memory")
#define PG8_WAIT_L(n) asm volatile("s_waitcnt lgkmcnt(" #n ")" ::: "memory")
#define PG8_BAR __builtin_amdgcn_s_barrier()
#define PG8_SCHED __builtin_amdgcn_sched_barrier(0)
    Unit cur, nxt; int ui = 0;
    if (!S.next(0, cur)) return;
    f32x4 acc[2][2][4][2];
#pragma unroll
    for (int a = 0; a < 2; ++a)
#pragma unroll
        for (int b = 0; b < 2; ++b)
#pragma unroll
            for (int m = 0; m < 4; ++m)
#pragma unroll
                for (int n = 0; n < 2; ++n) acc[a][b][m][n] = (f32x4){0.f, 0.f, 0.f, 0.f};
    bf16x8 At[4][2], B0[2][2], B1[2][2];
    const char* cA = (const char*)g.A + (size_t)cur.pm * tstep; const char* cB = (const char*)g.Bt + (size_t)cur.pn * tstep;
    PG8_STAGE(PG8_SB(0, 0), cB, voffB); PG8_STAGE(PG8_SB(0, 1), cB + hstep, voffB); PG8_STAGE(PG8_SA(0, 0), cA, voffA); PG8_STAGE(PG8_SA(0, 1), cA + hstep, voffA);
    if (wr == 1) PG8_BAR;
    PG8_WAIT_V(2); PG8_BAR;
    PG8_STAGE(PG8_SB(1, 0), cB + kstep, voffB); PG8_STAGE(PG8_SA(1, 0), cA + kstep, voffA); PG8_STAGE(PG8_SB(1, 1), cB + hstep + kstep, voffB);
    PG8_WAIT_V(6); PG8_BAR;
    for (;;) {
        const bool has_next = S.next(ui + 1, nxt);
        const char* nA = has_next ? (const char*)g.A + (size_t)nxt.pm * tstep : cA; const char* nB = has_next ? (const char*)g.Bt + (size_t)nxt.pn * tstep : cB;
        for (int t = 0; t < nt; t += 2) {
            const bool last = (t == nt - 2);
            const char* a1 = cA + (size_t)(t + 1) * kstep;
            const char* a2 = last ? nA : cA + (size_t)(t + 2) * kstep; const char* b2 = last ? nB : cB + (size_t)(t + 2) * kstep;
            const char* a3 = a2 + kstep; const char* b3 = b2 + kstep;
            PG8_LDB(B0, 0, 0); PG8_LDB(B1, 0, 1); PG8_SCHED; PG8_LDA(At, 0, 0); PG8_STAGE(PG8_SA(1, 1), a1 + hstep, voffA);
            PG8_WAIT_V(8); PG8_WAIT_L(0); PG8_BAR; PG8_MMA(0, 0, At, B0); PG8_MMA(0, 1, At, B1); PG8_BAR; PG8_SCHED;
            PG8_LDA(At, 0, 1); PG8_STAGE(PG8_SB(0, 0), b2, voffB); PG8_STAGE(PG8_SB(0, 1), b2 + hstep, voffB); PG8_STAGE(PG8_SA(0, 0), a2, voffA);
            PG8_WAIT_V(8); PG8_WAIT_L(0); PG8_BAR; PG8_MMA(1, 0, At, B0); PG8_MMA(1, 1, At, B1); PG8_BAR; PG8_SCHED;
            PG8_LDB(B0, 1, 0); PG8_LDB(B1, 1, 1); PG8_SCHED; PG8_LDA(At, 1, 0); PG8_STAGE(PG8_SA(0, 1), a2 + hstep, voffA);
            PG8_WAIT_V(8); PG8_WAIT_L(0); PG8_BAR; PG8_MMA(0, 0, At, B0); PG8_MMA(0, 1, At, B1); PG8_BAR; PG8_SCHED;
            PG8_LDA(At, 1, 1); PG8_STAGE(PG8_SB(1, 0), b3, voffB); PG8_STAGE(PG8_SB(1, 1), b3 + hstep, voffB); PG8_STAGE(PG8_SA(1, 0), a3, voffA);
            PG8_WAIT_V(8); PG8_WAIT_L(0); PG8_BAR; PG8_MMA(1, 0, At, B0); PG8_MMA(1, 1, At, B1); PG8_BAR; PG8_SCHED;
        }
        if (wr == 0) PG8_BAR;
        E(acc, cur, wr, wc, fr, fq, lds + EPI_OFF);
        if (!has_next) break;
#pragma unroll
        for (int a = 0; a < 2; ++a)
#pragma unroll
            for (int b = 0; b < 2; ++b)
#pragma unroll
                for (int m = 0; m < 4; ++m)
#pragma unroll
                    for (int n = 0; n < 2; ++n) acc[a][b][m][n] = (f32x4){0.f, 0.f, 0.f, 0.f};
        cur = nxt; cA = nA; cB = nB; ++ui;
        if (wr == 1) PG8_BAR;
    }
    PG8_WAIT_V(0);
    PG8_BAR;
#undef PG8_SA
#undef PG8_SB
#undef PG8_STAGE
#undef PG8_LDA
#undef PG8_LDB
#undef PG8_MMA
#undef PG8_WAIT_V
#undef PG8_WAIT_L
#undef PG8_SCHED
}
}
namespace mk {
typedef f32x4 Acc[2][2][4][2];

struct EpiRes {
    static constexpr bool PERM = false;
    const float* base; float* xout; bf16_t* xb16; float* rssp;
    __device__ __forceinline__ void operator()(Acc& acc, const Unit& u, int wr, int wc, int fr, int fq, MK_LAS unsigned char* lds) const {
        asm volatile("" : "+v"(fr), "+v"(fq)); const int lane = fq * 16 + fr;
        const int row0 = u.pm * BM + wr * 64 + fr, col0 = u.pn * BM + wc * 32 + 4 * fq;
        MK_LAS float* P = (MK_LAS float*)lds;
#pragma unroll
        for (int ai = 0; ai < 2; ++ai)
#pragma unroll
            for (int m = 0; m < 4; ++m) { const int row = row0 + ai * HALF + m * 16; const unsigned off = (unsigned)row * D + col0; float ss = 0.f;
#pragma unroll
                for (int bj = 0; bj < 2; ++bj)
#pragma unroll
                    for (int n = 0; n < 2; ++n) { const unsigned o = off + bj * HALF + n * 16; const f32x4 v = acc[ai][bj][m][n] + *(const f32x4*)(base + o);
                        *(f32x4*)(xout + o) = v; u32x2 w; w.x = cvt_pk_bf16(v[0], v[1]); w.y = cvt_pk_bf16(v[2], v[3]); *(u32x2*)(xb16 + o) = w;
                        ss += (v[0] * v[0] + v[1] * v[1]) + (v[2] * v[2] + v[3] * v[3]); }
                ss += SHX(ss, 16); ss += SHX(ss, 32);
                if (fq == 0) P[(ai * HALF + wr * 64 + m * 16 + fr) * 4 + wc] = ss;
                asm volatile("" ::: "memory"); }
        LDS_WAIT(); __builtin_amdgcn_s_barrier(); asm volatile("" ::: "memory");
        if (fq == 0) {
#pragma unroll
            for (int ai = 0; ai < 2; ++ai)
#pragma unroll
                for (int m = 0; m < 4; ++m) if (((ai * 4 + m) >> 1) == wc) { const int rl = ai * HALF + wr * 64 + m * 16 + fr; const f32x4 p = *(const MK_LAS f32x4*)(P + rl * 4);
                    rssp[(unsigned)(u.pm * BM + rl) * 8 + u.pn] = (p[0] + p[1]) + (p[2] + p[3]); } }
    }
};

struct EpiInAB {
    static constexpr bool PERM = true;
    bf16_t* Z; const float* rss; const float* qn; const float* kn; float* kv_out; float* conv_out;
    __device__ __forceinline__ void operator()(Acc& acc, const Unit& u, int wr, int wc, int fr, int fq, MK_LAS unsigned char* lds) const {
        asm volatile("" : "+v"(fr), "+v"(fq)); const int lane = fq * 16 + fr;
        const int kind = u.pn >> 2; const int row0 = u.pm * BM + wr * 64 + fr; const int cw = (u.pn & 3) * 256 + wc * 32 + 8 * fq;
        MK_LAS float* P = (MK_LAS float*)lds;
#pragma unroll
        for (int ai = 0; ai < 2; ++ai)
#pragma unroll
            for (int m = 0; m < 4; ++m) { const float rs = fast_rsq(rss_p(rss, row0 + ai * HALF + m * 16) * (1.0f / D) + EPS);
#pragma unroll
                for (int bj = 0; bj < 2; ++bj) { acc[ai][bj][m][0] = acc[ai][bj][m][0] * rs; acc[ai][bj][m][1] = acc[ai][bj][m][1] * rs;
                    if (kind <= 1) { const f32x4 v = acc[ai][bj][m][0], x = acc[ai][bj][m][1]; float s = ((v[0] * v[0] + v[1] * v[1]) + (v[2] * v[2] + v[3] * v[3])) + ((x[0] * x[0] + x[1] * x[1]) + (x[2] * x[2] + x[3] * x[3]));
                        s += SHX(s, 16); s += SHX(s, 32);
                        if (fq == 0) P[((ai * HALF + wr * 64 + m * 16 + fr) * 2 + bj) * 4 + wc] = s; } }
                asm volatile("" ::: "memory"); }
        f32x4 g0 = (f32x4){1.f, 1.f, 1.f, 1.f}, g1 = g0;
        if (kind <= 1) { LDS_WAIT(); __builtin_amdgcn_s_barrier(); asm volatile("" ::: "memory");
            const float* gp = (kind == 0 ? qn : kn) + wc * 32 + 8 * fq; g0 = *(const f32x4*)gp; g1 = *(const f32x4*)(gp + 4); }
#pragma unroll
        for (int ai = 0; ai < 2; ++ai)
#pragma unroll
            for (int m = 0; m < 4; ++m) { const int row = row0 + ai * HALF + m * 16; const int t = row & (SEQ - 1), b = row >> 12;
#pragma unroll
                for (int bj = 0; bj < 2; ++bj) { f32x4 v0 = acc[ai][bj][m][0], v1 = acc[ai][bj][m][1];
                    if (kind <= 1) { const f32x4 p = *(const MK_LAS f32x4*)(P + ((ai * HALF + wr * 64 + m * 16 + fr) * 2 + bj) * 4);
                        const float hs = fast_rsq(((p[0] + p[1]) + (p[2] + p[3])) * (1.0f / DH) + EPS); v0 = v0 * hs * g0; v1 = v1 * hs * g1; }
                    u32x4 w; w.x = cvt_pk_bf16(v0[0], v0[1]); w.y = cvt_pk_bf16(v0[2], v0[3]); w.z = cvt_pk_bf16(v1[0], v1[1]); w.w = cvt_pk_bf16(v1[2], v1[3]);
                    *(u32x4*)(Z + (unsigned)row * N_AB + kind * 1024 + cw + bj * HALF) = w;
                    if ((kind == 1 || kind == 2) && t >= SEQ - LA) { float* o = kv_out + (((unsigned)b * LA + (t - (SEQ - LA))) * 2 + (kind - 1)) * WA + cw + bj * HALF; *(f32x4*)o = v0; *(f32x4*)(o + 4) = v1; }
                    if (kind == 3 && t >= SEQ - 3) { float* o = conv_out + ((unsigned)b * 3 + (t - (SEQ - 3))) * WB + cw + bj * HALF; *(f32x4*)o = v0; *(f32x4*)(o + 4) = v1; } }
                asm volatile("" ::: "memory"); }
    }
};

struct EpiInCD {
    static constexpr bool PERM = true;
    bf16_t* Z; const float* rss; const float* lb; const float* bg; float* lgc; float* lgd;
    __device__ __forceinline__ void operator()(Acc& acc, const Unit& u, int wr, int wc, int fr, int fq, MK_LAS unsigned char*) const {
        asm volatile("" : "+v"(fr), "+v"(fq));
        const int pn = u.pn; const int row0 = u.pm * BM + wr * 64 + fr; const int c8 = wc * 32 + 8 * fq;
        const int mode = (pn >= 4 && pn < 8) ? 1 : (pn >= 28 ? 2 : 0);
        const float sc = (pn == 16 || pn == 17) ? 0.08838834764831845f : 1.0f;
#pragma unroll
        for (int ai = 0; ai < 2; ++ai)
#pragma unroll
            for (int m = 0; m < 4; ++m) { const int row = row0 + ai * HALF + m * 16; const float rs = sc * fast_rsq(rss_p(rss, row) * (1.0f / D) + EPS);
#pragma unroll
                for (int bj = 0; bj < 2; ++bj) { f32x4 v0 = acc[ai][bj][m][0] * rs, v1 = acc[ai][bj][m][1] * rs; const int ct = c8 + bj * HALF;
                    if (mode == 1) { const int ck = (pn - 4) * 256 + ct; const f32x4 l0 = *(const f32x4*)(lb + ck), l1 = *(const f32x4*)(lb + ck + 4); f32x4 g0, g1;
#pragma unroll
                        for (int j = 0; j < 4; ++j) { const float s0 = sigmoid_f(v0[j]), s1 = sigmoid_f(v1[j]);
                            g0[j] = fmaxf(fast_ln(l0[j] + (1.0f - l0[j]) * s0), -60.0f); g1[j] = fmaxf(fast_ln(l1[j] + (1.0f - l1[j]) * s1), -60.0f);
                            v0[j] = (1.0f - l0[j]) * (1.0f - s0); v1[j] = (1.0f - l1[j]) * (1.0f - s1); }
                        float* o = lgc + (unsigned)row * 1024 + ck; *(f32x4*)o = g0; *(f32x4*)(o + 4) = g1; }
                    if (mode == 2) { const int ck = (pn - 28) * 256 + ct; const f32x4 b0 = *(const f32x4*)(bg + ck), b1 = *(const f32x4*)(bg + ck + 4); f32x4 g0, g1;
#pragma unroll
                        for (int j = 0; j < 4; ++j) { const float x0 = v0[j] + b0[j], x1 = v1[j] + b1[j];
                            g0[j] = (fminf(x0, 0.f) - fast_ln(1.0f + fast_exp(-fabsf(x0)))) * 0.0625f;
                            g1[j] = (fminf(x1, 0.f) - fast_ln(1.0f + fast_exp(-fabsf(x1)))) * 0.0625f; }
                        float* o = lgd + (unsigned)row * 512 + ck; *(f32x4*)o = g0; *(f32x4*)(o + 4) = g1; }
                    else { u32x4 w; w.x = cvt_pk_bf16(v0[0], v0[1]); w.y = cvt_pk_bf16(v0[2], v0[3]); w.z = cvt_pk_bf16(v1[0], v1[1]); w.w = cvt_pk_bf16(v1[2], v1[3]);
                        *(u32x4*)(Z + (unsigned)row * N_CDZ + pn * 256 + ct) = w; } } }
    }
};

struct EpiUp {
    static constexpr bool PERM = true;
    bf16_t* HB; const float* rss; const float* cw; const float* cb; float* ghead; float* gtail; float* ffn_out;
    __device__ __forceinline__ void operator()(Acc& acc, const Unit& u, int wr, int wc, int fr, int fq, MK_LAS unsigned char* lds) const {
        asm volatile("" : "+v"(fr), "+v"(fq));
        const int lane = fq * 16 + fr; const int row0 = u.pm * BM + wr * 64 + fr; const int c8 = wc * 32 + 8 * fq, cg = u.pn * 128 + c8;
        MK_LAS float* T = (MK_LAS float*)lds;
#pragma unroll
        for (int ai = 0; ai < 2; ++ai)
#pragma unroll
            for (int m = 0; m < 4; ++m) { const float rs = fast_rsq(rss_p(rss, row0 + ai * HALF + m * 16) * (1.0f / D) + EPS);
#pragma unroll
                for (int bj = 0; bj < 2; ++bj) { acc[ai][bj][m][0] = acc[ai][bj][m][0] * rs; acc[ai][bj][m][1] = acc[ai][bj][m][1] * rs; } }
        if (fr >= 14) {
#pragma unroll
            for (int ai = 0; ai < 2; ++ai) { MK_LAS float* t = T + ((2 * ai + wr) * 2 + (fr - 14)) * 128 + c8; *(MK_LAS f32x4*)t = acc[ai][0][3][0]; *(MK_LAS f32x4*)(t + 4) = acc[ai][0][3][1]; }
        }
        LDS_WAIT(); __builtin_amdgcn_s_barrier(); asm volatile("" ::: "memory");
        const int s1 = (lane & 48) | ((fr + 15) & 15), s2 = (lane & 48) | ((fr + 14) & 15);
        const bool first_tile = (u.pm & 15) == 0;
#pragma unroll
        for (int n = 0; n < 2; ++n) {
            const f32x4 w0 = *(const f32x4*)(cw + cg + 4 * n), w1 = *(const f32x4*)(cw + FF + cg + 4 * n), w2 = *(const f32x4*)(cw + 2 * FF + cg + 4 * n), bb = *(const f32x4*)(cb + cg + 4 * n);
#pragma unroll
            for (int ai = 0; ai < 2; ++ai) { const int grp = 2 * ai + wr; f32x4 prev1, prev2;
                if (grp == 0) { prev1 = (f32x4){0.f, 0.f, 0.f, 0.f}; prev2 = prev1; }
                else { const f32x4 r63 = *(const MK_LAS f32x4*)(T + ((grp - 1) * 2 + 1) * 128 + c8 + 4 * n), r62 = *(const MK_LAS f32x4*)(T + ((grp - 1) * 2 + 0) * 128 + c8 + 4 * n); prev1 = r63; prev2 = (fr == 0) ? r62 : r63; }
#pragma unroll
                for (int m = 0; m < 4; ++m) { const int row = row0 + ai * HALF + m * 16; const f32x4 x = acc[ai][0][m][n]; f32x4 r1, r2, hv;
#pragma unroll
                    for (int j = 0; j < 4; ++j) { r1[j] = SHL(x[j], s1); r2[j] = SHL(x[j], s2); }
                    const f32x4 p1 = (fr >= 1) ? r1 : prev1, p2 = (fr >= 2) ? r2 : prev2;
                    prev1 = r1; prev2 = r2;
                    const f32x4 gc = bb + w0 * p2 + w1 * p1 + w2 * x; const f32x4 uu = acc[ai][1][m][n];
#pragma unroll
                    for (int j = 0; j < 4; ++j) hv[j] = silu_f(gc[j]) * uu[j];
                    const bool deferred = (grp == 0) && (m == 0) && (fr < 2) && !first_tile;
                    if (!deferred) { u32x2 w; w.x = cvt_pk_bf16(hv[0], hv[1]); w.y = cvt_pk_bf16(hv[2], hv[3]); *(u32x2*)(HB + (unsigned)row * FF + cg + 4 * n) = w; }
                    else { float* o = ghead + ((unsigned)u.pm * 2 + fr) * (2 * FF) + cg + 4 * n; *(f32x4*)o = x; *(f32x4*)(o + FF) = uu; }
                    if (grp == 3 && m == 3 && fr >= 14) { *(f32x4*)(gtail + ((unsigned)u.pm * 2 + (fr - 14)) * FF + cg + 4 * n) = x;
                        if ((u.pm & 15) == 15) *(f32x4*)(ffn_out + ((unsigned)(u.pm >> 4) * 2 + (fr - 14)) * FF + cg + 4 * n) = x; }
                    asm volatile("" ::: "memory"); } } }
    }
};

template <int NT> struct SgLd { static constexpr int LDR = 16 * NT + 4, SLAB = 64 * LDR; };
template <int NT> __device__ __forceinline__ float sred4(const MK_LAS float* red, int row, int col) { constexpr int LDR = SgLd<NT>::LDR, SLAB = SgLd<NT>::SLAB; const MK_LAS float* p = red + row * LDR + col; return (p[0] + p[SLAB]) + (p[2 * SLAB] + p[3 * SLAB]); }
template <int NT> __device__ __forceinline__ void sgemm_tile(MK_LAS float* red, const bf16_t* A, const bf16_t* Bt, int K, int n0, int wave, int lane) {
    constexpr int LDR = SgLd<NT>::LDR, SLAB = SgLd<NT>::SLAB;
    f32x4 acc[4][NT];
#pragma unroll
    for (int a = 0; a < 4; ++a)
#pragma unroll
        for (int b = 0; b < NT; ++b) acc[a][b] = (f32x4){0.f, 0.f, 0.f, 0.f};
    const int fr = lane & 15, g = lane >> 4;
    const bf16_t* ap = A + (size_t)fr * K + 8 * g; const bf16_t* bp = Bt + (size_t)(n0 + fr) * K + 8 * g;
    for (int ks = wave; ks < K / 32; ks += 8) { bf16x8 a[4], b[NT];
#pragma unroll
        for (int mt = 0; mt < 4; ++mt) a[mt] = *(const bf16x8*)(ap + (size_t)(16 * mt) * K + 32 * ks);
#pragma unroll
        for (int nt = 0; nt < NT; ++nt) b[nt] = *(const bf16x8*)(bp + (size_t)(16 * nt) * K + 32 * ks);
#pragma unroll
        for (int mt = 0; mt < 4; ++mt)
#pragma unroll
            for (int nt = 0; nt < NT; ++nt) acc[mt][nt] = __builtin_amdgcn_mfma_f32_16x16x32_bf16(a[mt], b[nt], acc[mt][nt], 0, 0, 0); }
    MK_LAS float* slab = red + (wave & 3) * SLAB;
    if (wave < 4) {
#pragma unroll
        for (int mt = 0; mt < 4; ++mt)
#pragma unroll
            for (int nt = 0; nt < NT; ++nt)
#pragma unroll
                for (int e = 0; e < 4; ++e) slab[(16 * mt + 4 * g + e) * LDR + 16 * nt + fr] = acc[mt][nt][e]; }
    LDS_WAIT(); __syncthreads();
    if (wave >= 4) {
#pragma unroll
        for (int mt = 0; mt < 4; ++mt)
#pragma unroll
            for (int nt = 0; nt < NT; ++nt)
#pragma unroll
                for (int e = 0; e < 4; ++e) slab[(16 * mt + 4 * g + e) * LDR + 16 * nt + fr] += acc[mt][nt][e]; }
    LDS_WAIT(); __syncthreads();
}
}
namespace mk {
struct Args { const float* in[32]; float* out; unsigned char* ws; int nlayers; int pad; };
struct Frame {
    MK_LAS unsigned char* lds; unsigned* ctl; unsigned char* ws; float* out; const float* const* in;
    int tid, lane, wave, vcu, G;
};
constexpr size_t O_YP = 0, O_YS = O_YP + (size_t)MP * D, O_KVP = O_YS + (size_t)MS * D, O_KVS = O_KVP + (size_t)2 * NB * LA * 2 * WA, O_CONVP = O_KVS + (size_t)2 * SB * ST * 2 * WA,
    O_CONVS = O_CONVP + (size_t)2 * NB * 3 * WB, O_HP = O_CONVS + (size_t)2 * SB * 3 * WB, O_HS = O_HP + (size_t)2 * NB * WB, O_HGP = O_HS + (size_t)2 * SB * WB,
    O_HGS = O_HGP + (size_t)2 * NB * HC * DK * DVC, O_GLP = O_HGS + (size_t)2 * SB * HC * DK * DVC, O_GLS = O_GLP + (size_t)2 * NB * HD_ * DK * DVD, O_FFP = O_GLS + (size_t)2 * SB * HD_ * DK * DVD,
    O_FFS = O_FFP + (size_t)4 * NB * 2 * FF, O_END = O_FFS + (size_t)4 * SB * 2 * FF;
enum { I_XP = 0, I_XS, I_KV, I_SCONV, I_SH, I_SHG, I_SGL, I_SFF, I_NMIX, I_NFFN, I_WINAB, I_QN, I_KN, I_LCW, I_LCB, I_LWA, I_LBA, I_LWX, I_LBX, I_LLAM, I_WOUTAB, I_WINCD, I_LBL, I_HGN, I_WG2, I_BG, I_GLN, I_WOUTCD, I_WUP, I_FCW, I_FCB, I_WDN };

__device__ __forceinline__ float* rss_ptr(Frame& F, int idx) { return (float*)(F.ws + WS_RSS) + (size_t)idx * MP * 8; }
__device__ __forceinline__ float* rss_sptr(Frame& F, int idx) { return (float*)(F.ws + WS_RSS) + RSS_P_FLOATS + (size_t)idx * MS * 128; }
__device__ __forceinline__ float wave_sum(float v, int lane) {
#pragma unroll
    for (int o = 1; o < 64; o <<= 1) v += SHX(v, o);
    return v;
}
__device__ __forceinline__ int q_next(Frame& F, int q) {
    volatile MK_LAS int* slot = (volatile MK_LAS int*)(F.lds + MISC_OFF + 64);
    __syncthreads();
    if (F.tid == 0) *slot = (int)__hip_atomic_fetch_add(F.ctl + CW_Q + 64 * q, 1u, __ATOMIC_RELAXED, __HIP_MEMORY_SCOPE_AGENT);
    __syncthreads();
    return *slot;
}

__device__ __forceinline__ void p0_item(const float* W, int K, int ldw, int n_src0, bf16_t* WT, int n_dst0, int k0, const float* gain, MK_LAS float* scr, int lane) {
#pragma unroll 8
    for (int i = 0; i < 32; ++i) { const int kk = 2 * i + (lane >> 5); const float gv = gain ? gain[k0 + kk] : 1.0f; scr[kk * 33 + (lane & 31)] = W[(size_t)(k0 + kk) * ldw + n_src0 + (lane & 31)] * gv; }
    LDS_WAIT(); asm volatile("" ::: "memory");
    const int c = lane & 7;
#pragma unroll
    for (int j = 0; j < 4; ++j) { const int n = (lane >> 3) + 8 * j; const MK_LAS float* s = scr + (8 * c) * 33 + n;
        u32x4 o; o.x = pk2(s[0 * 33], s[1 * 33]); o.y = pk2(s[2 * 33], s[3 * 33]); o.z = pk2(s[4 * 33], s[5 * 33]); o.w = pk2(s[6 * 33], s[7 * 33]);
        *(u32x4*)(WT + (size_t)(n_dst0 + n) * K + k0 + 8 * c) = o; }
    LDS_WAIT(); asm volatile("" ::: "memory");
}
__device__ __forceinline__ void p0_prologue(Frame& F) {
    MK_LAS float* scr = (MK_LAS float*)(F.lds + F.wave * 16384);
    const int gw = F.vcu * 8 + F.wave, NGW = F.G * 8; const int lane = F.lane;
    constexpr int I_AB = 32 * 160, I_O = 32 * 64, I_CD = 32 * 224, I_UP = 32 * 344, I_DN = 86 * 64;
    constexpr int PER_PAIR = I_AB + I_O + I_CD + I_O, PER_LAYER = I_UP + I_DN, NITEMS = 2 * PER_PAIR + 4 * PER_LAYER;
    for (int it = gw; it < NITEMS; it += NGW) {
        int r = it;
        if (r < 2 * PER_PAIR) { const int i = r / PER_PAIR; r -= i * PER_PAIR;
            if (r < I_AB) { const int kb = r / 160, nb = r % 160; p0_item(F.in[I_WINAB] + (size_t)i * D * N_AB, D, N_AB, 32 * nb, (bf16_t*)(F.ws + WS_WINAB + i * SZ_WINAB), 32 * nb, 64 * kb, F.in[I_NMIX] + (2 * i) * D, scr, lane); continue; } r -= I_AB;
            if (r < I_O) { const int kb = r / 64, nb = r % 64; p0_item(F.in[I_WOUTAB] + (size_t)i * D * D, D, D, 32 * nb, (bf16_t*)(F.ws + WS_WOUTAB + i * SZ_WOUT), 32 * nb, 64 * kb, nullptr, scr, lane); continue; } r -= I_O;
            if (r < I_CD) { const int kb = r / 224, nb = r % 224; p0_item(F.in[I_WINCD] + (size_t)i * D * N_CD_SRC, D, N_CD_SRC, 32 * nb, (bf16_t*)(F.ws + WS_WINCD + i * SZ_WINCD), 32 * nb, 64 * kb, F.in[I_NMIX] + (2 * i + 1) * D, scr, lane); continue; } r -= I_CD;
            { const int kb = r / 64, nb = r % 64; p0_item(F.in[I_WOUTCD] + (size_t)i * D * D, D, D, 32 * nb, (bf16_t*)(F.ws + WS_WOUTCD + i * SZ_WOUT), 32 * nb, 64 * kb, nullptr, scr, lane); continue; }
        }
        r -= 2 * PER_PAIR; const int l = r / PER_LAYER; r -= l * PER_LAYER;
        if (r < I_UP) { const int kb = r / 344, nb = r % 344; const int tile = nb >> 3, j32 = nb & 7;
            const int nsrc = (j32 < 4) ? tile * 128 + 32 * j32 : FF + tile * 128 + 32 * (j32 - 4);
            p0_item(F.in[I_WUP] + (size_t)l * D * N_UP, D, N_UP, nsrc, (bf16_t*)(F.ws + WS_WUP + l * SZ_WUP), 32 * nb, 64 * kb, F.in[I_NFFN] + l * D, scr, lane); continue; } r -= I_UP;
        { const int kb = r / 64, nb = r % 64; p0_item(F.in[I_WDN] + (size_t)l * FF * D, FF, D, 32 * nb, (bf16_t*)(F.ws + WS_WDN + l * SZ_WDN), 32 * nb, 64 * kb, nullptr, scr, lane); }
    }
    const int gt = F.vcu * 512 + F.tid, NGT = F.G * 512;
    for (int it = gt; it < 2 * 512 * (D / 8); it += NGT) { const int k8 = it % (D / 8), n = (it / (D / 8)) % 512, i = it / (512 * (D / 8));
        const float* W = F.in[I_WINCD] + (size_t)i * D * N_CD_SRC; const float* g2 = F.in[I_WG2] + (size_t)i * 16 * 512; const float* gn = F.in[I_NMIX] + (2 * i + 1) * D; float v[8];
#pragma unroll
        for (int j = 0; j < 8; ++j) { const int k = 8 * k8 + j; float s = 0.f;
#pragma unroll
            for (int r = 0; r < 16; ++r) s += W[(size_t)k * N_CD_SRC + N_CDZ + r] * g2[r * 512 + n];
            v[j] = s * gn[k]; }
        u32x4 o; o.x = pk2(v[0], v[1]); o.y = pk2(v[2], v[3]); o.z = pk2(v[4], v[5]); o.w = pk2(v[6], v[7]);
        *(u32x4*)((bf16_t*)(F.ws + WS_WINCD + i * SZ_WINCD) + (size_t)(N_CDZ + n) * D + 8 * k8) = o; }
    for (int it = gt; it < 2 * 8 * 2 * 128 * 16; it += NGT) { const int i8 = it % 16, o_ = (it / 16) % 128, gate = (it / 2048) % 2, h = (it / 4096) % 8, i = it / 32768;
        const float* W = F.in[gate ? I_LWX : I_LWA] + ((size_t)(i * 8 + h) * 128) * 128; float v[8];
#pragma unroll
        for (int j = 0; j < 8; ++j) v[j] = W[(size_t)(8 * i8 + j) * 128 + o_];
        u32x4 o; o.x = pk2(v[0], v[1]); o.y = pk2(v[2], v[3]); o.z = pk2(v[4], v[5]); o.w = pk2(v[6], v[7]);
        *(u32x4*)((bf16_t*)(F.ws + WS_WLRU) + ((size_t)((i * 8 + h) * 2 + gate) * 128 + o_) * 128 + 8 * i8) = o; }
    for (int k = gt; k < 1024; k += NGT) { const float a = F.in[I_LBL][k], b = F.in[I_LBL][1024 + k]; const float m = fmaxf(a, b), ea = expf(a - m), eb = expf(b - m), p0 = ea / (ea + eb), p1 = eb / (ea + eb);
        float* lb = (float*)(F.ws + WS_LB); lb[k] = p0 - p0; lb[1024 + k] = (p0 + p1) - p0; }
    for (int m = gw; m < MT; m += NGW) { const float* xr = (m < MP) ? F.in[I_XP] + (size_t)m * D : F.in[I_XS] + (size_t)(m - MP) * D; bf16_t* orow = (bf16_t*)(F.ws + WS_XB16) + (size_t)m * D; float s = 0.f;
#pragma unroll
        for (int j = 0; j < 8; ++j) { const f32x4 v = *(const f32x4*)(xr + 4 * lane + 256 * j); s += (v[0] * v[0] + v[1] * v[1]) + (v[2] * v[2] + v[3] * v[3]);
            u32x2 w; w.x = pk2(v[0], v[1]); w.y = pk2(v[2], v[3]); *(u32x2*)(orow + 4 * lane + 256 * j) = w; }
        s = wave_sum(s, lane);
        if (m < MP) { if (lane < 8) rss_ptr(F, 0)[(size_t)m * 8 + lane] = lane == 0 ? s : 0.f; } else { rss_sptr(F, 0)[(size_t)(m - MP) * 128 + lane] = lane == 0 ? s : 0.f; rss_sptr(F, 0)[(size_t)(m - MP) * 128 + 64 + lane] = 0.f; } }
}

__device__ __forceinline__ void sample_units_range(Frame& F, int nwg_main, int nsu, int& s0, int& sstep) {
    const int rem = nwg_main % F.G; const int c = opaque_bid();
    if (rem == 0) { s0 = c; sstep = F.G; } else if (c >= rem) { s0 = c - rem; sstep = F.G - rem; } else { s0 = nsu; sstep = 1; }
}
__device__ __forceinline__ void sample_in_ab(Frame& F, int i, const bf16_t* Wt, const float* rss) {
    MK_LAS float* red = (MK_LAS float*)F.lds; int s0, sstep; sample_units_range(F, 32 * (N_AB / 256), N_AB / 128, s0, sstep);
    const bf16_t* A = (const bf16_t*)(F.ws + WS_XB16) + (size_t)MP * D; float* zs = (float*)(F.ws + WS_ZS);
    for (int su = s0; su < N_AB / 128; su += sstep) {
        sgemm_tile<8>(red, A, Wt, D, 128 * su, F.wave, F.lane);
        const int lane = F.lane; const int row = F.tid >> 3, part = F.tid & 7, kind = su >> 3, cw = (su & 7) * 128 + 16 * part; const float rs = fast_rsq(rss_s(rss, row) * (1.0f / D) + EPS);
        float v[16]; float ss = 0.f;
#pragma unroll
        for (int j = 0; j < 16; ++j) { v[j] = sred4<8>(red, row, 16 * part + j) * rs; ss += v[j] * v[j]; }
        if (kind <= 1) { ss += SHX(ss, 1); ss += SHX(ss, 2); ss += SHX(ss, 4); const float hs = fast_rsq(ss * (1.0f / DH) + EPS); const float* gp = F.in[kind ? I_KN : I_QN] + i * DH + 16 * part;
#pragma unroll
            for (int j = 0; j < 16; ++j) v[j] = v[j] * hs * gp[j]; }
        float* zo = zs + (size_t)row * N_CD + 128 * su + 16 * part;
#pragma unroll
        for (int j = 0; j < 16; ++j) zo[j] = v[j];
        if (kind == 1 || kind == 2) { float* o = F.out + O_KVS + (((size_t)i * MS + row) * 2 + (kind - 1)) * WA + cw;
#pragma unroll
            for (int j = 0; j < 16; ++j) o[j] = v[j]; }
        if (kind == 3 && (row & 7) >= 5) { float* o = F.out + O_CONVS + (((size_t)i * SB + (row >> 3)) * 3 + ((row & 7) - 5)) * WB + cw;
#pragma unroll
            for (int j = 0; j < 16; ++j) o[j] = v[j]; }
        __syncthreads();
    }
}
__device__ __forceinline__ void sample_plain(Frame& F, const bf16_t* Wt, const float* rss, int N, int nwg_main, float* dst, int ldd, bool up_map) {
    MK_LAS float* red = (MK_LAS float*)F.lds; int s0, sstep; sample_units_range(F, nwg_main, N / 128, s0, sstep);
    const bf16_t* A = (const bf16_t*)(F.ws + WS_XB16) + (size_t)MP * D;
    for (int su = s0; su < N / 128; su += sstep) {
        sgemm_tile<8>(red, A, Wt, D, 128 * su, F.wave, F.lane);
        const int row = F.tid >> 3, part = F.tid & 7; const float rs = fast_rsq(rss_s(rss, row) * (1.0f / D) + EPS);
        const int col = up_map ? ((su & 1) * FF + (su >> 1) * 128) : 128 * su;
        float* o = dst + (size_t)row * ldd + col + 16 * part;
#pragma unroll
        for (int j = 0; j < 16; ++j) o[j] = sred4<8>(red, row, 16 * part + j) * rs;
        __syncthreads();
    }
}
__device__ __forceinline__ void sample_res(Frame& F, const bf16_t* A, const bf16_t* Wt, int K, const float* base, float* rss_next) {
    MK_LAS float* red = (MK_LAS float*)F.lds; int s0, sstep; sample_units_range(F, 256, D / 16, s0, sstep);
    float* xout = F.out + O_YS; bf16_t* xb = (bf16_t*)(F.ws + WS_XB16) + (size_t)MP * D;
    for (int su = s0; su < D / 16; su += sstep) {
        sgemm_tile<1>(red, A, Wt, K, 16 * su, F.wave, F.lane);
        const int lane = F.lane; const int row = F.tid >> 3, c2 = 2 * (F.tid & 7); const size_t o = (size_t)row * D + 16 * su + c2;
        const float v0 = base[o] + sred4<1>(red, row, c2), v1 = base[o + 1] + sred4<1>(red, row, c2 + 1);
        xout[o] = v0; xout[o + 1] = v1; *(unsigned*)(xb + o) = pk2(v0, v1);
        float ss = v0 * v0 + v1 * v1; ss += SHX(ss, 1); ss += SHX(ss, 2); ss += SHX(ss, 4);
        if ((F.tid & 7) == 0) rss_next[(size_t)row * 128 + su] = ss;
        __syncthreads();
    }
}

__device__ __forceinline__ void ffn_fixup(Frame& F, int layer) {
    const int gt = F.vcu * 512 + F.tid, NGT = F.G * 512;
    const float* cw = F.in[I_FCW] + (size_t)layer * 3 * FF; const float* cb = F.in[I_FCB] + (size_t)layer * FF;
    const float* ghead = (const float*)(F.ws + WS_GHEAD); const float* gtail = (const float*)(F.ws + WS_GTAIL); bf16_t* HBp = (bf16_t*)(F.ws + WS_Z);
    for (int it = gt; it < 30 * 2 * FF; it += NGT) { const int f = it % FF, r = (it / FF) & 1, ti = it / (2 * FF); const int pm = ti + 1 + (ti >= 15 ? 1 : 0);
        const float g0 = ghead[((size_t)pm * 2 + 0) * (2 * FF) + f], t0 = gtail[((size_t)(pm - 1) * 2 + 0) * FF + f], t1 = gtail[((size_t)(pm - 1) * 2 + 1) * FF + f];
        float gc, uu;
        if (r == 0) { gc = cb[f] + cw[f] * t0 + cw[FF + f] * t1 + cw[2 * FF + f] * g0; uu = ghead[((size_t)pm * 2 + 0) * (2 * FF) + FF + f]; }
        else { const float g1 = ghead[((size_t)pm * 2 + 1) * (2 * FF) + f]; gc = cb[f] + cw[f] * t1 + cw[FF + f] * g0 + cw[2 * FF + f] * g1; uu = ghead[((size_t)pm * 2 + 1) * (2 * FF) + FF + f]; }
        HBp[(size_t)(pm * 256 + r) * FF + f] = (bf16_t)f2bf(silu_f(gc) * uu); }
    const float* gus = (const float*)(F.ws + WS_GUS); const float* sbuf = F.in[I_SFF] + (size_t)layer * SB * 2 * FF;
    for (int it = gt; it < MS * FF; it += NGT) { const int f = it % FF, row = it / FF, t = row & 7, b = row >> 3;
        const float x0 = gus[(size_t)row * N_UP + f];
        const float x1 = (t >= 1) ? gus[(size_t)(row - 1) * N_UP + f] : sbuf[((size_t)b * 2 + 1) * FF + f];
        const float x2 = (t >= 2) ? gus[(size_t)(row - 2) * N_UP + f] : sbuf[((size_t)b * 2 + t) * FF + f];
        const float gc = cb[f] + cw[f] * x2 + cw[FF + f] * x1 + cw[2 * FF + f] * x0;
        HBp[(size_t)(MP + row) * FF + f] = (bf16_t)f2bf(silu_f(gc) * gus[(size_t)row * N_UP + FF + f]);
        if (t >= 6) F.out[O_FFS + (((size_t)layer * SB + b) * 2 + (t - 6)) * FF + f] = x0; }
}
}
namespace mk {
__device__ __forceinline__ s16x4 tr_read4(unsigned addr) { s16x4 r; asm volatile("ds_read_b64_tr_b16 %0, %1\n\ts_waitcnt lgkmcnt(0)" : "=&v"(r) : "v"(addr) : "memory"); return r; }

constexpr int ATT_VSTRIDE = 288;
__device__ __forceinline__ void attn_item(Frame& F, const bf16_t* Z, bf16_t* MIX, int item, MK_LAS unsigned char* vt) {
    const int lane = F.lane, qi = lane & 15, g = lane >> 4;
    const int rho = item & 15, blk = (item >> 4) & 15, h = (item >> 8) & 7, b = item >> 11;
    const int t0 = 256 * blk + rho, tq = t0 + 16 * qi;
    const bf16_t* Zb = Z + (size_t)b * SEQ * N_AB;
    bf16x8 qf[4];
#pragma unroll
    for (int s = 0; s < 4; ++s) qf[s] = *(const bf16x8*)(Zb + (size_t)tq * N_AB + h * DH + 32 * s + 8 * g);
    f32x4 o[8];
#pragma unroll
    for (int d = 0; d < 8; ++d) o[d] = (f32x4){0.f, 0.f, 0.f, 0.f};
    float mrun = -1e30f, lrun = 0.f;
    const float sc = 0.08838834764831845f * 1.44269504089f;
    const unsigned vbase = (unsigned)(size_t)vt;
    for (int st = 0; st < 23; ++st) {
        int base, dil, win;
        if (st < 12) { base = t0 - 128 + 32 * st; dil = 1; win = 128; } else if (st < 18) { base = t0 - 512 + 4 * 32 * (st - 12); dil = 4; win = 512; } else { base = t0 - 2048 + 16 * 32 * (st - 18); dil = 16; win = 2048; }
        bf16x8 kf[2][4];
#pragma unroll
        for (int kt = 0; kt < 2; ++kt) { int s = base + dil * (16 * kt + qi); s = s < 0 ? 0 : (s > SEQ - 1 ? SEQ - 1 : s); const bf16_t* kp = Zb + (size_t)s * N_AB + WA + h * DH + 8 * g;
#pragma unroll
            for (int q = 0; q < 4; ++q) kf[kt][q] = *(const bf16x8*)(kp + 32 * q); }
        u32x4 vv[8];
#pragma unroll
        for (int j = 0; j < 8; ++j) { const int c = lane + 64 * j, r = c >> 4, ch = c & 15; int s = base + dil * r; s = s < 0 ? 0 : (s > SEQ - 1 ? SEQ - 1 : s);
            vv[j] = *(const u32x4*)(Zb + (size_t)s * N_AB + 2 * WA + h * DH + 8 * ch); }
#pragma unroll
        for (int j = 0; j < 8; ++j) { const int c = lane + 64 * j, r = c >> 4, ch = c & 15; *(MK_LAS u32x4*)(vt + r * ATT_VSTRIDE + 16 * ch) = vv[j]; }
        f32x4 sv[2];
#pragma unroll
        for (int kt = 0; kt < 2; ++kt) { sv[kt] = (f32x4){0.f, 0.f, 0.f, 0.f};
#pragma unroll
            for (int q = 0; q < 4; ++q) sv[kt] = __builtin_amdgcn_mfma_f32_16x16x32_bf16(kf[kt][q], qf[q], sv[kt], 0, 0, 0); }
        float mx = -1e30f; bool val[2][4];
#pragma unroll
        for (int kt = 0; kt < 2; ++kt)
#pragma unroll
            for (int e = 0; e < 4; ++e) { const int s = base + dil * (16 * kt + 4 * g + e); const int dist = tq - s; val[kt][e] = (s >= 0) && (dist >= 0) && (dist <= win);
                sv[kt][e] = val[kt][e] ? sv[kt][e] * sc : -1e30f; mx = fmaxf(mx, sv[kt][e]); }
        mx = fmaxf(mx, SHX(mx, 16)); mx = fmaxf(mx, SHX(mx, 32));
        const float mnew = fmaxf(mrun, mx), alpha = fast_exp2(mrun - mnew); mrun = mnew;
        float ps = 0.f; float p[2][4];
#pragma unroll
        for (int kt = 0; kt < 2; ++kt)
#pragma unroll
            for (int e = 0; e < 4; ++e) { p[kt][e] = val[kt][e] ? fast_exp2(sv[kt][e] - mnew) : 0.f; ps += p[kt][e]; }
        lrun = lrun * alpha + ps;
        union { bf16x8 v; unsigned u[4]; } pf; pf.u[0] = cvt_pk_bf16(p[0][0], p[0][1]); pf.u[1] = cvt_pk_bf16(p[0][2], p[0][3]); pf.u[2] = cvt_pk_bf16(p[1][0], p[1][1]); pf.u[3] = cvt_pk_bf16(p[1][2], p[1][3]);
        LDS_WAIT();
        asm volatile("" ::: "memory");
        const int q4 = qi >> 2, p4 = qi & 3;
#pragma unroll
        for (int d = 0; d < 8; ++d) { const unsigned a0 = vbase + (4 * g + q4) * ATT_VSTRIDE + (16 * d + 4 * p4) * 2, a1 = a0 + 16 * ATT_VSTRIDE;
            union { bf16x8 v; s16x4 h[2]; } vf; vf.h[0] = tr_read4(a0); vf.h[1] = tr_read4(a1);
            o[d] = o[d] * alpha; o[d] = __builtin_amdgcn_mfma_f32_16x16x32_bf16(vf.v, pf.v, o[d], 0, 0, 0); }
        asm volatile("" ::: "memory");
    }
    lrun += SHX(lrun, 16); lrun += SHX(lrun, 32);
    const float inv = fast_rcp(lrun);
    bf16_t* op = MIX + ((size_t)b * SEQ + tq) * D + h * DH + 4 * g;
#pragma unroll
    for (int d = 0; d < 8; ++d) { u32x2 w; w.x = cvt_pk_bf16(o[d][0] * inv, o[d][1] * inv); w.y = cvt_pk_bf16(o[d][2] * inv, o[d][3] * inv); *(u32x2*)(op + 16 * d) = w; }
}

__device__ __forceinline__ void sattn_item(Frame& F, int i, int item) {
    const int lane = F.lane, li = lane & 15, g = lane >> 4; const int h = item & 7, t = (item >> 3) & 7, b = item >> 6; const int row = b * 8 + t;
    const float* zs = (const float*)(F.ws + WS_ZS); const float* cache = F.in[I_KV] + (size_t)(i * SB + b) * LA * 2 * WA; const float* kvn = F.out + O_KVS + (size_t)(i * SB + b) * ST * 2 * WA;
    float q[8]; { const f32x4 a = *(const f32x4*)(zs + (size_t)row * N_CD + h * DH + 8 * li), c = *(const f32x4*)(zs + (size_t)row * N_CD + h * DH + 8 * li + 4);
#pragma unroll
        for (int j = 0; j < 4; ++j) { q[j] = a[j]; q[4 + j] = c[j]; } }
    float m = -1e30f, l = 0.f, acc[8];
#pragma unroll
    for (int j = 0; j < 8; ++j) acc[j] = 0.f;
    const float sc = 0.08838834764831845f;
    for (int kk = g; kk < 3 * 129; kk += 4) { const int grp = kk / 129, j = kk - grp * 129; const int dil = grp == 0 ? 1 : (grp == 1 ? 4 : 16); const int idx = LA + t - dil * j;
        const float* kp = (idx < LA) ? cache + ((size_t)idx * 2) * WA + h * DH + 8 * li : kvn + ((size_t)(idx - LA) * 2) * WA + h * DH + 8 * li;
        const f32x4 k0 = *(const f32x4*)kp, k1 = *(const f32x4*)(kp + 4), v0 = *(const f32x4*)(kp + WA), v1 = *(const f32x4*)(kp + WA + 4);
        float s = (q[0] * k0[0] + q[1] * k0[1]) + (q[2] * k0[2] + q[3] * k0[3]) + (q[4] * k1[0] + q[5] * k1[1]) + (q[6] * k1[2] + q[7] * k1[3]);
        s += SHX(s, 1); s += SHX(s, 2); s += SHX(s, 4); s += SHX(s, 8); s *= sc;
        const float mn = fmaxf(m, s), al = fast_exp(m - mn), pw = fast_exp(s - mn); l = l * al + pw; m = mn;
#pragma unroll
        for (int jj = 0; jj < 4; ++jj) { acc[jj] = acc[jj] * al + pw * v0[jj]; acc[4 + jj] = acc[4 + jj] * al + pw * v1[jj]; } }
    float mm = fmaxf(m, SHX(m, 16)); mm = fmaxf(mm, SHX(mm, 32)); const float f = fast_exp(m - mm); l *= f; l += SHX(l, 16); l += SHX(l, 32);
#pragma unroll
    for (int j = 0; j < 8; ++j) { acc[j] *= f; acc[j] += SHX(acc[j], 16); acc[j] += SHX(acc[j], 32); }
    if (g == 0) { const float inv = fast_rcp(l); u32x4 w; w.x = pk2(acc[0] * inv, acc[1] * inv); w.y = pk2(acc[2] * inv, acc[3] * inv); w.z = pk2(acc[4] * inv, acc[5] * inv); w.w = pk2(acc[6] * inv, acc[7] * inv);
        *(u32x4*)((bf16_t*)(F.ws + WS_MIX) + (size_t)(MP + row) * D + h * DH + 8 * li) = w; }
}

constexpr int LRU_SEG = 256, LRU_NSEG = SEQ / LRU_SEG;
__device__ __forceinline__ void lru_unit(Frame& F, int i, int unit, const bf16_t* Z, bf16_t* MIX) {
    const int seg = unit & 15, hB = (unit >> 4) & 7, b = unit >> 7; const int tid = F.tid, lane = F.lane, w = F.wave, fr = lane & 15, g = lane >> 4;
    MK_LAS float* xc = (MK_LAS float*)F.lds; constexpr int LDX = 132;
    const int ch0 = hB * 128; const int c = ch0 + 16 * w + fr;
    bf16_t* CB = (bf16_t*)(F.ws + WS_SC); float* SUM = (float*)(F.ws + WS_LG);
    const bf16_t* Wl = (const bf16_t*)(F.ws + WS_WLRU) + (size_t)((i * 8 + hB) * 2) * 128 * 128;
    bf16x8 wf[2][4];
#pragma unroll
    for (int gt = 0; gt < 2; ++gt)
#pragma unroll
        for (int s = 0; s < 4; ++s) wf[gt][s] = *(const bf16x8*)(Wl + ((size_t)gt * 128 + 16 * w + fr) * 128 + 32 * s + 8 * g);
    const float ba = F.in[I_LBA][i * WB + c], bx = F.in[I_LBX][i * WB + c]; const float lam = F.in[I_LLAM][i * WB + c];
    const float dk = -8.0f * softplus_acc(-lam);
    const int sc8 = 8 * (tid & 15), stl = tid >> 4;
    float cwv[4][8], cbv[8];
#pragma unroll
    for (int j = 0; j < 8; ++j) { cbv[j] = F.in[I_LCB][i * WB + ch0 + sc8 + j];
#pragma unroll
        for (int tp = 0; tp < 4; ++tp) cwv[tp][j] = F.in[I_LCW][((size_t)i * 4 + tp) * WB + ch0 + sc8 + j]; }
    float hcar = 0.f, pcar = 1.f;
    const bf16_t* Zb = Z + (size_t)b * SEQ * N_AB;
    for (int ck = 0; ck < LRU_SEG / 128; ++ck) { const int tb = seg * LRU_SEG + 128 * ck;
#pragma unroll
        for (int ps = 0; ps < 4; ++ps) { const int tl = stl + 32 * ps, t = tb + tl; float a[8];
#pragma unroll
            for (int j = 0; j < 8; ++j) a[j] = cbv[j];
#pragma unroll
            for (int tp = 0; tp < 4; ++tp) { const int tt = t - 3 + tp; if (tt >= 0) { const u32x4 v = *(const u32x4*)(Zb + (size_t)tt * N_AB + 3 * WA + ch0 + sc8);
                    a[0] += cwv[tp][0] * bflo(v.x); a[1] += cwv[tp][1] * bfhi(v.x); a[2] += cwv[tp][2] * bflo(v.y); a[3] += cwv[tp][3] * bfhi(v.y);
                    a[4] += cwv[tp][4] * bflo(v.z); a[5] += cwv[tp][5] * bfhi(v.z); a[6] += cwv[tp][6] * bflo(v.w); a[7] += cwv[tp][7] * bfhi(v.w); } }
            *(MK_LAS f32x4*)(xc + tl * LDX + sc8) = (f32x4){a[0], a[1], a[2], a[3]}; *(MK_LAS f32x4*)(xc + tl * LDX + sc8 + 4) = (f32x4){a[4], a[5], a[6], a[7]}; }
        LDS_WAIT(); __syncthreads();
#pragma unroll 2
        for (int mt = 0; mt < 8; ++mt) {
            float gbv[4];
#pragma unroll
            for (int e = 0; e < 4; ++e) gbv[e] = bf2f(Zb[(size_t)(tb + 16 * mt + 4 * g + e) * N_AB + 3 * WA + WB + c]);
            f32x4 cr = (f32x4){0.f, 0.f, 0.f, 0.f}, ci = (f32x4){0.f, 0.f, 0.f, 0.f};
#pragma unroll
            for (int s = 0; s < 4; ++s) { const MK_LAS float* xp = xc + (16 * mt + fr) * LDX + 32 * s + 8 * g; const f32x4 x0 = *(const MK_LAS f32x4*)xp, x1 = *(const MK_LAS f32x4*)(xp + 4);
                union { bf16x8 v; unsigned u[4]; } af; af.u[0] = cvt_pk_bf16(x0[0], x0[1]); af.u[1] = cvt_pk_bf16(x0[2], x0[3]); af.u[2] = cvt_pk_bf16(x1[0], x1[1]); af.u[3] = cvt_pk_bf16(x1[2], x1[3]);
                cr = __builtin_amdgcn_mfma_f32_16x16x32_bf16(af.v, wf[0][s], cr, 0, 0, 0); ci = __builtin_amdgcn_mfma_f32_16x16x32_bf16(af.v, wf[1][s], ci, 0, 0, 0); }
            float P[4], H[4]; float pa = 1.f, hh = 0.f;
#pragma unroll
            for (int e = 0; e < 4; ++e) { const float r = sigmoid_f(cr[e] + ba), ig = sigmoid_f(ci[e] + bx); const float la = dk * r; const float a = fast_exp(la);
                const float xv = xc[(16 * mt + 4 * g + e) * LDX + 16 * w + fr]; const float u = fast_sqrt(one_minus_exp(2.0f * la)) * ig * xv;
                pa = pa * a; hh = a * hh + u; P[e] = pa; H[e] = hh; }
            float ip = pa, ih = hh;
            { const float pp = SHUP(ip, 16), ph = SHUP(ih, 16); if (g >= 1) { ih = ip * ph + ih; ip = ip * pp; } }
            { const float pp = SHUP(ip, 32), ph = SHUP(ih, 32); if (g >= 2) { ih = ip * ph + ih; ip = ip * pp; } }
            float ep = SHUP(ip, 16), eh = SHUP(ih, 16); if (g == 0) { ep = 1.f; eh = 0.f; }
            const float hin = ep * hcar + eh;
            const float pin = pcar * ep;
            const float tot_p = SHL(ip, 48 + fr), tot_h = SHL(ih, 48 + fr);
            hcar = tot_p * hcar + tot_h; pcar = pcar * tot_p;
#pragma unroll
            for (int e = 0; e < 4; ++e) { const float hv = P[e] * hin + H[e]; const size_t row = (size_t)b * SEQ + tb + 16 * mt + 4 * g + e; const float ge = gelu_tanh_f(gbv[e]);
                MIX[row * D + WA + c] = (bf16_t)f2bf(hv * ge); CB[row * WB + c] = (bf16_t)f2bf(pin * P[e] * ge); }
        }
        __syncthreads();
    }
    if (g == 0) { float* sp = SUM + ((size_t)((b * 8 + hB) * LRU_NSEG + seg) * 2) * 128 + 16 * w + fr; sp[0] = pcar; sp[128] = hcar; }
}
__device__ __forceinline__ void lru_fix_item(Frame& F, int i, int item) {
    const int tid = F.tid; MK_LAS float* hin = (MK_LAS float*)F.lds;
    const float* SUM = (const float*)(F.ws + WS_LG); const bf16_t* CB = (const bf16_t*)(F.ws + WS_SC); bf16_t* MIX = (bf16_t*)(F.ws + WS_MIX);
    int b, seg, sub; if (item < 240) { b = item / 120; const int r = item % 120; seg = 1 + r / 8; sub = r % 8; } else { b = item - 240; seg = LRU_NSEG; sub = 0; }
    for (int c = tid; c < WB; c += 512) { const int hB = c >> 7, cc = c & 127; float h = 0.f; const float* sp = SUM + ((size_t)((b * 8 + hB) * LRU_NSEG) * 2) * 128 + cc;
        for (int s = 0; s < seg; ++s) h = sp[(size_t)s * 256] * h + sp[(size_t)s * 256 + 128];
        if (item < 240) hin[c] = h; else F.out[O_HP + ((size_t)i * NB + b) * WB + c] = h; }
    LDS_WAIT(); __syncthreads();
    if (item < 240) {
#pragma unroll
        for (int j = 0; j < 8; ++j) { const int gi = tid + 512 * j, tl = gi >> 7, c8 = (gi & 127) * 8; const size_t row = (size_t)b * SEQ + seg * LRU_SEG + 32 * sub + tl;
            const u32x4 cv = *(const u32x4*)(CB + row * WB + c8); u32x4 mv = *(const u32x4*)(MIX + row * D + WA + c8); const f32x4 h0 = *(const MK_LAS f32x4*)(hin + c8), h1 = *(const MK_LAS f32x4*)(hin + c8 + 4);
            mv.x = pk2(bflo(mv.x) + bflo(cv.x) * h0[0], bfhi(mv.x) + bfhi(cv.x) * h0[1]); mv.y = pk2(bflo(mv.y) + bflo(cv.y) * h0[2], bfhi(mv.y) + bfhi(cv.y) * h0[3]);
            mv.z = pk2(bflo(mv.z) + bflo(cv.z) * h1[0], bfhi(mv.z) + bfhi(cv.z) * h1[1]); mv.w = pk2(bflo(mv.w) + bflo(cv.w) * h1[2], bfhi(mv.w) + bfhi(cv.w) * h1[3]);
            *(u32x4*)(MIX + row * D + WA + c8) = mv; } }
    __syncthreads();
}
__device__ __forceinline__ void slru_unit(Frame& F, int i, int unit) {
    const int b = unit >> 3, hB = unit & 7, tid = F.tid; const float* zs = (const float*)(F.ws + WS_ZS);
    MK_LAS float* xc = (MK_LAS float*)F.lds;
    MK_LAS float* gr = xc + 1024;
    MK_LAS float* gi = gr + 1024;
    const int ch0 = hB * 128;
    for (int e = tid; e < 1024; e += 512) { const int cc = e & 127, t = e >> 7; const int c = ch0 + cc; float y = F.in[I_LCB][i * WB + c];
#pragma unroll
        for (int tp = 0; tp < 4; ++tp) { const int tt = t - 3 + tp; const float v = (tt >= 0) ? zs[(size_t)(b * 8 + tt) * N_CD + 3 * WA + c] : F.in[I_SCONV][(((size_t)i * SB + b) * 3 + (tt + 3)) * WB + c];
            y += F.in[I_LCW][((size_t)i * 4 + tp) * WB + c] * v; }
        xc[t * 128 + cc] = y; }
    __syncthreads();
    for (int e = tid; e < 2048; e += 512) { const int cc = e & 127, t = (e >> 7) & 7, gate = e >> 10; const float* W = F.in[gate ? I_LWX : I_LWA] + (size_t)(i * 8 + hB) * 128 * 128; float s = 0.f;
        for (int k = 0; k < 128; ++k) s += xc[t * 128 + k] * W[(size_t)k * 128 + cc];
        const int c = ch0 + cc; s += F.in[gate ? I_LBX : I_LBA][i * WB + c]; (gate ? gi : gr)[t * 128 + cc] = sigmoid_f(s); }
    __syncthreads();
    if (tid < 128) { const int cc = tid, c = ch0 + cc; const float lam = F.in[I_LLAM][i * WB + c]; const float spl = softplus_acc(-lam);
        float h = F.in[I_SH][((size_t)i * SB + b) * WB + c];
        for (int t = 0; t < 8; ++t) { const float la = -8.0f * gr[t * 128 + cc] * spl, a = fast_exp(la); const float u = fast_sqrt(one_minus_exp(2.0f * la)) * gi[t * 128 + cc] * xc[t * 128 + cc];
            h = a * h + u; const float gb = zs[(size_t)(b * 8 + t) * N_CD + 3 * WA + WB + c];
            const float ge = gelu_tanh_f(gb);
            ((bf16_t*)(F.ws + WS_MIX))[(size_t)(MP + b * 8 + t) * D + WA + c] = (bf16_t)f2bf(h * ge); }
        F.out[O_HS + ((size_t)i * SB + b) * WB + c] = h; }
    __syncthreads();
}

template <int WHAT  > __device__ __forceinline__ void mixer_ab(Frame& F, int i, int qid) {
    const bf16_t* Z = (const bf16_t*)(F.ws + WS_Z); bf16_t* MIX = (bf16_t*)(F.ws + WS_MIX);
    constexpr int N_LRU = 256, N_SLRU = 64, N_SATT = 64, N_ATT = 512, N_ALL = N_LRU + N_SLRU + N_SATT + N_ATT;
    for (;;) { const int u = q_next(F, qid); if (u >= N_ALL) break;
        if (WHAT == 1 && u < N_LRU + N_SLRU + N_SATT) continue; if (WHAT == 2 && u >= N_LRU) break;
        if (u < N_LRU) lru_unit(F, i, u, Z, MIX);
        else if (u < N_LRU + N_SLRU) slru_unit(F, i, u - N_LRU);
        else if (u < N_LRU + N_SLRU + N_SATT) sattn_item(F, i, (u - N_LRU - N_SLRU) * 8 + F.wave);
        else attn_item(F, Z, MIX, (u - N_LRU - N_SLRU - N_SATT) * 8 + F.wave, F.lds + F.wave * (32 * ATT_VSTRIDE)); }
}
__device__ __forceinline__ void mixer_ab_fix(Frame& F, int i, int qid) { for (;;) { const int u = q_next(F, qid); if (u >= 242) break; lru_fix_item(F, i, u); } }
}
namespace mk {
struct GlaCfg { int H, V, qcol, kcol, vcol, gcol, lgld, mixcol; const float* lg; const float* gain; bf16_t* sc; };
__device__ __forceinline__ GlaCfg gla_cfg(Frame& F, int i, int kind) {
    GlaCfg c;
    if (kind == 0) { c.H = HC; c.V = DVC; c.qcol = ZC_QC; c.kcol = ZC_KC; c.vcol = ZC_IC; c.gcol = ZC_GC; c.lgld = 1024; c.mixcol = 0; c.lg = (const float*)(F.ws + WS_LG); c.gain = F.in[I_HGN] + i * DVC; c.sc = (bf16_t*)(F.ws + WS_SC); }
    else { c.H = HD_; c.V = DVD; c.qcol = ZC_QD; c.kcol = ZC_KD; c.vcol = ZC_VD; c.gcol = ZC_RD; c.lgld = 512; c.mixcol = 1024; c.lg = (const float*)(F.ws + WS_LG) + (size_t)MP * 1024; c.gain = F.in[I_GLN] + i * DVD; c.sc = (bf16_t*)(F.ws + WS_SC) + (size_t)NB * HC * NCHUNK * DVC * 128; }
    return c;
}
__device__ __forceinline__ void x2_unit(Frame& F, int i, int unit) {
    const int kind = unit >> 7; const int u = unit & 127; const GlaCfg c = gla_cfg(F, i, kind);
    const int nvs = c.V / 16; const int vs = u % nvs, hd = (u / nvs) % c.H, b = u / (nvs * c.H);
    const int lane = F.lane, w = F.wave, fr = lane & 15, g = lane >> 4;
    const bf16_t* Z = (const bf16_t*)(F.ws + WS_Z) + (size_t)b * SEQ * N_CDZ; const float* LG = c.lg + (size_t)b * SEQ * c.lgld + hd * 128 + 16 * w + fr;
    const bf16_t* Kp = Z + c.kcol + hd * 128 + 16 * w + fr; const bf16_t* Vp = Z + c.vcol + hd * c.V + 16 * vs + fr;
    bf16_t* SCp = c.sc + ((size_t)(b * c.H + hd) * NCHUNK) * c.V * 128 + (size_t)(16 * vs + fr) * 128 + 16 * w + 4 * g;
    f32x4 S = (f32x4){0.f, 0.f, 0.f, 0.f};
    float nlg[2][8]; unsigned short nkv[2][8], nvv[2][8];
#pragma unroll
    for (int ks = 0; ks < 2; ++ks)
#pragma unroll
        for (int j = 0; j < 8; ++j) { const size_t t = 32 * ks + 8 * g + j; nlg[ks][j] = LG[t * c.lgld]; nkv[ks][j] = Kp[t * N_CDZ]; nvv[ks][j] = Vp[t * N_CDZ]; }
#pragma unroll 1
    for (int ck = 0; ck < NCHUNK; ++ck) {
        float lg[2][8]; unsigned short kv[2][8], vv[2][8];
#pragma unroll
        for (int ks = 0; ks < 2; ++ks)
#pragma unroll
            for (int j = 0; j < 8; ++j) { lg[ks][j] = nlg[ks][j]; kv[ks][j] = nkv[ks][j]; vv[ks][j] = nvv[ks][j]; }
        if (ck + 1 < NCHUNK) { const size_t t0 = 64 * (ck + 1) + 8 * g;
            auto pl = launder(LG + t0 * c.lgld); auto pk = launder(Kp + t0 * N_CDZ); auto pv = launder(Vp + t0 * N_CDZ);
#pragma unroll
            for (int ks = 0; ks < 2; ++ks) {
#pragma unroll
                for (int j = 0; j < 8; ++j) { nlg[ks][j] = pl[(size_t)j * c.lgld]; nkv[ks][j] = pk[(size_t)j * N_CDZ]; nvv[ks][j] = pv[(size_t)j * N_CDZ]; }
                pl = launder(pl + (size_t)32 * c.lgld); pk = launder(pk + (size_t)32 * N_CDZ); pv = launder(pv + (size_t)32 * N_CDZ); } }
        { u32x2 wv; wv.x = cvt_pk_bf16(S[0], S[1]); wv.y = cvt_pk_bf16(S[2], S[3]); *(u32x2*)(SCp + (size_t)ck * c.V * 128) = wv; }
        float tot[2];
#pragma unroll
        for (int ks = 0; ks < 2; ++ks) {
#pragma unroll
            for (int j = 1; j < 8; ++j) lg[ks][j] += lg[ks][j - 1];
            float inc = lg[ks][7];
            { const float p = SHUP(inc, 16); if (g >= 1) inc += p; }
            { const float p = SHUP(inc, 32); if (g >= 2) inc += p; }
            float ex = SHUP(inc, 16); if (g == 0) ex = 0.f;
            tot[ks] = SHL(inc, 48 + fr);
#pragma unroll
            for (int j = 0; j < 8; ++j) lg[ks][j] += ex + (ks ? tot[0] : 0.f);
        }
        const float blast = tot[0] + tot[1];
        union { bf16x8 v; unsigned u[4]; } af[2], bf[2];
#pragma unroll
        for (int ks = 0; ks < 2; ++ks) { float kd[8];
#pragma unroll
            for (int j = 0; j < 8; ++j) kd[j] = bf2f(kv[ks][j]) * fast_exp(blast - lg[ks][j]);
#pragma unroll
            for (int j = 0; j < 4; ++j) { af[ks].u[j] = cvt_pk_bf16(kd[2 * j], kd[2 * j + 1]); bf[ks].u[j] = (unsigned)vv[ks][2 * j] | ((unsigned)vv[ks][2 * j + 1] << 16); } }
#pragma unroll
        for (int e = 0; e < 4; ++e) S[e] *= fast_exp(SHL(blast, 4 * g + e));
        S = __builtin_amdgcn_mfma_f32_16x16x32_bf16(af[0].v, bf[0].v, S, 0, 0, 0);
        S = __builtin_amdgcn_mfma_f32_16x16x32_bf16(af[1].v, bf[1].v, S, 0, 0, 0);
    }
    float* so = F.out + (kind == 0 ? O_HGP : O_GLP) + (((size_t)i * NB + b) * c.H + hd) * 128 * c.V + (size_t)(16 * w + 4 * g) * c.V + 16 * vs + fr;
#pragma unroll
    for (int e = 0; e < 4; ++e) so[(size_t)e * c.V] = S[e];
}

template <int V> __device__ __forceinline__ void scd_unit_t(Frame& F, int i, int kind, int b, int hd) {
    constexpr int KQ = 512 / V, KN = 128 / KQ;
    const int tid = F.tid; const float* zs = (const float*)(F.ws + WS_ZS);
    MK_LAS float* sq = (MK_LAS float*)F.lds;
    MK_LAS float* sk = sq + 1024;
    MK_LAS float* sl = sk + 1024;
    MK_LAS float* sv = sl + 1024;
    MK_LAS float* po = sv + 8 * V;
    MK_LAS float* rsd = po + KQ * 8 * V;
    const float* lb = (const float*)(F.ws + WS_LB) + i * 1024;
    for (int e = tid; e < 1024; e += 512) { const int k = e & 127, t = e >> 7; const float* zr = zs + (size_t)(b * 8 + t) * N_CD;
        if (kind == 0) { const float z = zr[ZC_KC + hd * 128 + k], l = lb[hd * 128 + k]; const float sg = sigmoid_f(z); sq[e] = zr[ZC_QC + hd * 128 + k]; sk[e] = (1.0f - l) * (1.0f - sg); sl[e] = l + (1.0f - l) * sg; }
        else { const float x = zr[N_CDZ + hd * 128 + k] + F.in[I_BG][i * 512 + hd * 128 + k]; const float ls = fminf(x, 0.f) - fast_ln(1.0f + fast_exp(-fabsf(x))); sq[e] = zr[ZC_QD + hd * 128 + k] * 0.08838834764831845f; sk[e] = zr[ZC_KD + hd * 128 + k]; sl[e] = fast_exp(ls * 0.0625f); } }
    for (int e = tid; e < 8 * V; e += 512) { const int v = e % V, t = e / V; sv[e] = zs[(size_t)(b * 8 + t) * N_CD + (kind == 0 ? ZC_IC : ZC_VD) + hd * V + v]; }
    __syncthreads();
    const int v = tid % V, kq = tid / V; const float* s0 = F.in[kind == 0 ? I_SHG : I_SGL] + ((((size_t)i * SB + b) * (kind == 0 ? HC : HD_) + hd) * 128) * V;
    float S[KN];
    { auto sp = launder(s0 + (size_t)(kq * KN) * V + v);
#pragma unroll
      for (int kk = 0; kk < KN; ++kk) { S[kk] = *sp; sp = launder(sp + V); } }
    for (int t = 0; t < 8; ++t) { const float vt = sv[t * V + v]; float acc = 0.f;
#pragma unroll
        for (int kk = 0; kk < KN; ++kk) { const int k = kq * KN + kk; S[kk] = sl[t * 128 + k] * S[kk] + sk[t * 128 + k] * vt; acc += sq[t * 128 + k] * S[kk]; }
        po[(kq * 8 + t) * V + v] = acc; }
    float* so = F.out + (kind == 0 ? O_HGS : O_GLS) + ((((size_t)i * SB + b) * (kind == 0 ? HC : HD_) + hd) * 128) * V;
    { auto sp = launder(so + (size_t)(kq * KN) * V + v);
#pragma unroll
      for (int kk = 0; kk < KN; ++kk) { *sp = S[kk]; sp = launder(sp + V); } }
    __syncthreads();
    for (int e = tid; e < 8 * V; e += 512) { float a = 0.f;
#pragma unroll
        for (int q = 0; q < KQ; ++q) a += po[q * 8 * V + e];
        po[e] = a; }
    __syncthreads();
    if (tid < 8) { float s = 0.f; for (int vv = 0; vv < V; ++vv) s += po[tid * V + vv] * po[tid * V + vv]; rsd[tid] = fast_rsq(s * (1.0f / V) + EPS); }
    __syncthreads();
    const float* gain = F.in[kind == 0 ? I_HGN : I_GLN] + i * V;
    for (int e = tid; e < 8 * V; e += 512) { const int vv = e % V, t = e / V; const float gt = zs[(size_t)(b * 8 + t) * N_CD + (kind == 0 ? ZC_GC : ZC_RD) + hd * V + vv];
        const float y = po[e] * rsd[t] * gain[vv] * silu_f(gt);
        ((bf16_t*)(F.ws + WS_MIX))[(size_t)(MP + b * 8 + t) * D + (kind == 0 ? 0 : 1024) + hd * V + vv] = (bf16_t)f2bf(y); }
    __syncthreads();
}
__device__ __forceinline__ void scd_unit(Frame& F, int i, int unit) {
    if (unit < 64) scd_unit_t<DVC>(F, i, 0, unit >> 3, unit & 7); else { const int u = unit - 64; scd_unit_t<DVD>(F, i, 1, u >> 2, u & 3); }
}

template <int V> __device__ __forceinline__ void x3_unit_t(Frame& F, const GlaCfg& c, int b, int hd, int ck) {
    constexpr int LDQ = 272, LDV = 2 * V + 32, LDA = 144;
    constexpr int NT = V / 32;
    MK_LAS unsigned char* QE = F.lds; MK_LAS unsigned char* QH = QE + 64 * LDQ; MK_LAS unsigned char* KH = QH + 64 * LDQ; MK_LAS unsigned char* VT = KH + 64 * LDQ;
    MK_LAS unsigned char* AM = VT + 64 * LDV; MK_LAS float* QT = (MK_LAS float*)(AM + 64 * LDA);
    MK_LAS float* SS = QT + 512;
    const int tid = F.tid, lane = F.lane, w = F.wave, fr = lane & 15, g = lane >> 4; const int tb = 64 * ck;
    const bf16_t* Z = (const bf16_t*)(F.ws + WS_Z) + ((size_t)b * SEQ + tb) * N_CDZ; const float* LG = c.lg + ((size_t)b * SEQ + tb) * c.lgld + hd * 128;
    { const int ch = tid & 127, tq = tid >> 7; float cum[16]; float run = 0.f;
        { auto pl = launder(LG + (size_t)(16 * tq) * c.lgld + ch);
#pragma unroll
          for (int j = 0; j < 16; ++j) { run += *pl; cum[j] = run; pl = launder(pl + c.lgld); } }
        QT[tq * 128 + ch] = run;
        unsigned short qv[16], kv[16];
        { auto pq = launder(Z + (size_t)(16 * tq) * N_CDZ + c.qcol + hd * 128 + ch); const int kdelta = c.kcol - c.qcol;
#pragma unroll
          for (int j = 0; j < 16; ++j) { qv[j] = pq[0]; kv[j] = pq[kdelta]; pq = launder(pq + N_CDZ); } }
        LDS_WAIT(); __syncthreads();
        const float q0 = QT[ch], q1 = QT[128 + ch], q2 = QT[256 + ch]; const float off = tq == 0 ? 0.f : (tq == 1 ? q0 : (tq == 2 ? q0 + q1 : q0 + q1 + q2)); const float bmid = q0 + q1;
#pragma unroll
        for (int j = 0; j < 16; ++j) { const float bb = cum[j] + off; const float qf = bf2f(qv[j]), kf = bf2f(kv[j]); const int t = 16 * tq + j;
            *(MK_LAS unsigned short*)(QE + t * LDQ + 2 * ch) = (unsigned short)f2bf(qf * fast_exp(bb));
            *(MK_LAS unsigned short*)(QH + t * LDQ + 2 * ch) = (unsigned short)f2bf(qf * fast_exp(fminf(bb - bmid, 80.f)));
            *(MK_LAS unsigned short*)(KH + t * LDQ + 2 * ch) = (unsigned short)f2bf(kf * fast_exp(fminf(bmid - bb, 80.f))); }
        constexpr int CPR = V / 8;
        for (int e = tid; e < 64 * CPR; e += 512) { const int t = e / CPR, chk = e % CPR; *(MK_LAS u32x4*)(VT + t * LDV + 16 * chk) = *(const u32x4*)(Z + (size_t)t * N_CDZ + c.vcol + hd * V + 8 * chk); }
    }
    LDS_WAIT(); __syncthreads();
    { const int ti = w >> 1;
#pragma unroll
        for (int jj = 0; jj < 2; ++jj) { const int sj = 2 * (w & 1) + jj; f32x4 a = (f32x4){0.f, 0.f, 0.f, 0.f};
            if (sj <= ti) {
#pragma unroll
                for (int ks = 0; ks < 4; ++ks) { const bf16x8 qa = *(const MK_LAS bf16x8*)(QH + (16 * ti + fr) * LDQ + 64 * ks + 16 * g), kb = *(const MK_LAS bf16x8*)(KH + (16 * sj + fr) * LDQ + 64 * ks + 16 * g);
                    a = __builtin_amdgcn_mfma_f32_16x16x32_bf16(qa, kb, a, 0, 0, 0); } }
#pragma unroll
            for (int e = 0; e < 4; ++e) { const int t = 16 * ti + 4 * g + e, s = 16 * sj + fr; *(MK_LAS unsigned short*)(AM + t * LDA + 2 * s) = (unsigned short)f2bf(s <= t ? a[e] : 0.f); } } }
    LDS_WAIT(); __syncthreads();
    const int mt = w & 3, vh = w >> 2; f32x4 o[NT];
#pragma unroll
    for (int n = 0; n < NT; ++n) o[n] = (f32x4){0.f, 0.f, 0.f, 0.f};
    const unsigned vtb = (unsigned)(size_t)VT; const int q4 = fr >> 2, p4 = fr & 3;
#pragma unroll
    for (int ks = 0; ks < 2; ++ks) { if (32 * ks <= 16 * mt + 15) { const bf16x8 aa = *(const MK_LAS bf16x8*)(AM + (16 * mt + fr) * LDA + 64 * ks + 16 * g);
#pragma unroll
            for (int n = 0; n < NT; ++n) { const int vc = (V / 2) * vh + 16 * n; const unsigned a0 = vtb + (32 * ks + 8 * g + q4) * LDV + (vc + 4 * p4) * 2, a1 = a0 + 4 * LDV;
                union { bf16x8 v; s16x4 h[2]; } vf; vf.h[0] = tr_read4(a0); vf.h[1] = tr_read4(a1);
                o[n] = __builtin_amdgcn_mfma_f32_16x16x32_bf16(aa, vf.v, o[n], 0, 0, 0); } } }
    { const bf16_t* SCp = c.sc + (((size_t)(b * c.H + hd) * NCHUNK + ck) * V) * 128;
#pragma unroll
        for (int ks = 0; ks < 4; ++ks) { const bf16x8 qa = *(const MK_LAS bf16x8*)(QE + (16 * mt + fr) * LDQ + 64 * ks + 16 * g);
#pragma unroll
            for (int n = 0; n < NT; ++n) { const int vc = (V / 2) * vh + 16 * n + fr; const bf16x8 sb = *(const bf16x8*)(SCp + (size_t)vc * 128 + 32 * ks + 8 * g);
                o[n] = __builtin_amdgcn_mfma_f32_16x16x32_bf16(qa, sb, o[n], 0, 0, 0); } } }
    float ss[4];
#pragma unroll
    for (int e = 0; e < 4; ++e) { float s = 0.f;
#pragma unroll
        for (int n = 0; n < NT; ++n) s += o[n][e] * o[n][e];
        s += SHX(s, 1); s += SHX(s, 2); s += SHX(s, 4); s += SHX(s, 8); ss[e] = s; }
    if (fr == 0) {
#pragma unroll
        for (int e = 0; e < 4; ++e) SS[vh * 64 + 16 * mt + 4 * g + e] = ss[e]; }
    LDS_WAIT(); __syncthreads();
    bf16_t* MIX = (bf16_t*)(F.ws + WS_MIX) + ((size_t)b * SEQ + tb) * D + c.mixcol + hd * V;
#pragma unroll
    for (int e = 0; e < 4; ++e) { const int t = 16 * mt + 4 * g + e; const float rs = fast_rsq((SS[t] + SS[64 + t]) * (1.0f / V) + EPS);
#pragma unroll
        for (int n = 0; n < NT; ++n) { const int vc = (V / 2) * vh + 16 * n + fr; const float gt = bf2f(Z[(size_t)t * N_CDZ + c.gcol + hd * V + vc]);
            MIX[(size_t)t * D + vc] = (bf16_t)f2bf(o[n][e] * rs * c.gain[vc] * silu_f(gt)); } }
    __syncthreads();
}
__device__ __forceinline__ void x3_unit(Frame& F, int i, int unit) {
    if (unit < NB * HC * NCHUNK) { const GlaCfg c = gla_cfg(F, i, 0); x3_unit_t<DVC>(F, c, unit / (HC * NCHUNK), (unit / NCHUNK) % HC, unit % NCHUNK); }
    else { const int u = unit - NB * HC * NCHUNK; const GlaCfg c = gla_cfg(F, i, 1); x3_unit_t<DVD>(F, c, u / (HD_ * NCHUNK), (u / NCHUNK) % HD_, u % NCHUNK); }
}
__device__ __forceinline__ void mixer_cd_x2(Frame& F, int i, int qid) {
    for (;;) { const int u = q_next(F, qid); if (u >= 256 + 96) break; if (u < 256) x2_unit(F, i, u); else scd_unit(F, i, u - 256); }
}
__device__ __forceinline__ void mixer_cd_x3(Frame& F, int i, int qid) {
    constexpr int NU = NB * HC * NCHUNK + NB * HD_ * NCHUNK;
    for (;;) { const int u = q_next(F, qid); if (u >= NU) break; x3_unit(F, i, u); }
}
}
namespace mk {
#define PHASE_FRAME(Fp) Frame Fp = F0; asm volatile("" : "+s"(Fp.wave)); Fp.tid = opaque_tid(Fp.wave); Fp.lane = Fp.tid & 63
__device__ __forceinline__ void ffn_part(Frame& F0, const XcdBarrier& bar, int layer) {
    { PHASE_FRAME(F); Gemm g{(const bf16_t*)(F.ws + WS_XB16), (const bf16_t*)(F.ws + WS_WUP + layer * SZ_WUP), MP, N_UP, D}; StaticOrder S; S.init(MP, N_UP, F.G, opaque_bid());
      EpiUp E{(bf16_t*)(F.ws + WS_Z), rss_ptr(F, 2 * layer + 1), F.in[I_FCW] + (size_t)layer * 3 * FF, F.in[I_FCB] + (size_t)layer * FF, (float*)(F.ws + WS_GHEAD), (float*)(F.ws + WS_GTAIL), F.out + O_FFP + (size_t)layer * NB * 2 * FF};
      gemm_phase<EpiUp>(F.lds, g, S, E, F.wave);
#if MK_PROBE == 9
      gemm_phase<EpiUp>(F.lds, g, S, E, F.wave);
#endif
    }
    { PHASE_FRAME(F); const bf16_t* Bt = (const bf16_t*)(F.ws + WS_WUP + layer * SZ_WUP);
      sample_plain(F, Bt, rss_sptr(F, 2 * layer + 1), N_UP, 32 * (N_UP / 256), (float*)(F.ws + WS_GUS), N_UP, true); }
    xcd_barrier(bar, F0.wave);
    { PHASE_FRAME(F); ffn_fixup(F, layer); }
#if MK_PROBE == 10
    xcd_barrier(bar, F0.wave); { PHASE_FRAME(F); ffn_fixup(F, layer); }
#endif
    xcd_barrier(bar, F0.wave);
    { PHASE_FRAME(F); Gemm g{(const bf16_t*)(F.ws + WS_Z), (const bf16_t*)(F.ws + WS_WDN + layer * SZ_WDN), MP, D, FF}; StaticOrder S; S.init(MP, D, F.G, opaque_bid());
      EpiRes E{F.out + O_YP, F.out + O_YP, (bf16_t*)(F.ws + WS_XB16), rss_ptr(F, 2 * layer + 2)};
      gemm_phase<EpiRes>(F.lds, g, S, E, F.wave); }
    { PHASE_FRAME(F); const bf16_t* Bt = (const bf16_t*)(F.ws + WS_WDN + layer * SZ_WDN);
      sample_res(F, (const bf16_t*)(F.ws + WS_Z) + (size_t)MP * FF, Bt, FF, F.out + O_YS, rss_sptr(F, 2 * layer + 2)); }
    xcd_barrier(bar, F0.wave);
}
__device__ __forceinline__ void out_part(Frame& F0, const XcdBarrier& bar, int layer, const bf16_t* Wt) {
    PHASE_FRAME(F);
    Gemm g{(const bf16_t*)(F.ws + WS_MIX), Wt, MP, D, D}; StaticOrder S; S.init(MP, D, F.G, opaque_bid());
    const float* baseP = layer == 0 ? F.in[I_XP] : F.out + O_YP; const float* baseS = layer == 0 ? F.in[I_XS] : F.out + O_YS;
    EpiRes E{baseP, F.out + O_YP, (bf16_t*)(F.ws + WS_XB16), rss_ptr(F, 2 * layer + 1)};
    gemm_phase<EpiRes>(F.lds, g, S, E, F.wave);
    { PHASE_FRAME(F2); sample_res(F2, (const bf16_t*)(F2.ws + WS_MIX) + (size_t)MP * D, Wt, D, baseS, rss_sptr(F2, 2 * layer + 1)); }
    xcd_barrier(bar, F0.wave);
}

__global__ void __launch_bounds__(512, 2) mega_fwd(Args args) {
    extern __shared__ __attribute__((aligned(16))) unsigned char lds_raw[];
    Frame F0; Frame& F = F0; F.lds = (MK_LAS unsigned char*)lds_raw; F.ws = args.ws; F.out = args.out; F.in = args.in; F.ctl = (unsigned*)(args.ws + WS_CTL);
    F.wave = __builtin_amdgcn_readfirstlane((int)threadIdx.x >> 6); asm volatile("" : "+s"(F.wave));
    F.tid = opaque_tid(F.wave); F.lane = F.tid & 63;
    F.G = gridDim.x; { const int bx = opaque_bid(); F.vcu = (F.G % 8 == 0) ? (bx % 8) * (F.G / 8) + bx / 8 : bx; }
    for (int u = F.tid; u < (LDS_BYTES - MISC_OFF) / 4; u += 512) ((MK_LAS unsigned*)(F.lds + MISC_OFF))[u] = 0u;
    __syncthreads();
    const XcdBarrier bar = xcd_barrier_post(F.ctl + CW_BAR, (volatile MK_LAS unsigned*)(F.lds + MISC_OFF), F0.wave);
    p0_prologue(F);
    xcd_barrier(bar, F0.wave);
#if MK_PROBE == 7
    p0_prologue(F); xcd_barrier(bar, F0.wave);
#elif MK_PROBE == 6
    for (int r = 0; r < 32; ++r) xcd_barrier(bar, F0.wave);
#endif
    const int nl = args.nlayers;
    for (int lp = 0; lp < 2; ++lp) {
        { const int layer = 2 * lp, i = lp; if (layer >= nl) break;
          { PHASE_FRAME(F); Gemm g{(const bf16_t*)(F.ws + WS_XB16), (const bf16_t*)(F.ws + WS_WINAB + i * SZ_WINAB), MP, N_AB, D}; StaticOrder S; S.init(MP, N_AB, F.G, opaque_bid());
            EpiInAB E{(bf16_t*)(F.ws + WS_Z), rss_ptr(F, 2 * layer), F.in[I_QN] + i * DH, F.in[I_KN] + i * DH, F.out + O_KVP + (size_t)i * NB * LA * 2 * WA, F.out + O_CONVP + (size_t)i * NB * 3 * WB};
            gemm_phase<EpiInAB>(F.lds, g, S, E, F.wave);
#if MK_PROBE == 8
            gemm_phase<EpiInAB>(F.lds, g, S, E, F.wave);
#endif
          }
          { PHASE_FRAME(F); sample_in_ab(F, i, (const bf16_t*)(F.ws + WS_WINAB + i * SZ_WINAB), rss_sptr(F, 2 * layer)); }
          xcd_barrier(bar, F0.wave);
          { PHASE_FRAME(F); mixer_ab<0>(F, i, 2 * layer); }
          xcd_barrier(bar, F0.wave);
          { PHASE_FRAME(F); mixer_ab_fix(F, i, 2 * layer + 1); }
          xcd_barrier(bar, F0.wave);
#if MK_PROBE == 1
          { PHASE_FRAME(F); mixer_ab<0>(F, i, 16 + 2 * layer); } xcd_barrier(bar, F0.wave);
#elif MK_PROBE == 2
          { PHASE_FRAME(F); mixer_ab<1>(F, i, 16 + 2 * layer); } xcd_barrier(bar, F0.wave);
#elif MK_PROBE == 3
          { PHASE_FRAME(F); mixer_ab<2>(F, i, 16 + 2 * layer); } xcd_barrier(bar, F0.wave);
#endif
          if (args.pad && layer == nl - 1) return;
          out_part(F0, bar, layer, (const bf16_t*)(F.ws + WS_WOUTAB + i * SZ_WOUT));
          ffn_part(F0, bar, layer); }
        { const int layer = 2 * lp + 1, i = lp; if (layer >= nl) break;
          { PHASE_FRAME(F); Gemm g{(const bf16_t*)(F.ws + WS_XB16), (const bf16_t*)(F.ws + WS_WINCD + i * SZ_WINCD), MP, N_CD, D}; StaticOrder S; S.init(MP, N_CD, F.G, opaque_bid());
            EpiInCD E{(bf16_t*)(F.ws + WS_Z), rss_ptr(F, 2 * layer), (const float*)(F.ws + WS_LB) + i * 1024, F.in[I_BG] + i * 512, (float*)(F.ws + WS_LG), (float*)(F.ws + WS_LG) + (size_t)MP * 1024};
            gemm_phase<EpiInCD>(F.lds, g, S, E, F.wave);
#if MK_PROBE == 8
            gemm_phase<EpiInCD>(F.lds, g, S, E, F.wave);
#endif
          }
          { PHASE_FRAME(F); sample_plain(F, (const bf16_t*)(F.ws + WS_WINCD + i * SZ_WINCD), rss_sptr(F, 2 * layer), N_CD, 32 * (N_CD / 256), (float*)(F.ws + WS_ZS), N_CD, false); }
          xcd_barrier(bar, F0.wave);
          { PHASE_FRAME(F); mixer_cd_x2(F, i, 2 * layer); }
          xcd_barrier(bar, F0.wave);
#if MK_PROBE == 4
          { PHASE_FRAME(F); mixer_cd_x2(F, i, 16 + 2 * layer); } xcd_barrier(bar, F0.wave);
#endif
          { PHASE_FRAME(F); mixer_cd_x3(F, i, 2 * layer + 1); }
          xcd_barrier(bar, F0.wave);
#if MK_PROBE == 5
          { PHASE_FRAME(F); mixer_cd_x3(F, i, 16 + 2 * layer + 1); } xcd_barrier(bar, F0.wave);
#endif
          if (args.pad && layer == nl - 1) return;
          out_part(F0, bar, layer, (const bf16_t*)(F.ws + WS_WOUTCD + i * SZ_WOUT));
          ffn_part(F0, bar, layer); }
    }
}

static int g_grid = 0;
inline void launch_mega(void* const* d_in, float* out, unsigned char* ws, int nlayers, hipStream_t stream, int stop_after_mixer = 0) {
    if (g_grid == 0) {
        int dev = 0, cus = 0;
        if (hipGetDevice(&dev) != hipSuccess || hipDeviceGetAttribute(&cus, hipDeviceAttributeMultiprocessorCount, dev) != hipSuccess) { g_grid = -1; return; }
        if (hipFuncSetAttribute((const void*)mega_fwd, hipFuncAttributeMaxDynamicSharedMemorySize, LDS_BYTES) != hipSuccess) { g_grid = -1; return; }
        int per_cu = 0; (void)hipOccupancyMaxActiveBlocksPerMultiprocessor(&per_cu, (const void*)mega_fwd, 512, LDS_BYTES); (void)hipGetLastError();
        g_grid = (per_cu >= 1) ? cus : -1;
    }
    if (g_grid < 0) return;
    (void)hipMemsetAsync(ws + WS_CTL, 0, CTL_BYTES, stream);
    Args a{}; for (int k = 0; k < 32; ++k) a.in[k] = (const float*)d_in[k];
    a.out = out; a.ws = ws; a.nlayers = nlayers; a.pad = stop_after_mixer;
    hipLaunchKernelGGL(mega_fwd, dim3(g_grid), dim3(512), LDS_BYTES, stream, a);
}
}
extern "C" void kernel_launch(void* const* d_in, const int* in_sizes, int n_in, void* d_out, int out_size, void* d_ws, size_t ws_size, hipStream_t stream) {
    if (n_in != 32 || ws_size < mk::WS_END || (size_t)out_size != mk::O_END) return;
    mk::launch_mega(d_in, (float*)d_out, (unsigned char*)d_ws, 4, stream);
}
```

```cpp
#include <hip/hip_runtime.h>
namespace mk {
#define MK_LAS __attribute__((address_space(3)))
#define MK_GAS __attribute__((address_space(1)))
typedef unsigned short bf16_t;
typedef short bf16x8 __attribute__((ext_vector_type(8)));
typedef short s16x4 __attribute__((ext_vector_type(4)));
typedef float f32x4 __attribute__((ext_vector_type(4)));
typedef float f32x2 __attribute__((ext_vector_type(2)));
typedef unsigned u32x4 __attribute__((ext_vector_type(4)));
typedef unsigned u32x2 __attribute__((ext_vector_type(2)));

constexpr int D = 2048, NB = 2, SEQ = 4096, MP = NB * SEQ, SB = 8, ST = 8, MS = SB * ST, MT = MP + MS;
constexpr int HA = 8, DH = 128, WA = 1024, WB = 1024, HB_ = 8, LA = 2048;
constexpr int N_AB = 5120, N_CD = 7680, N_CD_SRC = 7184, N_CDZ = 7168, FF = 5504, N_UP = 2 * FF;
constexpr int HC = 8, HD_ = 4, DK = 128, DVC = 128, DVD = 256;
constexpr float EPS = 1e-6f;
constexpr int NCHUNK = SEQ / 64;
constexpr int ZC_QC = 0, ZC_KC = 1024, ZC_IC = 2048, ZC_GC = 3072, ZC_QD = 4096, ZC_KD = 4608, ZC_VD = 5120, ZC_RD = 6144;

constexpr size_t MiB = 1u << 20;
constexpr size_t WS_CTL = 0, CTL_BYTES = 1 * MiB;
constexpr size_t WS_WINAB = 1 * MiB, SZ_WINAB = (size_t)N_AB * D * 2;
constexpr size_t WS_WOUTAB = WS_WINAB + 2 * SZ_WINAB, SZ_WOUT = (size_t)D * D * 2;
constexpr size_t WS_WINCD = WS_WOUTAB + 2 * SZ_WOUT, SZ_WINCD = (size_t)N_CD * D * 2;
constexpr size_t WS_WOUTCD = WS_WINCD + 2 * SZ_WINCD;
constexpr size_t WS_WUP = WS_WOUTCD + 2 * SZ_WOUT, SZ_WUP = (size_t)N_UP * D * 2;
constexpr size_t WS_WDN = WS_WUP + 4 * SZ_WUP, SZ_WDN = (size_t)D * FF * 2;
constexpr size_t WS_WLRU = WS_WDN + 4 * SZ_WDN, SZ_WLRU = (size_t)2 * 8 * 2 * 128 * 128 * 2;
constexpr size_t WS_LB = WS_WLRU + SZ_WLRU;
constexpr size_t WS_XB16 = WS_LB + 64 * 1024;
constexpr size_t WS_Z = WS_XB16 + 33 * MiB;
constexpr size_t WS_LG = WS_Z + 112 * MiB;
constexpr size_t WS_SC = WS_LG + 48 * MiB;
constexpr size_t WS_MIX = WS_SC + 64 * MiB;
constexpr size_t WS_ZS = WS_MIX + 33 * MiB;
constexpr size_t WS_GUS = WS_ZS + 2 * MiB;
constexpr size_t WS_GHEAD = WS_GUS + 3 * MiB;
constexpr size_t WS_GTAIL = WS_GHEAD + 3 * MiB;
constexpr size_t WS_RSS = WS_GTAIL + 2 * MiB;
constexpr size_t RSS_P_FLOATS = (size_t)9 * MP * 8, RSS_S_FLOATS = (size_t)9 * MS * 128;
constexpr size_t WS_END = WS_RSS + 3 * MiB;
static_assert((RSS_P_FLOATS + RSS_S_FLOATS) * 4 <= 3 * MiB && (size_t)MT * FF * 2 <= 112 * MiB && (size_t)MP * N_CDZ * 2 <= 112 * MiB && (size_t)MT * D * 2 <= 33 * MiB, "ws map");
constexpr int CW_TMO = 0, CW_CODE = 1, CW_BAR = 4096, CW_Q = 8192;
constexpr int RING_BYTES = 131072, EPI_OFF = RING_BYTES, EPI_BYTES = 12288, MISC_OFF = EPI_OFF + EPI_BYTES, LDS_BYTES = 147456;
static_assert(MISC_OFF + 256 <= LDS_BYTES, "lds");

__device__ __forceinline__ unsigned f2bf(float f) { unsigned u = __builtin_bit_cast(unsigned, f); return (u + 0x7fffu + ((u >> 16) & 1u)) >> 16; }
__device__ __forceinline__ unsigned pk2(float lo, float hi) { return f2bf(lo) | (f2bf(hi) << 16); }
__device__ __forceinline__ float bf2f(unsigned short b) { return __builtin_bit_cast(float, ((unsigned)b) << 16); }
__device__ __forceinline__ float bflo(unsigned w) { return __builtin_bit_cast(float, w << 16); }
__device__ __forceinline__ float bfhi(unsigned w) { return __builtin_bit_cast(float, w & 0xffff0000u); }
__device__ __forceinline__ unsigned cvt_pk_bf16(float lo, float hi) { unsigned r; asm volatile("v_cvt_pk_bf16_f32 %0, %1, %2" : "=v"(r) : "v"(lo), "v"(hi)); return r; }
__device__ __forceinline__ float fast_exp2(float x) { return __builtin_amdgcn_exp2f(x); }
__device__ __forceinline__ float fast_exp(float x) { return __builtin_amdgcn_exp2f(x * 1.44269504089f); }
__device__ __forceinline__ float fast_rcp(float x) { return __builtin_amdgcn_rcpf(x); }
__device__ __forceinline__ float sigmoid_f(float x) { return fast_rcp(1.0f + fast_exp(-x)); }
__device__ __forceinline__ float silu_f(float x) { return x * sigmoid_f(x); }
__device__ __forceinline__ float gelu_tanh_f(float x) { const float u = 0.7978845608028654f * (x + 0.044715f * x * x * x); return x * sigmoid_f(2.0f * u); }
template <class T> __device__ __forceinline__ MK_GAS T* launder(T* p) { MK_GAS T* q = (MK_GAS T*)p; asm volatile("" : "+v"(q)); return q; }
template <class T> __device__ __forceinline__ MK_GAS T* launder(MK_GAS T* q) { asm volatile("" : "+v"(q)); return q; }
__device__ __forceinline__ int opaque_bid() { int b = (int)blockIdx.x; asm volatile("" : "+s"(b)); return b; }
__device__ __forceinline__ int lane_id() { int l; asm volatile("v_mbcnt_lo_u32_b32 %0, -1, 0\n\tv_mbcnt_hi_u32_b32 %0, -1, %0" : "=v"(l)); return l; }
__device__ __forceinline__ int opaque_tid(int wave) { int l; asm volatile("v_mbcnt_lo_u32_b32 %0, -1, 0\n\tv_mbcnt_hi_u32_b32 %0, -1, %0" : "=v"(l)); return wave * 64 + l; }
__device__ __forceinline__ float fast_rsq(float x) { return __builtin_amdgcn_rsqf(x); }
__device__ __forceinline__ float fast_sqrt(float x) { return __builtin_amdgcn_sqrtf(x); }
__device__ __forceinline__ float fast_ln(float x) { return 0.69314718056f * __builtin_amdgcn_logf(x); }
__device__ __forceinline__ float softplus_acc(float x) { if (x > 20.f) return x; const float e = fast_exp(x); const float ser = e * (1.0f + e * (-0.5f + e * (0.33333333f + e * (-0.25f + e * 0.2f)))); return e < 0.06f ? ser : fast_ln(1.0f + e); }
__device__ __forceinline__ float one_minus_exp(float x) { const float ser = -x * (1.0f + x * (0.5f + x * (0.16666667f + x * (0.041666668f + x * 0.0083333338f)))); return x > -0.3f ? ser : 1.0f - fast_exp(x); }
__device__ __forceinline__ float rss_p(const float* part, int row) { const f32x4 a = *(const f32x4*)(part + (size_t)row * 8), b = *(const f32x4*)(part + (size_t)row * 8 + 4); return ((a[0] + a[1]) + (a[2] + a[3])) + ((b[0] + b[1]) + (b[2] + b[3])); }
__device__ __forceinline__ float rss_s(const float* part, int row) { float s = 0.f; const f32x4* p = (const f32x4*)(part + (size_t)row * 128);
#pragma unroll 8
    for (int j = 0; j < 32; ++j) { const f32x4 a = p[j]; s += (a[0] + a[1]) + (a[2] + a[3]); } return s; }
__device__ __forceinline__ float bperm(int srclane, float v) { return __builtin_bit_cast(float, __builtin_amdgcn_ds_bpermute(srclane << 2, __builtin_bit_cast(int, v))); }
#define SHX(v, mask) bperm(lane ^ (mask), (v))
#define SHUP(v, d) bperm(lane >= (d) ? lane - (d) : lane, (v))
#define SHL(v, src) bperm((src), (v))
#define LDS_WAIT() asm volatile("s_waitcnt lgkmcnt(0)" ::: "memory")
#define VM_WAIT() asm volatile("s_waitcnt vmcnt(0)" ::: "memory")

#define XB_TMO      128
#define XB_XCNT(j)  (256  + 64 * (j))
#define XB_XSUB(j)  (1280 + 64 * (j))
#define XB_XGEN(j)  (2304 + 64 * (j))
#define XB_TOP      3328
#define XB_TOPGEN   3392
#define XCD_BAR_WORDS 3456
#define XB_SPIN_CAP (1u << 22)
__device__ __forceinline__ unsigned xb_ld(unsigned* p)              { return __hip_atomic_load(p, __ATOMIC_RELAXED, __HIP_MEMORY_SCOPE_AGENT); }
__device__ __forceinline__ unsigned xb_add(unsigned* p, unsigned v) { return __hip_atomic_fetch_add(p, v, __ATOMIC_RELAXED, __HIP_MEMORY_SCOPE_AGENT); }
__device__ __forceinline__ unsigned xb_xcc_id() { return (unsigned)__builtin_amdgcn_s_getreg((3 << 11) | 20) & 0xFu; }
#define XB_SPIN(cond, bar) do { unsigned _sp = 0; while (cond) { __builtin_amdgcn_s_sleep(1); \
    if ((++_sp & 255u) == 0u) { if (xb_ld(&(bar)[XB_TMO])) break; if (_sp > XB_SPIN_CAP) { atomicAdd(&(bar)[XB_TMO], 1u); break; } } } } while (0)
struct XcdBarrier { unsigned* bar; unsigned x; volatile MK_LAS unsigned* st; };
__device__ __forceinline__ XcdBarrier xcd_barrier_post(unsigned* bar, volatile MK_LAS unsigned* st, int wave) {
    XcdBarrier b; b.bar = bar; b.x = xb_xcc_id(); b.st = st;
    if (wave == 0 && lane_id() == 0) (void)xb_add(&bar[XB_XCNT(b.x)], 1u);
    return b;
}
__device__ __forceinline__ void xcd_barrier_complete(unsigned* bar, unsigned x, unsigned& nloc, unsigned& nx) {
    const unsigned G = gridDim.x * gridDim.y * gridDim.z;
    unsigned sum, cnt, mine, sp = 0u;
    for (;;) {
        sum = 0u; cnt = 0u; mine = 0u;
#pragma unroll
        for (unsigned j = 0; j < 16; ++j) { const unsigned c = xb_ld(&bar[XB_XCNT(j)]); sum += c; cnt += (c > 0u) ? 1u : 0u; mine = (j == x) ? c : mine; }
        if (sum == G) break;
        __builtin_amdgcn_s_sleep(1);
        if ((++sp & 255u) == 0u) { if (xb_ld(&bar[XB_TMO])) break; if (sp > XB_SPIN_CAP) { atomicAdd(&bar[XB_TMO], 1u); break; } }
    }
    nloc = mine > 0u ? mine : 1u; nx = cnt > 0u ? cnt : 1u;
}
__device__ __forceinline__ void xcd_barrier(const XcdBarrier& b, int wave) {
    asm volatile("s_waitcnt vmcnt(0)" ::: "memory");
    __syncthreads();
    if (wave == 0 && lane_id() == 0) {
        unsigned* bar = b.bar; unsigned bx = xb_xcc_id(); asm volatile("" : "+s"(bx));
        __builtin_amdgcn_s_waitcnt(0);
        unsigned nloc = b.st[0], nx = b.st[1];
        if (nloc == 0u) { xcd_barrier_complete(bar, bx, nloc, nx); b.st[0] = nloc; b.st[1] = nx; }
        const unsigned old = xb_add(&bar[XB_XSUB(bx)], 1u);
        const unsigned gen = old / nloc;
        if (old + 1u == (gen + 1u) * nloc) {
            __builtin_amdgcn_fence(__ATOMIC_RELEASE, "agent");
            asm volatile("s_waitcnt vmcnt(0)" ::: "memory");
            const unsigned og = xb_add(&bar[XB_TOP], 1u);
            const unsigned tg = og / nx;
            if (og + 1u == (tg + 1u) * nx) xb_add(&bar[XB_TOPGEN], 1u);
            else XB_SPIN(xb_ld(&bar[XB_TOPGEN]) == tg, bar);
            __builtin_amdgcn_fence(__ATOMIC_ACQUIRE, "agent");
            xb_add(&bar[XB_XGEN(bx)], 1u);
            asm volatile("s_waitcnt vmcnt(0)" ::: "memory");
        } else {
            XB_SPIN(xb_ld(&bar[XB_XGEN(bx)]) == gen, bar);
            __builtin_amdgcn_fence(__ATOMIC_ACQUIRE, "agent");
            asm volatile("s_waitcnt vmcnt(0)" ::: "memory");
        }
    }
    __syncthreads();
}

constexpr int BM = 256, BK = 64, HALF = 128, HTB = HALF * BK * 2, STAGE_BYTES = 8 * HTB, NXCD = 8, WGM = 8;
__host__ __device__ __forceinline__ int lds_byte(int r, int c) { const int st = (r >> 4) * 2 + (c >> 5), rr = r & 15, cc = c & 31, ob = rr * 64 + cc * 2; return st * 1024 + (ob ^ (((ob >> 9) & 1) << 5)); }
__host__ __device__ __forceinline__ void stage_rc(int b, int& R, int& C) { const int st = b / 1024, sb = b % 1024, swz = sb ^ (((sb >> 9) & 1) << 5); R = (st >> 1) * 16 + swz / 64; C = (st & 1) * 32 + (swz % 64) / 2; }
__host__ __device__ __forceinline__ int perm32(int rho) { const int n = rho >> 4, i = rho & 15; return 8 * (i >> 2) + 4 * n + (i & 3); }
struct Unit { int pm, pn; };
struct Gemm { const bf16_t* A; const bf16_t* Bt; int M, N, K; };
struct StaticOrder {
    int nM, nN, nwg, G, c;
    __device__ __forceinline__ void init(int M, int N, int G_, int c_) { nM = M / BM; nN = N / BM; nwg = nM * nN; G = G_; c = c_; }
    __device__ __forceinline__ bool next(int i, Unit& u) const {
        const long L = (long)i * G + c; if (L >= nwg) return false;
        int wgid = (int)L; { const int q = nwg / NXCD, r = nwg % NXCD, xcd = wgid % NXCD, off = wgid / NXCD; wgid = (xcd < r ? xcd * (q + 1) : r * (q + 1) + (xcd - r) * q) + off; }
        const int nig = WGM * nN, gid = wgid / nig, fm = gid * WGM, gsz = (nM - fm) < WGM ? (nM - fm) : WGM;
        u.pm = fm + ((wgid % nig) % gsz); u.pn = (wgid % nig) / gsz; return true;
    }
};
template <class Epi>
__device__ __forceinline__ void gemm_phase(MK_LAS unsigned char* lds, const Gemm g, const StaticOrder& S, const Epi& E, int wave_id) {
    const int tid = opaque_tid(wave_id), wid = wave_id, lane = tid & 63, wr = wid >> 2, wc = wid & 3, fr = lane & 15, fq = lane >> 4;
    const int K = g.K, nt = K / BK;
    unsigned voffA[2], voffB[2];
#pragma unroll
    for (int i = 0; i < 2; ++i) { int R, C; stage_rc(tid * 16 + i * 8192, R, C); const int Rb = Epi::PERM ? ((R & ~31) + perm32(R & 31)) : R;
        voffA[i] = (unsigned)(R * K + C) * 2u; voffB[i] = (unsigned)(Rb * K + C) * 2u; }
    const size_t kstep = (size_t)(BK * 2);
    const size_t hstep = (size_t)HALF * K * 2;
    const size_t tstep = 2 * hstep;
    const unsigned ldsw = (unsigned)wid * 1024u;
    const int aoff = lds_byte(wr * 64 + fr, fq * 8), boff = lds_byte(wc * 32 + fr, fq * 8);
#define PG8_SA(b, h) (((b) * 2 + (h)) * HTB)
#define PG8_SB(b, h) ((4 + (b) * 2 + (h)) * HTB)
#define PG8_STAGE(bufoff, gbase, voff) do { _Pragma("unroll") for (int _i = 0; _i < 2; ++_i) \
        __builtin_amdgcn_global_load_lds((const unsigned*)((const char*)(gbase) + (voff)[_i]), (MK_LAS unsigned*)(lds + (bufoff) + ldsw + _i * 8192), 16, 0, 0); } while (0)
#define PG8_LDA(dst, b, h) do { _Pragma("unroll") for (int m = 0; m < 4; ++m) _Pragma("unroll") for (int k = 0; k < 2; ++k) dst[m][k] = *(const MK_LAS bf16x8*)(lds + PG8_SA(b, h) + aoff + m * 2048 + k * 1024); } while (0)
#define PG8_LDB(dst, b, h) do { _Pragma("unroll") for (int n = 0; n < 2; ++n) _Pragma("unroll") for (int k = 0; k < 2; ++k) dst[n][k] = *(const MK_LAS bf16x8*)(lds + PG8_SB(b, h) + boff + n * 2048 + k * 1024); } while (0)
#define PG8_MMA(ai, bj, At, Bt) do { __builtin_amdgcn_s_setprio(1); _Pragma("unroll") for (int m = 0; m < 4; ++m) _Pragma("unroll") for (int n = 0; n < 2; ++n) _Pragma("unroll") for (int k = 0; k < 2; ++k) \
        acc[ai][bj][m][n] = __builtin_amdgcn_mfma_f32_16x16x32_bf16(Bt[n][k], At[m][k], acc[ai][bj][m][n], 0, 0, 0); __builtin_amdgcn_s_setprio(0); } while (0)
#define PG8_WAIT_V(n) asm volatile("s_waitcnt vmcnt(" #n ")" ::: "memory")
#define PG8_WAIT_L(n) asm volatile("s_waitcnt lgkmcnt(" #n ")" ::: "memory")
#define PG8_BAR __builtin_amdgcn_s_barrier()
#define PG8_SCHED __builtin_amdgcn_sched_barrier(0)
    Unit cur, nxt; int ui = 0;
    if (!S.next(0, cur)) return;
    f32x4 acc[2][2][4][2];
#pragma unroll
    for (int a = 0; a < 2; ++a)
#pragma unroll
        for (int b = 0; b < 2; ++b)
#pragma unroll
            for (int m = 0; m < 4; ++m)
#pragma unroll
                for (int n = 0; n < 2; ++n) acc[a][b][m][n] = (f32x4){0.f, 0.f, 0.f, 0.f};
    bf16x8 At[4][2], B0[2][2], B1[2][2];
    const char* cA = (const char*)g.A + (size_t)cur.pm * tstep; const char* cB = (const char*)g.Bt + (size_t)cur.pn * tstep;
    PG8_STAGE(PG8_SB(0, 0), cB, voffB); PG8_STAGE(PG8_SB(0, 1), cB + hstep, voffB); PG8_STAGE(PG8_SA(0, 0), cA, voffA); PG8_STAGE(PG8_SA(0, 1), cA + hstep, voffA);
    if (wr == 1) PG8_BAR;
    PG8_WAIT_V(2); PG8_BAR;
    PG8_STAGE(PG8_SB(1, 0), cB + kstep, voffB); PG8_STAGE(PG8_SA(1, 0), cA + kstep, voffA); PG8_STAGE(PG8_SB(1, 1), cB + hstep + kstep, voffB);
    PG8_WAIT_V(6); PG8_BAR;
    for (;;) {
        const bool has_next = S.next(ui + 1, nxt);
        const char* nA = has_next ? (const char*)g.A + (size_t)nxt.pm * tstep : cA; const char* nB = has_next ? (const char*)g.Bt + (size_t)nxt.pn * tstep : cB;
        for (int t = 0; t < nt; t += 2) {
            const bool last = (t == nt - 2);
            const char* a1 = cA + (size_t)(t + 1) * kstep;
            const char* a2 = last ? nA : cA + (size_t)(t + 2) * kstep; const char* b2 = last ? nB : cB + (size_t)(t + 2) * kstep;
            const char* a3 = a2 + kstep; const char* b3 = b2 + kstep;
            PG8_LDB(B0, 0, 0); PG8_LDB(B1, 0, 1); PG8_SCHED; PG8_LDA(At, 0, 0); PG8_STAGE(PG8_SA(1, 1), a1 + hstep, voffA);
            PG8_WAIT_V(8); PG8_WAIT_L(0); PG8_BAR; PG8_MMA(0, 0, At, B0); PG8_MMA(0, 1, At, B1); PG8_BAR; PG8_SCHED;
            PG8_LDA(At, 0, 1); PG8_STAGE(PG8_SB(0, 0), b2, voffB); PG8_STAGE(PG8_SB(0, 1), b2 + hstep, voffB); PG8_STAGE(PG8_SA(0, 0), a2, voffA);
            PG8_WAIT_V(8); PG8_WAIT_L(0); PG8_BAR; PG8_MMA(1, 0, At, B0); PG8_MMA(1, 1, At, B1); PG8_BAR; PG8_SCHED;
            PG8_LDB(B0, 1, 0); PG8_LDB(B1, 1, 1); PG8_SCHED; PG8_LDA(At, 1, 0); PG8_STAGE(PG8_SA(0, 1), a2 + hstep, voffA);
            PG8_WAIT_V(8); PG8_WAIT_L(0); PG8_BAR; PG8_MMA(0, 0, At, B0); PG8_MMA(0, 1, At, B1); PG8_BAR; PG8_SCHED;
            PG8_LDA(At, 1, 1); PG8_STAGE(PG8_SB(1, 0), b3, voffB); PG8_STAGE(PG8_SB(1, 1), b3 + hstep, voffB); PG8_STAGE(PG8_SA(1, 0), a3, voffA);
            PG8_WAIT_V(8); PG8_WAIT_L(0); PG8_BAR; PG8_MMA(1, 0, At, B0); PG8_MMA(1, 1, At, B1); PG8_BAR; PG8_SCHED;
        }
        if (wr == 0) PG8_BAR;
        E(acc, cur, wr, wc, fr, fq, lds + EPI_OFF);
        if (!has_next) break;
#pragma unroll
        for (int a = 0; a < 2; ++a)
#pragma unroll
            for (int b = 0; b < 2; ++b)
#pragma unroll
                for (int m = 0; m < 4; ++m)
#pragma unroll
                    for (int n = 0; n < 2; ++n) acc[a][b][m][n] = (f32x4){0.f, 0.f, 0.f, 0.f};
        cur = nxt; cA = nA; cB = nB; ++ui;
        if (wr == 1) PG8_BAR;
    }
    PG8_WAIT_V(0);
    PG8_BAR;
#undef PG8_SA
#undef PG8_SB
#undef PG8_STAGE
#undef PG8_LDA
#undef PG8_LDB
#undef PG8_MMA
#undef PG8_WAIT_V
#undef PG8_WAIT_L
#undef PG8_SCHED
}
}
namespace mk {
typedef f32x4 Acc[2][2][4][2];

struct EpiRes {
    static constexpr bool PERM = false;
    bf16_t* xb16; float* yout; float* rssp;
    __device__ __forceinline__ void operator()(Acc& acc, const Unit& u, int wr, int wc, int fr, int fq, MK_LAS unsigned char* lds) const {
        asm volatile("" : "+v"(fr), "+v"(fq)); const int lane = fq * 16 + fr;
        const int row0 = u.pm * BM + wr * 64 + fr, col0 = u.pn * BM + wc * 32 + 4 * fq;
        MK_LAS float* P = (MK_LAS float*)lds;
#pragma unroll
        for (int ai = 0; ai < 2; ++ai)
#pragma unroll
            for (int m = 0; m < 4; ++m) { const int row = row0 + ai * HALF + m * 16; const unsigned off = (unsigned)row * D + col0; float ss = 0.f;
#pragma unroll
                for (int bj = 0; bj < 2; ++bj)
#pragma unroll
                    for (int n = 0; n < 2; ++n) { const unsigned o = off + bj * HALF + n * 16; const u32x2 xo = *(const u32x2*)(xb16 + o);
                        const f32x4 v = acc[ai][bj][m][n] + (f32x4){bflo(xo.x), bfhi(xo.x), bflo(xo.y), bfhi(xo.y)};
                        u32x2 w; w.x = cvt_pk_bf16(v[0], v[1]); w.y = cvt_pk_bf16(v[2], v[3]); *(u32x2*)(xb16 + o) = w;
                        if (yout) *(f32x4*)(yout + o) = v;
                        ss += (v[0] * v[0] + v[1] * v[1]) + (v[2] * v[2] + v[3] * v[3]); }
                ss += SHX(ss, 16); ss += SHX(ss, 32);
                if (fq == 0) P[(ai * HALF + wr * 64 + m * 16 + fr) * 4 + wc] = ss;
                asm volatile("" ::: "memory"); }
        LDS_WAIT(); __builtin_amdgcn_s_barrier(); asm volatile("" ::: "memory");
        if (fq == 0) {
#pragma unroll
            for (int ai = 0; ai < 2; ++ai)
#pragma unroll
                for (int m = 0; m < 4; ++m) if (((ai * 4 + m) >> 1) == wc) { const int rl = ai * HALF + wr * 64 + m * 16 + fr; const f32x4 p = *(const MK_LAS f32x4*)(P + rl * 4);
                    rssp[(unsigned)(u.pm * BM + rl) * 8 + u.pn] = (p[0] + p[1]) + (p[2] + p[3]); } }
    }
};

struct EpiInAB {
    static constexpr bool PERM = true;
    bf16_t* Z; const float* rss; const float* qn; const float* kn; float* kv_out; float* conv_out;
    __device__ __forceinline__ void operator()(Acc& acc, const Unit& u, int wr, int wc, int fr, int fq, MK_LAS unsigned char* lds) const {
        asm volatile("" : "+v"(fr), "+v"(fq)); const int lane = fq * 16 + fr;
        const int kind = u.pn >> 2; const int row0 = u.pm * BM + wr * 64 + fr; const int cw = (u.pn & 3) * 256 + wc * 32 + 8 * fq;
        MK_LAS float* P = (MK_LAS float*)lds;
#pragma unroll
        for (int ai = 0; ai < 2; ++ai)
#pragma unroll
            for (int m = 0; m < 4; ++m) { const float rs = fast_rsq(rss_p(rss, row0 + ai * HALF + m * 16) * (1.0f / D) + EPS);
#pragma unroll
                for (int bj = 0; bj < 2; ++bj) { acc[ai][bj][m][0] = acc[ai][bj][m][0] * rs; acc[ai][bj][m][1] = acc[ai][bj][m][1] * rs;
                    if (kind <= 1) { const f32x4 v = acc[ai][bj][m][0], x = acc[ai][bj][m][1]; float s = ((v[0] * v[0] + v[1] * v[1]) + (v[2] * v[2] + v[3] * v[3])) + ((x[0] * x[0] + x[1] * x[1]) + (x[2] * x[2] + x[3] * x[3]));
                        s += SHX(s, 16); s += SHX(s, 32);
                        if (fq == 0) P[((ai * HALF + wr * 64 + m * 16 + fr) * 2 + bj) * 4 + wc] = s; } }
                asm volatile("" ::: "memory"); }
        f32x4 g0 = (f32x4){1.f, 1.f, 1.f, 1.f}, g1 = g0;
        if (kind <= 1) { LDS_WAIT(); __builtin_amdgcn_s_barrier(); asm volatile("" ::: "memory");
            const float* gp = (kind == 0 ? qn : kn) + wc * 32 + 8 * fq; g0 = *(const f32x4*)gp; g1 = *(const f32x4*)(gp + 4); }
#pragma unroll
        for (int ai = 0; ai < 2; ++ai)
#pragma unroll
            for (int m = 0; m < 4; ++m) { const int row = row0 + ai * HALF + m * 16; const int t = row & (SEQ - 1), b = row >> 12;
#pragma unroll
                for (int bj = 0; bj < 2; ++bj) { f32x4 v0 = acc[ai][bj][m][0], v1 = acc[ai][bj][m][1];
                    if (kind <= 1) { const f32x4 p = *(const MK_LAS f32x4*)(P + ((ai * HALF + wr * 64 + m * 16 + fr) * 2 + bj) * 4);
                        const float hs = fast_rsq(((p[0] + p[1]) + (p[2] + p[3])) * (1.0f / DH) + EPS); v0 = v0 * hs * g0; v1 = v1 * hs * g1; }
                    u32x4 w; w.x = cvt_pk_bf16(v0[0], v0[1]); w.y = cvt_pk_bf16(v0[2], v0[3]); w.z = cvt_pk_bf16(v1[0], v1[1]); w.w = cvt_pk_bf16(v1[2], v1[3]);
                    *(u32x4*)(Z + (unsigned)row * N_AB + kind * 1024 + cw + bj * HALF) = w;
                    if ((kind == 1 || kind == 2) && t >= SEQ - LA) { float* o = kv_out + (((unsigned)b * LA + (t - (SEQ - LA))) * 2 + (kind - 1)) * WA + cw + bj * HALF; *(f32x4*)o = v0; *(f32x4*)(o + 4) = v1; }
                    if (kind == 3 && t >= SEQ - 3) { float* o = conv_out + ((unsigned)b * 3 + (t - (SEQ - 3))) * WB + cw + bj * HALF; *(f32x4*)o = v0; *(f32x4*)(o + 4) = v1; } }
                asm volatile("" ::: "memory"); }
    }
};

struct EpiInCD {
    static constexpr bool PERM = true;
    bf16_t* Z; const float* rss; const float* lb; const float* bg; float* lgc; float* lgd;
    __device__ __forceinline__ void operator()(Acc& acc, const Unit& u, int wr, int wc, int fr, int fq, MK_LAS unsigned char*) const {
        asm volatile("" : "+v"(fr), "+v"(fq));
        const int pn = u.pn; const int row0 = u.pm * BM + wr * 64 + fr; const int c8 = wc * 32 + 8 * fq;
        const int mode = (pn >= 4 && pn < 8) ? 1 : (pn >= 28 ? 2 : 0);
        const float sc = (pn == 16 || pn == 17) ? 0.08838834764831845f : 1.0f;
#pragma unroll
        for (int ai = 0; ai < 2; ++ai)
#pragma unroll
            for (int m = 0; m < 4; ++m) { const int row = row0 + ai * HALF + m * 16; const float rs = sc * fast_rsq(rss_p(rss, row) * (1.0f / D) + EPS);
#pragma unroll
                for (int bj = 0; bj < 2; ++bj) { f32x4 v0 = acc[ai][bj][m][0] * rs, v1 = acc[ai][bj][m][1] * rs; const int ct = c8 + bj * HALF;
                    if (mode == 1) { const int ck = (pn - 4) * 256 + ct; const f32x4 l0 = *(const f32x4*)(lb + ck), l1 = *(const f32x4*)(lb + ck + 4); f32x4 g0, g1;
#pragma unroll
                        for (int j = 0; j < 4; ++j) { const float s0 = sigmoid_f(v0[j]), s1 = sigmoid_f(v1[j]);
                            g0[j] = fmaxf(fast_ln(l0[j] + (1.0f - l0[j]) * s0), -60.0f); g1[j] = fmaxf(fast_ln(l1[j] + (1.0f - l1[j]) * s1), -60.0f);
                            v0[j] = (1.0f - l0[j]) * (1.0f - s0); v1[j] = (1.0f - l1[j]) * (1.0f - s1); }
                        float* o = lgc + (unsigned)row * 1024 + ck; *(f32x4*)o = g0; *(f32x4*)(o + 4) = g1; }
                    if (mode == 2) { const int ck = (pn - 28) * 256 + ct; const f32x4 b0 = *(const f32x4*)(bg + ck), b1 = *(const f32x4*)(bg + ck + 4); f32x4 g0, g1;
#pragma unroll
                        for (int j = 0; j < 4; ++j) { const float x0 = v0[j] + b0[j], x1 = v1[j] + b1[j];
                            g0[j] = (fminf(x0, 0.f) - fast_ln(1.0f + fast_exp(-fabsf(x0)))) * 0.0625f;
                            g1[j] = (fminf(x1, 0.f) - fast_ln(1.0f + fast_exp(-fabsf(x1)))) * 0.0625f; }
                        float* o = lgd + (unsigned)row * 512 + ck; *(f32x4*)o = g0; *(f32x4*)(o + 4) = g1; }
                    else { u32x4 w; w.x = cvt_pk_bf16(v0[0], v0[1]); w.y = cvt_pk_bf16(v0[2], v0[3]); w.z = cvt_pk_bf16(v1[0], v1[1]); w.w = cvt_pk_bf16(v1[2], v1[3]);
                        *(u32x4*)(Z + (unsigned)row * N_CDZ + pn * 256 + ct) = w; } } }
    }
};

struct EpiUp {
    static constexpr bool PERM = true;
    bf16_t* HB; const float* rss; const float* cw; const float* cb; float* ghead; float* gtail; float* ffn_out;
    __device__ __forceinline__ void operator()(Acc& acc, const Unit& u, int wr, int wc, int fr, int fq, MK_LAS unsigned char* lds) const {
        asm volatile("" : "+v"(fr), "+v"(fq));
        const int lane = fq * 16 + fr; const int row0 = u.pm * BM + wr * 64 + fr; const int c8 = wc * 32 + 8 * fq, cg = u.pn * 128 + c8;
        MK_LAS float* T = (MK_LAS float*)lds;
        f32x4 w0 = *(const f32x4*)(cw + cg), w1 = *(const f32x4*)(cw + FF + cg), w2 = *(const f32x4*)(cw + 2 * FF + cg), bb = *(const f32x4*)(cb + cg);
#pragma unroll
        for (int ai = 0; ai < 2; ++ai)
#pragma unroll
            for (int m = 0; m < 4; ++m) { const float rs = fast_rsq(rss_p(rss, row0 + ai * HALF + m * 16) * (1.0f / D) + EPS);
#pragma unroll
                for (int bj = 0; bj < 2; ++bj) { acc[ai][bj][m][0] = acc[ai][bj][m][0] * rs; acc[ai][bj][m][1] = acc[ai][bj][m][1] * rs; } }
        if (fr >= 14) {
#pragma unroll
            for (int ai = 0; ai < 2; ++ai) { MK_LAS float* t = T + ((2 * ai + wr) * 2 + (fr - 14)) * 128 + c8; *(MK_LAS f32x4*)t = acc[ai][0][3][0]; *(MK_LAS f32x4*)(t + 4) = acc[ai][0][3][1]; }
        }
        LDS_WAIT(); __builtin_amdgcn_s_barrier(); asm volatile("" ::: "memory");
        const int s1 = (lane & 48) | ((fr + 15) & 15), s2 = (lane & 48) | ((fr + 14) & 15);
        const bool first_tile = (u.pm & 15) == 0;
#pragma unroll
        for (int n = 0; n < 2; ++n) {
            if (n == 1) { w0 = *(const f32x4*)(cw + cg + 4); w1 = *(const f32x4*)(cw + FF + cg + 4); w2 = *(const f32x4*)(cw + 2 * FF + cg + 4); bb = *(const f32x4*)(cb + cg + 4); }
#pragma unroll
            for (int ai = 0; ai < 2; ++ai) { const int grp = 2 * ai + wr; f32x4 prev1, prev2;
                if (grp == 0) { prev1 = (f32x4){0.f, 0.f, 0.f, 0.f}; prev2 = prev1; }
                else { const f32x4 r63 = *(const MK_LAS f32x4*)(T + ((grp - 1) * 2 + 1) * 128 + c8 + 4 * n), r62 = *(const MK_LAS f32x4*)(T + ((grp - 1) * 2 + 0) * 128 + c8 + 4 * n); prev1 = r63; prev2 = (fr == 0) ? r62 : r63; }
#pragma unroll
                for (int m = 0; m < 4; ++m) { const int row = row0 + ai * HALF + m * 16; const f32x4 x = acc[ai][0][m][n]; f32x4 r1, r2, hv;
#pragma unroll
                    for (int j = 0; j < 4; ++j) { r1[j] = SHL(x[j], s1); r2[j] = SHL(x[j], s2); }
                    const f32x4 p1 = (fr >= 1) ? r1 : prev1, p2 = (fr >= 2) ? r2 : prev2;
                    prev1 = r1; prev2 = r2;
                    const f32x4 gc = bb + w0 * p2 + w1 * p1 + w2 * x; const f32x4 uu = acc[ai][1][m][n];
#pragma unroll
                    for (int j = 0; j < 4; ++j) hv[j] = silu_f(gc[j]) * uu[j];
                    const bool deferred = (grp == 0) && (m == 0) && (fr < 2) && !first_tile;
                    if (deferred) { float* o = ghead + ((unsigned)u.pm * 2 + fr) * (2 * FF) + cg + 4 * n; *(f32x4*)o = x; *(f32x4*)(o + FF) = uu; }
                    if (grp == 3 && m == 3 && fr >= 14) { *(f32x4*)(gtail + ((unsigned)u.pm * 2 + (fr - 14)) * FF + cg + 4 * n) = x;
                        if ((u.pm & 15) == 15) *(f32x4*)(ffn_out + ((unsigned)(u.pm >> 4) * 2 + (fr - 14)) * FF + cg + 4 * n) = x; }
                    if (!deferred) { u32x2 w; w.x = cvt_pk_bf16(hv[0], hv[1]); w.y = cvt_pk_bf16(hv[2], hv[3]); *(u32x2*)(HB + (unsigned)row * FF + cg + 4 * n) = w; }
                    asm volatile("" ::: "memory"); } } }
    }
};

template <int NT> struct SgLd { static constexpr int LDR = 16 * NT + 4, SLAB = 64 * LDR; };
template <int NT> __device__ __forceinline__ float sred4(const MK_LAS float* red, int row, int col) { constexpr int LDR = SgLd<NT>::LDR, SLAB = SgLd<NT>::SLAB; const MK_LAS float* p = red + row * LDR + col; return (p[0] + p[SLAB]) + (p[2 * SLAB] + p[3 * SLAB]); }
template <int NT> __device__ __forceinline__ void sgemm_tile(MK_LAS float* red, const bf16_t* A, const bf16_t* Bt, int K, int n0, int wave, int lane) {
    constexpr int LDR = SgLd<NT>::LDR, SLAB = SgLd<NT>::SLAB;
    f32x4 acc[4][NT];
#pragma unroll
    for (int a = 0; a < 4; ++a)
#pragma unroll
        for (int b = 0; b < NT; ++b) acc[a][b] = (f32x4){0.f, 0.f, 0.f, 0.f};
    const int fr = lane & 15, g = lane >> 4;
    const bf16_t* ap = A + (size_t)fr * K + 8 * g; const bf16_t* bp = Bt + (size_t)(n0 + fr) * K + 8 * g;
    bf16x8 a[4], b[NT], a2[4], b2[NT];
    if (wave < K / 32) {
#pragma unroll
        for (int mt = 0; mt < 4; ++mt) a[mt] = *(const bf16x8*)(ap + (size_t)(16 * mt) * K + 32 * wave);
#pragma unroll
        for (int nt = 0; nt < NT; ++nt) b[nt] = *(const bf16x8*)(bp + (size_t)(16 * nt) * K + 32 * wave); }
    for (int ks = wave; ks < K / 32; ks += 8) { const int kn = (ks + 8 < K / 32) ? ks + 8 : ks;
#pragma unroll
        for (int mt = 0; mt < 4; ++mt) a2[mt] = *(const bf16x8*)(ap + (size_t)(16 * mt) * K + 32 * kn);
#pragma unroll
        for (int nt = 0; nt < NT; ++nt) b2[nt] = *(const bf16x8*)(bp + (size_t)(16 * nt) * K + 32 * kn);
#pragma unroll
        for (int mt = 0; mt < 4; ++mt)
#pragma unroll
            for (int nt = 0; nt < NT; ++nt) acc[mt][nt] = __builtin_amdgcn_mfma_f32_16x16x32_bf16(a[mt], b[nt], acc[mt][nt], 0, 0, 0);
#pragma unroll
        for (int mt = 0; mt < 4; ++mt) a[mt] = a2[mt];
#pragma unroll
        for (int nt = 0; nt < NT; ++nt) b[nt] = b2[nt]; }
    MK_LAS float* slab = red + (wave & 3) * SLAB;
    if (wave < 4) {
#pragma unroll
        for (int mt = 0; mt < 4; ++mt)
#pragma unroll
            for (int nt = 0; nt < NT; ++nt)
#pragma unroll
                for (int e = 0; e < 4; ++e) slab[(16 * mt + 4 * g + e) * LDR + 16 * nt + fr] = acc[mt][nt][e]; }
    LDS_WAIT(); __syncthreads();
    if (wave >= 4) {
#pragma unroll
        for (int mt = 0; mt < 4; ++mt)
#pragma unroll
            for (int nt = 0; nt < NT; ++nt)
#pragma unroll
                for (int e = 0; e < 4; ++e) slab[(16 * mt + 4 * g + e) * LDR + 16 * nt + fr] += acc[mt][nt][e]; }
    LDS_WAIT(); __syncthreads();
}
}
namespace mk {
struct Args { const float* in[32]; float* out; unsigned char* ws; int nlayers; int pad; };
struct Frame {
    MK_LAS unsigned char* lds; unsigned* ctl; unsigned char* ws; float* out; const float* const* in;
    int tid, lane, wave, vcu, G;
};
constexpr size_t O_YP = 0, O_YS = O_YP + (size_t)MP * D, O_KVP = O_YS + (size_t)MS * D, O_KVS = O_KVP + (size_t)2 * NB * LA * 2 * WA, O_CONVP = O_KVS + (size_t)2 * SB * ST * 2 * WA,
    O_CONVS = O_CONVP + (size_t)2 * NB * 3 * WB, O_HP = O_CONVS + (size_t)2 * SB * 3 * WB, O_HS = O_HP + (size_t)2 * NB * WB, O_HGP = O_HS + (size_t)2 * SB * WB,
    O_HGS = O_HGP + (size_t)2 * NB * HC * DK * DVC, O_GLP = O_HGS + (size_t)2 * SB * HC * DK * DVC, O_GLS = O_GLP + (size_t)2 * NB * HD_ * DK * DVD, O_FFP = O_GLS + (size_t)2 * SB * HD_ * DK * DVD,
    O_FFS = O_FFP + (size_t)4 * NB * 2 * FF, O_END = O_FFS + (size_t)4 * SB * 2 * FF;
enum { I_XP = 0, I_XS, I_KV, I_SCONV, I_SH, I_SHG, I_SGL, I_SFF, I_NMIX, I_NFFN, I_WINAB, I_QN, I_KN, I_LCW, I_LCB, I_LWA, I_LBA, I_LWX, I_LBX, I_LLAM, I_WOUTAB, I_WINCD, I_LBL, I_HGN, I_WG2, I_BG, I_GLN, I_WOUTCD, I_WUP, I_FCW, I_FCB, I_WDN };

__device__ __forceinline__ float* rss_ptr(Frame& F, int idx) { return (float*)(F.ws + WS_RSS) + (size_t)idx * MP * 8; }
__device__ __forceinline__ float* rss_sptr(Frame& F, int idx) { return (float*)(F.ws + WS_RSS) + RSS_P_FLOATS + (size_t)idx * MS * 128; }
__device__ __forceinline__ float wave_sum(float v, int lane) {
#pragma unroll
    for (int o = 1; o < 64; o <<= 1) v += SHX(v, o);
    return v;
}
__device__ __forceinline__ int q_next(Frame& F, int q) {
    volatile MK_LAS int* slot = (volatile MK_LAS int*)(F.lds + MISC_OFF + 64);
    __syncthreads();
    if (F.tid == 0) *slot = (int)__hip_atomic_fetch_add(F.ctl + CW_Q + 64 * q, 1u, __ATOMIC_RELAXED, __HIP_MEMORY_SCOPE_AGENT);
    __syncthreads();
    return *slot;
}

struct P0Item { const float* W; bf16_t* WT; const float* gain; int K, ldw, n0, k0, upmap; };
__device__ __forceinline__ P0Item p0_decode(Frame& F, int it) {
    constexpr int I_AB = 32 * 20, I_O = 32 * 8, I_CD = 32 * 28, I_UP = 32 * 43, I_DN = 86 * 8;
    constexpr int PER_PAIR = I_AB + I_O + I_CD + I_O, PER_LAYER = I_UP + I_DN;
    P0Item p; int r = it; p.upmap = 0; p.gain = nullptr;
    if (r < 2 * PER_PAIR) { const int i = r / PER_PAIR; r -= i * PER_PAIR;
        if (r < I_AB) { p.W = F.in[I_WINAB] + (size_t)i * D * N_AB; p.WT = (bf16_t*)(F.ws + WS_WINAB + i * SZ_WINAB); p.gain = F.in[I_NMIX] + (2 * i) * D; p.K = D; p.ldw = N_AB; p.k0 = 64 * (r / 20); p.n0 = 256 * (r % 20); return p; } r -= I_AB;
        if (r < I_O) { p.W = F.in[I_WOUTAB] + (size_t)i * D * D; p.WT = (bf16_t*)(F.ws + WS_WOUTAB + i * SZ_WOUT); p.K = D; p.ldw = D; p.k0 = 64 * (r / 8); p.n0 = 256 * (r % 8); return p; } r -= I_O;
        if (r < I_CD) { p.W = F.in[I_WINCD] + (size_t)i * D * N_CD_SRC; p.WT = (bf16_t*)(F.ws + WS_WINCD + i * SZ_WINCD); p.gain = F.in[I_NMIX] + (2 * i + 1) * D; p.K = D; p.ldw = N_CD_SRC; p.k0 = 64 * (r / 28); p.n0 = 256 * (r % 28); return p; } r -= I_CD;
        p.W = F.in[I_WOUTCD] + (size_t)i * D * D; p.WT = (bf16_t*)(F.ws + WS_WOUTCD + i * SZ_WOUT); p.K = D; p.ldw = D; p.k0 = 64 * (r / 8); p.n0 = 256 * (r % 8); return p; }
    r -= 2 * PER_PAIR; const int l = r / PER_LAYER; r -= l * PER_LAYER;
    if (r < I_UP) { p.W = F.in[I_WUP] + (size_t)l * D * N_UP; p.WT = (bf16_t*)(F.ws + WS_WUP + l * SZ_WUP); p.gain = F.in[I_NFFN] + l * D; p.K = D; p.ldw = N_UP; p.k0 = 64 * (r / 43); p.n0 = 256 * (r % 43); p.upmap = 1; return p; } r -= I_UP;
    p.W = F.in[I_WDN] + (size_t)l * FF * D; p.WT = (bf16_t*)(F.ws + WS_WDN + l * SZ_WDN); p.K = FF; p.ldw = D; p.k0 = 64 * (r / 8); p.n0 = 256 * (r % 8); return p;
}
__device__ __forceinline__ void p0_load(const P0Item& p, int wave, int lane, f32x4 (&v)[8]) {
    const float* src = p.W + (size_t)(p.k0 + 8 * wave) * p.ldw + p.n0 + 4 * lane;
#pragma unroll
    for (int r = 0; r < 8; ++r) v[r] = *(const f32x4*)(src + (size_t)r * p.ldw);
}
__device__ __forceinline__ void p0_store(const P0Item& p, int tid, int wave, int lane, f32x4 (&v)[8], MK_LAS unsigned char* img) {
    if (p.gain) {
#pragma unroll
        for (int r = 0; r < 8; ++r) v[r] = v[r] * p.gain[p.k0 + 8 * wave + r]; }
#pragma unroll
    for (int j = 0; j < 4; ++j) { u32x4 o; o.x = pk2(v[0][j], v[1][j]); o.y = pk2(v[2][j], v[3][j]); o.z = pk2(v[4][j], v[5][j]); o.w = pk2(v[6][j], v[7][j]);
        *(MK_LAS u32x4*)(img + (4 * lane + j) * 144 + 16 * wave) = o; }
    LDS_WAIT(); __syncthreads();
#pragma unroll
    for (int q = 0; q < 4; ++q) { const int n = (tid >> 3) + 64 * q, ch = tid & 7; const int c = p.n0 + n; int drow = c;
        if (p.upmap) { const int cc = c < FF ? c : c - FF; drow = (cc >> 7) * 256 + (cc & 127) + (c < FF ? 0 : 128); }
        *(u32x4*)(p.WT + (size_t)drow * p.K + p.k0 + 8 * ch) = *(const MK_LAS u32x4*)(img + n * 144 + 16 * ch); }
}
__device__ __forceinline__ void p0_prologue(Frame& F) {
    const int gw = F.vcu * 8 + F.wave, NGW = F.G * 8; const int lane = F.lane;
    constexpr int NITEMS = 2 * (32 * 20 + 32 * 8 + 32 * 28 + 32 * 8) + 4 * (32 * 43 + 86 * 8);
    { f32x4 va[8], vb[8]; int it = F.vcu; P0Item pa, pb; MK_LAS unsigned char* img0 = F.lds; MK_LAS unsigned char* img1 = F.lds + 40960;
      if (it < NITEMS) { pa = p0_decode(F, it); p0_load(pa, F.wave, lane, va); }
      while (it < NITEMS) {
          const int it1 = it + F.G; if (it1 < NITEMS) { pb = p0_decode(F, it1); p0_load(pb, F.wave, lane, vb); }
          p0_store(pa, F.tid, F.wave, lane, va, img0);
          if (it1 >= NITEMS) break;
          const int it2 = it1 + F.G; if (it2 < NITEMS) { pa = p0_decode(F, it2); p0_load(pa, F.wave, lane, va); }
          p0_store(pb, F.tid, F.wave, lane, vb, img1);
          it = it2; }
      __syncthreads(); }
    const int gt = F.vcu * 512 + F.tid, NGT = F.G * 512;
    for (int it = gt; it < 2 * 512 * (D / 8); it += NGT) { const int k8 = it % (D / 8), n = (it / (D / 8)) % 512, i = it / (512 * (D / 8));
        const float* W = F.in[I_WINCD] + (size_t)i * D * N_CD_SRC; const float* g2 = F.in[I_WG2] + (size_t)i * 16 * 512; const float* gn = F.in[I_NMIX] + (2 * i + 1) * D; float v[8];
#pragma unroll
        for (int j = 0; j < 8; ++j) { const int k = 8 * k8 + j; float s = 0.f;
#pragma unroll
            for (int r = 0; r < 16; ++r) s += W[(size_t)k * N_CD_SRC + N_CDZ + r] * g2[r * 512 + n];
            v[j] = s * gn[k]; }
        u32x4 o; o.x = pk2(v[0], v[1]); o.y = pk2(v[2], v[3]); o.z = pk2(v[4], v[5]); o.w = pk2(v[6], v[7]);
        *(u32x4*)((bf16_t*)(F.ws + WS_WINCD + i * SZ_WINCD) + (size_t)(N_CDZ + n) * D + 8 * k8) = o; }
    for (int it = gt; it < 2 * 8 * 2 * 128 * 16; it += NGT) { const int i8 = it % 16, o_ = (it / 16) % 128, gate = (it / 2048) % 2, h = (it / 4096) % 8, i = it / 32768;
        const float* W = F.in[gate ? I_LWX : I_LWA] + ((size_t)(i * 8 + h) * 128) * 128; float v[8];
#pragma unroll
        for (int j = 0; j < 8; ++j) v[j] = W[(size_t)(8 * i8 + j) * 128 + o_];
        u32x4 o; o.x = pk2(v[0], v[1]); o.y = pk2(v[2], v[3]); o.z = pk2(v[4], v[5]); o.w = pk2(v[6], v[7]);
        *(u32x4*)((bf16_t*)(F.ws + WS_WLRU) + ((size_t)((i * 8 + h) * 2 + gate) * 128 + o_) * 128 + 8 * i8) = o; }
    for (int k = gt; k < 1024; k += NGT) { const float a = F.in[I_LBL][k], b = F.in[I_LBL][1024 + k]; const float m = fmaxf(a, b), ea = expf(a - m), eb = expf(b - m), p0 = ea / (ea + eb), p1 = eb / (ea + eb);
        float* lb = (float*)(F.ws + WS_LB); lb[k] = p0 - p0; lb[1024 + k] = (p0 + p1) - p0; }
    for (int m = gw; m < MT; m += NGW) { const float* xr = (m < MP) ? F.in[I_XP] + (size_t)m * D : F.in[I_XS] + (size_t)(m - MP) * D; bf16_t* orow = (bf16_t*)(F.ws + WS_XB16) + (size_t)m * D; float s = 0.f;
#pragma unroll
        for (int j = 0; j < 8; ++j) { const f32x4 v = *(const f32x4*)(xr + 4 * lane + 256 * j); s += (v[0] * v[0] + v[1] * v[1]) + (v[2] * v[2] + v[3] * v[3]);
            u32x2 w; w.x = pk2(v[0], v[1]); w.y = pk2(v[2], v[3]); *(u32x2*)(orow + 4 * lane + 256 * j) = w; }
        s = wave_sum(s, lane);
        if (m < MP) { if (lane < 8) rss_ptr(F, 0)[(size_t)m * 8 + lane] = lane == 0 ? s : 0.f; } else { rss_sptr(F, 0)[(size_t)(m - MP) * 128 + lane] = lane == 0 ? s : 0.f; rss_sptr(F, 0)[(size_t)(m - MP) * 128 + 64 + lane] = 0.f; } }
}

__device__ __forceinline__ void sample_units_range(Frame& F, int nwg_main, int nsu, int& s0, int& sstep) {
    const int rem = nwg_main % F.G; const int c = opaque_bid();
    if (rem == 0) { s0 = c; sstep = F.G; } else if (c >= rem) { s0 = c - rem; sstep = F.G - rem; } else { s0 = nsu; sstep = 1; }
}
__device__ __forceinline__ void sample_in_ab(Frame& F, int i, const bf16_t* Wt, const float* rss) {
    MK_LAS float* red = (MK_LAS float*)F.lds; int s0, sstep; sample_units_range(F, 32 * (N_AB / 256), N_AB / 128, s0, sstep);
    const bf16_t* A = (const bf16_t*)(F.ws + WS_XB16) + (size_t)MP * D; float* zs = (float*)(F.ws + WS_ZS);
    for (int su = s0; su < N_AB / 128; su += sstep) {
        sgemm_tile<8>(red, A, Wt, D, 128 * su, F.wave, F.lane);
        const int lane = F.lane; const int row = F.tid >> 3, part = F.tid & 7, kind = su >> 3, cw = (su & 7) * 128 + 16 * part; const float rs = fast_rsq(rss_s(rss, row) * (1.0f / D) + EPS);
        float v[16]; float ss = 0.f;
#pragma unroll
        for (int j = 0; j < 16; ++j) { v[j] = sred4<8>(red, row, 16 * part + j) * rs; ss += v[j] * v[j]; }
        if (kind <= 1) { ss += SHX(ss, 1); ss += SHX(ss, 2); ss += SHX(ss, 4); const float hs = fast_rsq(ss * (1.0f / DH) + EPS); const float* gp = F.in[kind ? I_KN : I_QN] + i * DH + 16 * part;
#pragma unroll
            for (int j = 0; j < 16; ++j) v[j] = v[j] * hs * gp[j]; }
        float* zo = zs + (size_t)row * N_CD + 128 * su + 16 * part;
#pragma unroll
        for (int j = 0; j < 16; ++j) zo[j] = v[j];
        if (kind == 1 || kind == 2) { float* o = F.out + O_KVS + (((size_t)i * MS + row) * 2 + (kind - 1)) * WA + cw;
#pragma unroll
            for (int j = 0; j < 16; ++j) o[j] = v[j]; }
        if (kind == 3 && (row & 7) >= 5) { float* o = F.out + O_CONVS + (((size_t)i * SB + (row >> 3)) * 3 + ((row & 7) - 5)) * WB + cw;
#pragma unroll
            for (int j = 0; j < 16; ++j) o[j] = v[j]; }
        __syncthreads();
    }
}
__device__ __forceinline__ void sample_plain(Frame& F, const bf16_t* Wt, const float* rss, int N, int nwg_main, float* dst, int ldd, bool up_map) {
    MK_LAS float* red = (MK_LAS float*)F.lds; int s0, sstep; sample_units_range(F, nwg_main, N / 128, s0, sstep);
    const bf16_t* A = (const bf16_t*)(F.ws + WS_XB16) + (size_t)MP * D;
    for (int su = s0; su < N / 128; su += sstep) {
        sgemm_tile<8>(red, A, Wt, D, 128 * su, F.wave, F.lane);
        const int row = F.tid >> 3, part = F.tid & 7; const float rs = fast_rsq(rss_s(rss, row) * (1.0f / D) + EPS);
        const int col = up_map ? ((su & 1) * FF + (su >> 1) * 128) : 128 * su;
        float* o = dst + (size_t)row * ldd + col + 16 * part;
#pragma unroll
        for (int j = 0; j < 16; ++j) o[j] = sred4<8>(red, row, 16 * part + j) * rs;
        __syncthreads();
    }
}
__device__ __forceinline__ void sample_res(Frame& F, const bf16_t* A, const bf16_t* Wt, int K, float* yout, float* rss_next) {
    MK_LAS float* red = (MK_LAS float*)F.lds; int s0, sstep; sample_units_range(F, 256, D / 16, s0, sstep);
    bf16_t* xb = (bf16_t*)(F.ws + WS_XB16) + (size_t)MP * D;
    for (int su = s0; su < D / 16; su += sstep) {
        sgemm_tile<1>(red, A, Wt, K, 16 * su, F.wave, F.lane);
        const int lane = F.lane; const int row = F.tid >> 3, c2 = 2 * (F.tid & 7); const size_t o = (size_t)row * D + 16 * su + c2;
        const unsigned xo = *(const unsigned*)(xb + o);
        const float v0 = bflo(xo) + sred4<1>(red, row, c2), v1 = bfhi(xo) + sred4<1>(red, row, c2 + 1);
        *(unsigned*)(xb + o) = pk2(v0, v1); if (yout) { yout[o] = v0; yout[o + 1] = v1; }
        float ss = v0 * v0 + v1 * v1; ss += SHX(ss, 1); ss += SHX(ss, 2); ss += SHX(ss, 4);
        if ((F.tid & 7) == 0) rss_next[(size_t)row * 128 + su] = ss;
        __syncthreads();
    }
}

__device__ __forceinline__ void ffn_fixup(Frame& F, int layer) {
    const int gt = F.vcu * 512 + F.tid, NGT = F.G * 512;
    const float* cw = F.in[I_FCW] + (size_t)layer * 3 * FF; const float* cb = F.in[I_FCB] + (size_t)layer * FF;
    const float* ghead = (const float*)(F.ws + WS_GHEAD); const float* gtail = (const float*)(F.ws + WS_GTAIL); bf16_t* HBp = (bf16_t*)(F.ws + WS_Z);
    for (int it = gt; it < 30 * 2 * FF; it += NGT) { const int f = it % FF, r = (it / FF) & 1, ti = it / (2 * FF); const int pm = ti + 1 + (ti >= 15 ? 1 : 0);
        const float g0 = ghead[((size_t)pm * 2 + 0) * (2 * FF) + f], t0 = gtail[((size_t)(pm - 1) * 2 + 0) * FF + f], t1 = gtail[((size_t)(pm - 1) * 2 + 1) * FF + f];
        float gc, uu;
        if (r == 0) { gc = cb[f] + cw[f] * t0 + cw[FF + f] * t1 + cw[2 * FF + f] * g0; uu = ghead[((size_t)pm * 2 + 0) * (2 * FF) + FF + f]; }
        else { const float g1 = ghead[((size_t)pm * 2 + 1) * (2 * FF) + f]; gc = cb[f] + cw[f] * t1 + cw[FF + f] * g0 + cw[2 * FF + f] * g1; uu = ghead[((size_t)pm * 2 + 1) * (2 * FF) + FF + f]; }
        HBp[(size_t)(pm * 256 + r) * FF + f] = (bf16_t)f2bf(silu_f(gc) * uu); }
    const float* gus = (const float*)(F.ws + WS_GUS); const float* sbuf = F.in[I_SFF] + (size_t)layer * SB * 2 * FF;
    for (int it = gt; it < MS * FF; it += NGT) { const int f = it % FF, row = it / FF, t = row & 7, b = row >> 3;
        const float x0 = gus[(size_t)row * N_UP + f];
        const float x1 = (t >= 1) ? gus[(size_t)(row - 1) * N_UP + f] : sbuf[((size_t)b * 2 + 1) * FF + f];
        const float x2 = (t >= 2) ? gus[(size_t)(row - 2) * N_UP + f] : sbuf[((size_t)b * 2 + t) * FF + f];
        const float gc = cb[f] + cw[f] * x2 + cw[FF + f] * x1 + cw[2 * FF + f] * x0;
        HBp[(size_t)(MP + row) * FF + f] = (bf16_t)f2bf(silu_f(gc) * gus[(size_t)row * N_UP + FF + f]);
        if (t >= 6) F.out[O_FFS + (((size_t)layer * SB + b) * 2 + (t - 6)) * FF + f] = x0; }
}
}
namespace mk {
__device__ __forceinline__ s16x4 tr_read4(unsigned addr) { s16x4 r; asm volatile("ds_read_b64_tr_b16 %0, %1\n\ts_waitcnt lgkmcnt(0)" : "=&v"(r) : "v"(addr) : "memory"); return r; }

constexpr int ATT_VSTRIDE = 288;
__device__ __forceinline__ void att_seg(int st, int t0, int& base, int& dil, int& win) {
    if (st < 12) { base = t0 - 128 + 32 * st; dil = 1; win = 128; } else if (st < 18) { base = t0 - 512 + 4 * 32 * (st - 12); dil = 4; win = 512; } else { base = t0 - 2048 + 16 * 32 * (st - 18); dil = 16; win = 2048; }
}
__device__ __forceinline__ void att_load(const bf16_t* Zb, int h, int base, int dil, int lane, bf16x8 (&kf)[2][4], u32x4 (&vv)[8]) {
    const int qi = lane & 15, g = lane >> 4;
#pragma unroll
    for (int kt = 0; kt < 2; ++kt) { int s = base + dil * (16 * kt + qi); s = s < 0 ? 0 : (s > SEQ - 1 ? SEQ - 1 : s); const bf16_t* kp = Zb + (size_t)s * N_AB + WA + h * DH + 8 * g;
#pragma unroll
        for (int q = 0; q < 4; ++q) kf[kt][q] = *(const bf16x8*)(kp + 32 * q); }
#pragma unroll
    for (int j = 0; j < 8; ++j) { const int c = lane + 64 * j, r = c >> 4, ch = c & 15; int s = base + dil * r; s = s < 0 ? 0 : (s > SEQ - 1 ? SEQ - 1 : s);
        vv[j] = *(const u32x4*)(Zb + (size_t)s * N_AB + 2 * WA + h * DH + 8 * ch); }
}
struct AttState { f32x4 o[8]; float mrun, lrun; };
__device__ __forceinline__ void attn_step(AttState& A, const bf16_t* Zb, int h, int t0, int tq, int st, int lane, MK_LAS unsigned char* vt, unsigned trb, const bf16x8 (&qf)[4],
                                          bf16x8 (&kf)[2][4], u32x4 (&vv)[8], bf16x8 (&kn)[2][4], u32x4 (&vn)[8]) {
    const int g = lane >> 4; const float sc = 0.08838834764831845f * 1.44269504089f;
    int base, dil, win; att_seg(st, t0, base, dil, win);
#pragma unroll
    for (int j = 0; j < 8; ++j) { const int c = lane + 64 * j, r = c >> 4, ch = c & 15; *(MK_LAS u32x4*)(vt + r * ATT_VSTRIDE + 16 * ch) = vv[j]; }
    { int nb, nd, nw; att_seg(st + 1 < 23 ? st + 1 : st, t0, nb, nd, nw); att_load(Zb, h, nb, nd, lane, kn, vn); }
    f32x4 sv[2];
#pragma unroll
    for (int kt = 0; kt < 2; ++kt) { sv[kt] = (f32x4){0.f, 0.f, 0.f, 0.f};
#pragma unroll
        for (int q = 0; q < 4; ++q) sv[kt] = __builtin_amdgcn_mfma_f32_16x16x32_bf16(kf[kt][q], qf[q], sv[kt], 0, 0, 0); }
    float mx = -1e30f; bool val[2][4];
#pragma unroll
    for (int kt = 0; kt < 2; ++kt)
#pragma unroll
        for (int e = 0; e < 4; ++e) { const int s = base + dil * (16 * kt + 4 * g + e); const int dist = tq - s; val[kt][e] = (s >= 0) && (dist >= 0) && (dist <= win);
            sv[kt][e] = val[kt][e] ? sv[kt][e] * sc : -1e30f; mx = fmaxf(mx, sv[kt][e]); }
    mx = fmaxf(mx, SHX(mx, 16)); mx = fmaxf(mx, SHX(mx, 32));
    const float mnew = fmaxf(A.mrun, mx), alpha = fast_exp2(A.mrun - mnew); A.mrun = mnew;
    float ps = 0.f; float p[2][4];
#pragma unroll
    for (int kt = 0; kt < 2; ++kt)
#pragma unroll
        for (int e = 0; e < 4; ++e) { p[kt][e] = val[kt][e] ? fast_exp2(sv[kt][e] - mnew) : 0.f; ps += p[kt][e]; }
    A.lrun = A.lrun * alpha + ps;
    union { bf16x8 v; unsigned u[4]; } pf; pf.u[0] = cvt_pk_bf16(p[0][0], p[0][1]); pf.u[1] = cvt_pk_bf16(p[0][2], p[0][3]); pf.u[2] = cvt_pk_bf16(p[1][0], p[1][1]); pf.u[3] = cvt_pk_bf16(p[1][2], p[1][3]);
    s16x4 t0a, t1a, t2a, t3a, t4a, t5a, t6a, t7a, t0b, t1b, t2b, t3b, t4b, t5b, t6b, t7b;
    asm volatile("s_waitcnt lgkmcnt(0)\n\t"
                 "ds_read_b64_tr_b16 %0, %16\n\tds_read_b64_tr_b16 %1, %16 offset:32\n\tds_read_b64_tr_b16 %2, %16 offset:64\n\tds_read_b64_tr_b16 %3, %16 offset:96\n\t"
                 "ds_read_b64_tr_b16 %4, %16 offset:128\n\tds_read_b64_tr_b16 %5, %16 offset:160\n\tds_read_b64_tr_b16 %6, %16 offset:192\n\tds_read_b64_tr_b16 %7, %16 offset:224\n\t"
                 "ds_read_b64_tr_b16 %8, %16 offset:4608\n\tds_read_b64_tr_b16 %9, %16 offset:4640\n\tds_read_b64_tr_b16 %10, %16 offset:4672\n\tds_read_b64_tr_b16 %11, %16 offset:4704\n\t"
                 "ds_read_b64_tr_b16 %12, %16 offset:4736\n\tds_read_b64_tr_b16 %13, %16 offset:4768\n\tds_read_b64_tr_b16 %14, %16 offset:4800\n\tds_read_b64_tr_b16 %15, %16 offset:4832\n\t"
                 "s_waitcnt lgkmcnt(0)"
                 : "=&v"(t0a), "=&v"(t1a), "=&v"(t2a), "=&v"(t3a), "=&v"(t4a), "=&v"(t5a), "=&v"(t6a), "=&v"(t7a), "=&v"(t0b), "=&v"(t1b), "=&v"(t2b), "=&v"(t3b), "=&v"(t4b), "=&v"(t5b), "=&v"(t6b), "=&v"(t7b)
                 : "v"(trb) : "memory");
#define ATT_PV(d, ta, tb) { union { bf16x8 v; s16x4 hh[2]; } vf; vf.hh[0] = ta; vf.hh[1] = tb; A.o[d] = A.o[d] * alpha; A.o[d] = __builtin_amdgcn_mfma_f32_16x16x32_bf16(vf.v, pf.v, A.o[d], 0, 0, 0); }
    ATT_PV(0, t0a, t0b) ATT_PV(1, t1a, t1b) ATT_PV(2, t2a, t2b) ATT_PV(3, t3a, t3b) ATT_PV(4, t4a, t4b) ATT_PV(5, t5a, t5b) ATT_PV(6, t6a, t6b) ATT_PV(7, t7a, t7b)
#undef ATT_PV
}
__device__ __forceinline__ void attn_item(Frame& F, const bf16_t* Z, bf16_t* MIX, int item, MK_LAS unsigned char* vt) {
    const int lane = F.lane, qi = lane & 15, g = lane >> 4;
    const int rho = item & 15, blk = (item >> 4) & 15, h = (item >> 8) & 7, b = item >> 11;
    const int t0 = 256 * blk + rho, tq = t0 + 16 * qi;
    const bf16_t* Zb = Z + (size_t)b * SEQ * N_AB;
    bf16x8 qf[4];
#pragma unroll
    for (int s = 0; s < 4; ++s) qf[s] = *(const bf16x8*)(Zb + (size_t)tq * N_AB + h * DH + 32 * s + 8 * g);
    AttState A;
#pragma unroll
    for (int d = 0; d < 8; ++d) A.o[d] = (f32x4){0.f, 0.f, 0.f, 0.f};
    A.mrun = -1e30f; A.lrun = 0.f;
    const unsigned vbase = (unsigned)(size_t)vt;
    const unsigned trb = vbase + (4 * g + (qi >> 2)) * ATT_VSTRIDE + (4 * (qi & 3)) * 2;
    bf16x8 k0[2][4], k1[2][4]; u32x4 v0[8], v1[8];
    { int base, dil, win; att_seg(0, t0, base, dil, win); att_load(Zb, h, base, dil, lane, k0, v0); }
#pragma unroll 1
    for (int st = 0; st < 22; st += 2) { attn_step(A, Zb, h, t0, tq, st, lane, vt, trb, qf, k0, v0, k1, v1); attn_step(A, Zb, h, t0, tq, st + 1, lane, vt, trb, qf, k1, v1, k0, v0); }
    attn_step(A, Zb, h, t0, tq, 22, lane, vt, trb, qf, k0, v0, k1, v1);
    float lrun = A.lrun; lrun += SHX(lrun, 16); lrun += SHX(lrun, 32);
    const float inv = fast_rcp(lrun);
    bf16_t* op = MIX + ((size_t)b * SEQ + tq) * D + h * DH + 4 * g;
#pragma unroll
    for (int d = 0; d < 8; ++d) { u32x2 w; w.x = cvt_pk_bf16(A.o[d][0] * inv, A.o[d][1] * inv); w.y = cvt_pk_bf16(A.o[d][2] * inv, A.o[d][3] * inv); *(u32x2*)(op + 16 * d) = w; }
}

__device__ __forceinline__ void sattn_item(Frame& F, int i, int item) {
    const int lane = F.lane, li = lane & 15, g = lane >> 4; const int h = item & 7, t = (item >> 3) & 7, b = item >> 6; const int row = b * 8 + t;
    const float* zs = (const float*)(F.ws + WS_ZS); const float* cache = F.in[I_KV] + (size_t)(i * SB + b) * LA * 2 * WA; const float* kvn = F.out + O_KVS + (size_t)(i * SB + b) * ST * 2 * WA;
    float q[8]; { const f32x4 a = *(const f32x4*)(zs + (size_t)row * N_CD + h * DH + 8 * li), c = *(const f32x4*)(zs + (size_t)row * N_CD + h * DH + 8 * li + 4);
#pragma unroll
        for (int j = 0; j < 4; ++j) { q[j] = a[j]; q[4 + j] = c[j]; } }
    float m = -1e30f, l = 0.f, acc[8];
#pragma unroll
    for (int j = 0; j < 8; ++j) acc[j] = 0.f;
    const float sc = 0.08838834764831845f;
    for (int kb = g; kb < 3 * 129; kb += 16) {
        f32x4 kq[4][2], vq[4][2]; bool ok[4];
#pragma unroll
        for (int u = 0; u < 4; ++u) { const int kk = kb + 4 * u; ok[u] = kk < 3 * 129; const int k2 = ok[u] ? kk : 0; const int grp = k2 / 129, j = k2 - grp * 129; const int dil = grp == 0 ? 1 : (grp == 1 ? 4 : 16); const int idx = LA + t - dil * j;
            const float* kp = (idx < LA) ? cache + ((size_t)idx * 2) * WA + h * DH + 8 * li : kvn + ((size_t)(idx - LA) * 2) * WA + h * DH + 8 * li;
            kq[u][0] = *(const f32x4*)kp; kq[u][1] = *(const f32x4*)(kp + 4); vq[u][0] = *(const f32x4*)(kp + WA); vq[u][1] = *(const f32x4*)(kp + WA + 4); }
#pragma unroll
        for (int u = 0; u < 4; ++u) { const f32x4 k0 = kq[u][0], k1 = kq[u][1], v0 = vq[u][0], v1 = vq[u][1];
            float s = (q[0] * k0[0] + q[1] * k0[1]) + (q[2] * k0[2] + q[3] * k0[3]) + (q[4] * k1[0] + q[5] * k1[1]) + (q[6] * k1[2] + q[7] * k1[3]);
            s += SHX(s, 1); s += SHX(s, 2); s += SHX(s, 4); s += SHX(s, 8); s *= sc;
            if (ok[u]) { const float mn = fmaxf(m, s), al = fast_exp(m - mn), pw = fast_exp(s - mn); l = l * al + pw; m = mn;
#pragma unroll
                for (int jj = 0; jj < 4; ++jj) { acc[jj] = acc[jj] * al + pw * v0[jj]; acc[4 + jj] = acc[4 + jj] * al + pw * v1[jj]; } } } }
    float mm = fmaxf(m, SHX(m, 16)); mm = fmaxf(mm, SHX(mm, 32)); const float f = fast_exp(m - mm); l *= f; l += SHX(l, 16); l += SHX(l, 32);
#pragma unroll
    for (int j = 0; j < 8; ++j) { acc[j] *= f; acc[j] += SHX(acc[j], 16); acc[j] += SHX(acc[j], 32); }
    if (g == 0) { const float inv = fast_rcp(l); u32x4 w; w.x = pk2(acc[0] * inv, acc[1] * inv); w.y = pk2(acc[2] * inv, acc[3] * inv); w.z = pk2(acc[4] * inv, acc[5] * inv); w.w = pk2(acc[6] * inv, acc[7] * inv);
        *(u32x4*)((bf16_t*)(F.ws + WS_MIX) + (size_t)(MP + row) * D + h * DH + 8 * li) = w; }
}

constexpr int LRU_SEG = 256, LRU_NSEG = SEQ / LRU_SEG;
__device__ __forceinline__ void lru_unit(Frame& F, int i, int unit, const bf16_t* Z, bf16_t* MIX) {
    const int seg = unit & 15, hB = (unit >> 4) & 7, b = unit >> 7; const int tid = F.tid, lane = F.lane, w = F.wave, fr = lane & 15, g = lane >> 4;
    MK_LAS float* xc = (MK_LAS float*)F.lds; constexpr int LDX = 132;
    const int ch0 = hB * 128; const int c = ch0 + 16 * w + fr;
    bf16_t* CB = (bf16_t*)(F.ws + WS_SC); float* SUM = (float*)(F.ws + WS_LG);
    const bf16_t* Wl = (const bf16_t*)(F.ws + WS_WLRU) + (size_t)((i * 8 + hB) * 2) * 128 * 128;
    bf16x8 wf[2][4];
#pragma unroll
    for (int gt = 0; gt < 2; ++gt)
#pragma unroll
        for (int s = 0; s < 4; ++s) wf[gt][s] = *(const bf16x8*)(Wl + ((size_t)gt * 128 + 16 * w + fr) * 128 + 32 * s + 8 * g);
    const float ba = F.in[I_LBA][i * WB + c], bx = F.in[I_LBX][i * WB + c]; const float lam = F.in[I_LLAM][i * WB + c];
    const float dk = -8.0f * softplus_acc(-lam);
    const int sc8 = 8 * (tid & 15), stl = tid >> 4;
    float cwv[4][8], cbv[8];
#pragma unroll
    for (int j = 0; j < 8; ++j) { cbv[j] = F.in[I_LCB][i * WB + ch0 + sc8 + j];
#pragma unroll
        for (int tp = 0; tp < 4; ++tp) cwv[tp][j] = F.in[I_LCW][((size_t)i * 4 + tp) * WB + ch0 + sc8 + j]; }
    float hcar = 0.f, pcar = 1.f;
    const bf16_t* Zb = Z + (size_t)b * SEQ * N_AB;
    for (int ck = 0; ck < LRU_SEG / 128; ++ck) { const int tb = seg * LRU_SEG + 128 * ck;
#pragma unroll
        for (int ps = 0; ps < 4; ++ps) { const int tl = stl + 32 * ps, t = tb + tl; float a[8];
#pragma unroll
            for (int j = 0; j < 8; ++j) a[j] = cbv[j];
#pragma unroll
            for (int tp = 0; tp < 4; ++tp) { const int tt = t - 3 + tp; if (tt >= 0) { const u32x4 v = *(const u32x4*)(Zb + (size_t)tt * N_AB + 3 * WA + ch0 + sc8);
                    a[0] += cwv[tp][0] * bflo(v.x); a[1] += cwv[tp][1] * bfhi(v.x); a[2] += cwv[tp][2] * bflo(v.y); a[3] += cwv[tp][3] * bfhi(v.y);
                    a[4] += cwv[tp][4] * bflo(v.z); a[5] += cwv[tp][5] * bfhi(v.z); a[6] += cwv[tp][6] * bflo(v.w); a[7] += cwv[tp][7] * bfhi(v.w); } }
            *(MK_LAS f32x4*)(xc + tl * LDX + sc8) = (f32x4){a[0], a[1], a[2], a[3]}; *(MK_LAS f32x4*)(xc + tl * LDX + sc8 + 4) = (f32x4){a[4], a[5], a[6], a[7]}; }
        LDS_WAIT(); __syncthreads();
#pragma unroll 2
        for (int mt = 0; mt < 8; ++mt) {
            float gbv[4];
#pragma unroll
            for (int e = 0; e < 4; ++e) gbv[e] = bf2f(Zb[(size_t)(tb + 16 * mt + 4 * g + e) * N_AB + 3 * WA + WB + c]);
            f32x4 cr = (f32x4){0.f, 0.f, 0.f, 0.f}, ci = (f32x4){0.f, 0.f, 0.f, 0.f};
#pragma unroll
            for (int s = 0; s < 4; ++s) { const MK_LAS float* xp = xc + (16 * mt + fr) * LDX + 32 * s + 8 * g; const f32x4 x0 = *(const MK_LAS f32x4*)xp, x1 = *(const MK_LAS f32x4*)(xp + 4);
                union { bf16x8 v; unsigned u[4]; } af; af.u[0] = cvt_pk_bf16(x0[0], x0[1]); af.u[1] = cvt_pk_bf16(x0[2], x0[3]); af.u[2] = cvt_pk_bf16(x1[0], x1[1]); af.u[3] = cvt_pk_bf16(x1[2], x1[3]);
                cr = __builtin_amdgcn_mfma_f32_16x16x32_bf16(af.v, wf[0][s], cr, 0, 0, 0); ci = __builtin_amdgcn_mfma_f32_16x16x32_bf16(af.v, wf[1][s], ci, 0, 0, 0); }
            float P[4], H[4]; float pa = 1.f, hh = 0.f;
#pragma unroll
            for (int e = 0; e < 4; ++e) { const float r = sigmoid_f(cr[e] + ba), ig = sigmoid_f(ci[e] + bx); const float la = dk * r; const float a = fast_exp(la);
                const float xv = xc[(16 * mt + 4 * g + e) * LDX + 16 * w + fr]; const float u = fast_sqrt(one_minus_exp(2.0f * la)) * ig * xv;
                pa = pa * a; hh = a * hh + u; P[e] = pa; H[e] = hh; }
            float ip = pa, ih = hh;
            { const float pp = SHUP(ip, 16), ph = SHUP(ih, 16); if (g >= 1) { ih = ip * ph + ih; ip = ip * pp; } }
            { const float pp = SHUP(ip, 32), ph = SHUP(ih, 32); if (g >= 2) { ih = ip * ph + ih; ip = ip * pp; } }
            float ep = SHUP(ip, 16), eh = SHUP(ih, 16); if (g == 0) { ep = 1.f; eh = 0.f; }
            const float hin = ep * hcar + eh;
            const float pin = pcar * ep;
            const float tot_p = SHL(ip, 48 + fr), tot_h = SHL(ih, 48 + fr);
            hcar = tot_p * hcar + tot_h; pcar = pcar * tot_p;
#pragma unroll
            for (int e = 0; e < 4; ++e) { const float hv = P[e] * hin + H[e]; const size_t row = (size_t)b * SEQ + tb + 16 * mt + 4 * g + e; const float ge = gelu_tanh_f(gbv[e]);
                MIX[row * D + WA + c] = (bf16_t)f2bf(hv * ge); CB[row * WB + c] = (bf16_t)f2bf(pin * P[e] * ge); }
        }
        __syncthreads();
    }
    if (g == 0) { float* sp = SUM + ((size_t)((b * 8 + hB) * LRU_NSEG + seg) * 2) * 128 + 16 * w + fr; sp[0] = pcar; sp[128] = hcar; }
}
__device__ __forceinline__ void lru_fix_item(Frame& F, int i, int item) {
    const int tid = F.tid; MK_LAS float* hin = (MK_LAS float*)F.lds;
    const float* SUM = (const float*)(F.ws + WS_LG); const bf16_t* CB = (const bf16_t*)(F.ws + WS_SC); bf16_t* MIX = (bf16_t*)(F.ws + WS_MIX);
    int b, seg, sub; if (item < 240) { b = item / 120; const int r = item % 120; seg = 1 + r / 8; sub = r % 8; } else { b = item - 240; seg = LRU_NSEG; sub = 0; }
    for (int c = tid; c < WB; c += 512) { const int hB = c >> 7, cc = c & 127; float h = 0.f; const float* sp = SUM + ((size_t)((b * 8 + hB) * LRU_NSEG) * 2) * 128 + cc;
        for (int s = 0; s < seg; ++s) h = sp[(size_t)s * 256] * h + sp[(size_t)s * 256 + 128];
        if (item < 240) hin[c] = h; else F.out[O_HP + ((size_t)i * NB + b) * WB + c] = h; }
    LDS_WAIT(); __syncthreads();
    if (item < 240) {
#pragma unroll
        for (int j = 0; j < 8; ++j) { const int gi = tid + 512 * j, tl = gi >> 7, c8 = (gi & 127) * 8; const size_t row = (size_t)b * SEQ + seg * LRU_SEG + 32 * sub + tl;
            const u32x4 cv = *(const u32x4*)(CB + row * WB + c8); u32x4 mv = *(const u32x4*)(MIX + row * D + WA + c8); const f32x4 h0 = *(const MK_LAS f32x4*)(hin + c8), h1 = *(const MK_LAS f32x4*)(hin + c8 + 4);
            mv.x = pk2(bflo(mv.x) + bflo(cv.x) * h0[0], bfhi(mv.x) + bfhi(cv.x) * h0[1]); mv.y = pk2(bflo(mv.y) + bflo(cv.y) * h0[2], bfhi(mv.y) + bfhi(cv.y) * h0[3]);
            mv.z = pk2(bflo(mv.z) + bflo(cv.z) * h1[0], bfhi(mv.z) + bfhi(cv.z) * h1[1]); mv.w = pk2(bflo(mv.w) + bflo(cv.w) * h1[2], bfhi(mv.w) + bfhi(cv.w) * h1[3]);
            *(u32x4*)(MIX + row * D + WA + c8) = mv; } }
    __syncthreads();
}
__device__ __forceinline__ void slru_unit(Frame& F, int i, int unit) {
    const int b = unit >> 3, hB = unit & 7, tid = F.tid; const float* zs = (const float*)(F.ws + WS_ZS);
    MK_LAS float* xc = (MK_LAS float*)F.lds;
    MK_LAS float* gr = xc + 1024;
    MK_LAS float* gi = gr + 1024;
    const int ch0 = hB * 128;
    for (int e = tid; e < 1024; e += 512) { const int cc = e & 127, t = e >> 7; const int c = ch0 + cc; float y = F.in[I_LCB][i * WB + c];
#pragma unroll
        for (int tp = 0; tp < 4; ++tp) { const int tt = t - 3 + tp; const float v = (tt >= 0) ? zs[(size_t)(b * 8 + tt) * N_CD + 3 * WA + c] : F.in[I_SCONV][(((size_t)i * SB + b) * 3 + (tt + 3)) * WB + c];
            y += F.in[I_LCW][((size_t)i * 4 + tp) * WB + c] * v; }
        xc[t * 128 + cc] = y; }
    __syncthreads();
    for (int e = tid; e < 2048; e += 512) { const int cc = e & 127, t = (e >> 7) & 7, gate = e >> 10; const float* W = F.in[gate ? I_LWX : I_LWA] + (size_t)(i * 8 + hB) * 128 * 128; float s = 0.f;
        for (int k = 0; k < 128; ++k) s += xc[t * 128 + k] * W[(size_t)k * 128 + cc];
        const int c = ch0 + cc; s += F.in[gate ? I_LBX : I_LBA][i * WB + c]; (gate ? gi : gr)[t * 128 + cc] = sigmoid_f(s); }
    __syncthreads();
    if (tid < 128) { const int cc = tid, c = ch0 + cc; const float lam = F.in[I_LLAM][i * WB + c]; const float spl = softplus_acc(-lam);
        float h = F.in[I_SH][((size_t)i * SB + b) * WB + c];
        for (int t = 0; t < 8; ++t) { const float la = -8.0f * gr[t * 128 + cc] * spl, a = fast_exp(la); const float u = fast_sqrt(one_minus_exp(2.0f * la)) * gi[t * 128 + cc] * xc[t * 128 + cc];
            h = a * h + u; const float gb = zs[(size_t)(b * 8 + t) * N_CD + 3 * WA + WB + c];
            const float ge = gelu_tanh_f(gb);
            ((bf16_t*)(F.ws + WS_MIX))[(size_t)(MP + b * 8 + t) * D + WA + c] = (bf16_t)f2bf(h * ge); }
        F.out[O_HS + ((size_t)i * SB + b) * WB + c] = h; }
    __syncthreads();
}

template <int WHAT  > __device__ __forceinline__ void mixer_ab(Frame& F, int i, int qid) {
    const bf16_t* Z = (const bf16_t*)(F.ws + WS_Z); bf16_t* MIX = (bf16_t*)(F.ws + WS_MIX);
    constexpr int N_LRU = 256, N_SLRU = 64, N_SATT = 64, N_ATT = 512, N_ALL = N_LRU + N_SLRU + N_SATT + N_ATT;
    for (;;) { const int u = q_next(F, qid); if (u >= N_ALL) break;
        if (WHAT == 1 && u < N_LRU + N_SLRU + N_SATT) continue; if (WHAT == 2 && u >= N_LRU) break;
        if (u < N_LRU) lru_unit(F, i, u, Z, MIX);
        else if (u < N_LRU + N_SLRU) slru_unit(F, i, u - N_LRU);
        else if (u < N_LRU + N_SLRU + N_SATT) sattn_item(F, i, (u - N_LRU - N_SLRU) * 8 + F.wave);
        else attn_item(F, Z, MIX, (u - N_LRU - N_SLRU - N_SATT) * 8 + F.wave, F.lds + F.wave * (32 * ATT_VSTRIDE)); }
}
__device__ __forceinline__ void mixer_ab_fix(Frame& F, int i, int qid) { (void)qid; for (int u = F.vcu; u < 242; u += F.G) lru_fix_item(F, i, u); }
}
namespace mk {
struct GlaCfg { int H, V, qcol, kcol, vcol, gcol, lgld, mixcol; const float* lg; const float* gain; bf16_t* sc; };
__device__ __forceinline__ GlaCfg gla_cfg(Frame& F, int i, int kind) {
    GlaCfg c;
    if (kind == 0) { c.H = HC; c.V = DVC; c.qcol = ZC_QC; c.kcol = ZC_KC; c.vcol = ZC_IC; c.gcol = ZC_GC; c.lgld = 1024; c.mixcol = 0; c.lg = (const float*)(F.ws + WS_LG); c.gain = F.in[I_HGN] + i * DVC; c.sc = (bf16_t*)(F.ws + WS_SC); }
    else { c.H = HD_; c.V = DVD; c.qcol = ZC_QD; c.kcol = ZC_KD; c.vcol = ZC_VD; c.gcol = ZC_RD; c.lgld = 512; c.mixcol = 1024; c.lg = (const float*)(F.ws + WS_LG) + (size_t)MP * 1024; c.gain = F.in[I_GLN] + i * DVD; c.sc = (bf16_t*)(F.ws + WS_SC) + (size_t)NB * HC * NCHUNK * DVC * 128; }
    return c;
}
__device__ __forceinline__ void x2_unit(Frame& F, int i, int unit) {
    const int kind = unit >> 7; const int u = unit & 127; const GlaCfg c = gla_cfg(F, i, kind);
    const int nvs = c.V / 16; const int vs = u % nvs, hd = (u / nvs) % c.H, b = u / (nvs * c.H);
    const int lane = F.lane, w = F.wave, fr = lane & 15, g = lane >> 4;
    const bf16_t* Z = (const bf16_t*)(F.ws + WS_Z) + (size_t)b * SEQ * N_CDZ; const float* LG = c.lg + (size_t)b * SEQ * c.lgld + hd * 128 + 16 * w + fr;
    const bf16_t* Kp = Z + c.kcol + hd * 128 + 16 * w + fr; const bf16_t* Vp = Z + c.vcol + hd * c.V + 16 * vs + fr;
    bf16_t* SCp = c.sc + ((size_t)(b * c.H + hd) * NCHUNK) * c.V * 128 + (size_t)(16 * vs + fr) * 128 + 16 * w + 4 * g;
    f32x4 S = (f32x4){0.f, 0.f, 0.f, 0.f};
    float nlg[2][8]; unsigned short nkv[2][8], nvv[2][8];
#pragma unroll
    for (int ks = 0; ks < 2; ++ks)
#pragma unroll
        for (int j = 0; j < 8; ++j) { const size_t t = 32 * ks + 8 * g + j; nlg[ks][j] = LG[t * c.lgld]; nkv[ks][j] = Kp[t * N_CDZ]; nvv[ks][j] = Vp[t * N_CDZ]; }
#pragma unroll 1
    for (int ck = 0; ck < NCHUNK; ++ck) {
        float lg[2][8]; unsigned short kv[2][8], vv[2][8];
#pragma unroll
        for (int ks = 0; ks < 2; ++ks)
#pragma unroll
            for (int j = 0; j < 8; ++j) { lg[ks][j] = nlg[ks][j]; kv[ks][j] = nkv[ks][j]; vv[ks][j] = nvv[ks][j]; }
        if (ck + 1 < NCHUNK) { const size_t t0 = 64 * (ck + 1) + 8 * g;
            auto pl = launder(LG + t0 * c.lgld); auto pk = launder(Kp + t0 * N_CDZ); auto pv = launder(Vp + t0 * N_CDZ);
#pragma unroll
            for (int ks = 0; ks < 2; ++ks) {
#pragma unroll
                for (int j = 0; j < 8; ++j) { nlg[ks][j] = pl[(size_t)j * c.lgld]; nkv[ks][j] = pk[(size_t)j * N_CDZ]; nvv[ks][j] = pv[(size_t)j * N_CDZ]; }
                pl = launder(pl + (size_t)32 * c.lgld); pk = launder(pk + (size_t)32 * N_CDZ); pv = launder(pv + (size_t)32 * N_CDZ); } }
        { u32x2 wv; wv.x = cvt_pk_bf16(S[0], S[1]); wv.y = cvt_pk_bf16(S[2], S[3]); *(u32x2*)(SCp + (size_t)ck * c.V * 128) = wv; }
        float tot[2];
#pragma unroll
        for (int ks = 0; ks < 2; ++ks) {
#pragma unroll
            for (int j = 1; j < 8; ++j) lg[ks][j] += lg[ks][j - 1];
            float inc = lg[ks][7];
            { const float p = SHUP(inc, 16); if (g >= 1) inc += p; }
            { const float p = SHUP(inc, 32); if (g >= 2) inc += p; }
            float ex = SHUP(inc, 16); if (g == 0) ex = 0.f;
            tot[ks] = SHL(inc, 48 + fr);
#pragma unroll
            for (int j = 0; j < 8; ++j) lg[ks][j] += ex + (ks ? tot[0] : 0.f);
        }
        const float blast = tot[0] + tot[1];
        union { bf16x8 v; unsigned u[4]; } af[2], bf[2];
#pragma unroll
        for (int ks = 0; ks < 2; ++ks) { float kd[8];
#pragma unroll
            for (int j = 0; j < 8; ++j) kd[j] = bf2f(kv[ks][j]) * fast_exp(blast - lg[ks][j]);
#pragma unroll
            for (int j = 0; j < 4; ++j) { af[ks].u[j] = cvt_pk_bf16(kd[2 * j], kd[2 * j + 1]); bf[ks].u[j] = (unsigned)vv[ks][2 * j] | ((unsigned)vv[ks][2 * j + 1] << 16); } }
#pragma unroll
        for (int e = 0; e < 4; ++e) S[e] *= fast_exp(SHL(blast, 4 * g + e));
        S = __builtin_amdgcn_mfma_f32_16x16x32_bf16(af[0].v, bf[0].v, S, 0, 0, 0);
        S = __builtin_amdgcn_mfma_f32_16x16x32_bf16(af[1].v, bf[1].v, S, 0, 0, 0);
    }
    float* so = F.out + (kind == 0 ? O_HGP : O_GLP) + (((size_t)i * NB + b) * c.H + hd) * 128 * c.V + (size_t)(16 * w + 4 * g) * c.V + 16 * vs + fr;
#pragma unroll
    for (int e = 0; e < 4; ++e) so[(size_t)e * c.V] = S[e];
}

template <int V> __device__ __forceinline__ void scd_unit_t(Frame& F, int i, int kind, int b, int hd) {
    constexpr int KQ = 512 / V, KN = 128 / KQ;
    const int tid = F.tid; const float* zs = (const float*)(F.ws + WS_ZS);
    MK_LAS float* sq = (MK_LAS float*)F.lds;
    MK_LAS float* sk = sq + 1024;
    MK_LAS float* sl = sk + 1024;
    MK_LAS float* sv = sl + 1024;
    MK_LAS float* po = sv + 8 * V;
    MK_LAS float* rsd = po + KQ * 8 * V;
    const float* lb = (const float*)(F.ws + WS_LB) + i * 1024;
    for (int e = tid; e < 1024; e += 512) { const int k = e & 127, t = e >> 7; const float* zr = zs + (size_t)(b * 8 + t) * N_CD;
        if (kind == 0) { const float z = zr[ZC_KC + hd * 128 + k], l = lb[hd * 128 + k]; const float sg = sigmoid_f(z); sq[e] = zr[ZC_QC + hd * 128 + k]; sk[e] = (1.0f - l) * (1.0f - sg); sl[e] = l + (1.0f - l) * sg; }
        else { const float x = zr[N_CDZ + hd * 128 + k] + F.in[I_BG][i * 512 + hd * 128 + k]; const float ls = fminf(x, 0.f) - fast_ln(1.0f + fast_exp(-fabsf(x))); sq[e] = zr[ZC_QD + hd * 128 + k] * 0.08838834764831845f; sk[e] = zr[ZC_KD + hd * 128 + k]; sl[e] = fast_exp(ls * 0.0625f); } }
    for (int e = tid; e < 8 * V; e += 512) { const int v = e % V, t = e / V; sv[e] = zs[(size_t)(b * 8 + t) * N_CD + (kind == 0 ? ZC_IC : ZC_VD) + hd * V + v]; }
    __syncthreads();
    const int v = tid % V, kq = tid / V; const float* s0 = F.in[kind == 0 ? I_SHG : I_SGL] + ((((size_t)i * SB + b) * (kind == 0 ? HC : HD_) + hd) * 128) * V;
    float S[KN];
    { auto sp = launder(s0 + (size_t)(kq * KN) * V + v);
#pragma unroll
      for (int kk = 0; kk < KN; ++kk) { S[kk] = *sp; sp = launder(sp + V); } }
    for (int t = 0; t < 8; ++t) { const float vt = sv[t * V + v]; float acc = 0.f;
#pragma unroll
        for (int kk = 0; kk < KN; ++kk) { const int k = kq * KN + kk; S[kk] = sl[t * 128 + k] * S[kk] + sk[t * 128 + k] * vt; acc += sq[t * 128 + k] * S[kk]; }
        po[(kq * 8 + t) * V + v] = acc; }
    float* so = F.out + (kind == 0 ? O_HGS : O_GLS) + ((((size_t)i * SB + b) * (kind == 0 ? HC : HD_) + hd) * 128) * V;
    { auto sp = launder(so + (size_t)(kq * KN) * V + v);
#pragma unroll
      for (int kk = 0; kk < KN; ++kk) { *sp = S[kk]; sp = launder(sp + V); } }
    __syncthreads();
    for (int e = tid; e < 8 * V; e += 512) { float a = 0.f;
#pragma unroll
        for (int q = 0; q < KQ; ++q) a += po[q * 8 * V + e];
        po[e] = a; }
    __syncthreads();
    if (tid < 8) { float s = 0.f; for (int vv = 0; vv < V; ++vv) s += po[tid * V + vv] * po[tid * V + vv]; rsd[tid] = fast_rsq(s * (1.0f / V) + EPS); }
    __syncthreads();
    const float* gain = F.in[kind == 0 ? I_HGN : I_GLN] + i * V;
    for (int e = tid; e < 8 * V; e += 512) { const int vv = e % V, t = e / V; const float gt = zs[(size_t)(b * 8 + t) * N_CD + (kind == 0 ? ZC_GC : ZC_RD) + hd * V + vv];
        const float y = po[e] * rsd[t] * gain[vv] * silu_f(gt);
        ((bf16_t*)(F.ws + WS_MIX))[(size_t)(MP + b * 8 + t) * D + (kind == 0 ? 0 : 1024) + hd * V + vv] = (bf16_t)f2bf(y); }
    __syncthreads();
}
__device__ __forceinline__ void scd_unit(Frame& F, int i, int unit) {
    if (unit < 64) scd_unit_t<DVC>(F, i, 0, unit >> 3, unit & 7); else { const int u = unit - 64; scd_unit_t<DVD>(F, i, 1, u >> 2, u & 3); }
}

template <int V> __device__ __forceinline__ void x3_unit_t(Frame& F, const GlaCfg& c, int b, int hd, int ck) {
    constexpr int LDQ = 272, LDV = 2 * V + 32, LDA = 144;
    constexpr int NT = V / 32;
    MK_LAS unsigned char* QE = F.lds; MK_LAS unsigned char* QH = QE + 64 * LDQ; MK_LAS unsigned char* KH = QH + 64 * LDQ; MK_LAS unsigned char* VT = KH + 64 * LDQ;
    MK_LAS unsigned char* AM = VT + 64 * LDV; MK_LAS float* QT = (MK_LAS float*)(AM + 64 * LDA);
    MK_LAS float* SS = QT + 512;
    const int tid = F.tid, lane = F.lane, w = F.wave, fr = lane & 15, g = lane >> 4; const int tb = 64 * ck;
    const bf16_t* Z = (const bf16_t*)(F.ws + WS_Z) + ((size_t)b * SEQ + tb) * N_CDZ; const float* LG = c.lg + ((size_t)b * SEQ + tb) * c.lgld + hd * 128;
    { const int ch = tid & 127, tq = tid >> 7; float cum[16]; float run = 0.f;
        { auto pl = launder(LG + (size_t)(16 * tq) * c.lgld + ch);
#pragma unroll
          for (int j = 0; j < 16; ++j) { run += *pl; cum[j] = run; pl = launder(pl + c.lgld); } }
        QT[tq * 128 + ch] = run;
        unsigned short qv[16], kv[16];
        { auto pq = launder(Z + (size_t)(16 * tq) * N_CDZ + c.qcol + hd * 128 + ch); const int kdelta = c.kcol - c.qcol;
#pragma unroll
          for (int j = 0; j < 16; ++j) { qv[j] = pq[0]; kv[j] = pq[kdelta]; pq = launder(pq + N_CDZ); } }
        LDS_WAIT(); __syncthreads();
        const float q0 = QT[ch], q1 = QT[128 + ch], q2 = QT[256 + ch]; const float off = tq == 0 ? 0.f : (tq == 1 ? q0 : (tq == 2 ? q0 + q1 : q0 + q1 + q2)); const float bmid = q0 + q1;
#pragma unroll
        for (int j = 0; j < 16; ++j) { const float bb = cum[j] + off; const float qf = bf2f(qv[j]), kf = bf2f(kv[j]); const int t = 16 * tq + j;
            *(MK_LAS unsigned short*)(QE + t * LDQ + 2 * ch) = (unsigned short)f2bf(qf * fast_exp(bb));
            *(MK_LAS unsigned short*)(QH + t * LDQ + 2 * ch) = (unsigned short)f2bf(qf * fast_exp(fminf(bb - bmid, 80.f)));
            *(MK_LAS unsigned short*)(KH + t * LDQ + 2 * ch) = (unsigned short)f2bf(kf * fast_exp(fminf(bmid - bb, 80.f))); }
        constexpr int CPR = V / 8;
        for (int e = tid; e < 64 * CPR; e += 512) { const int t = e / CPR, chk = e % CPR; *(MK_LAS u32x4*)(VT + t * LDV + 16 * chk) = *(const u32x4*)(Z + (size_t)t * N_CDZ + c.vcol + hd * V + 8 * chk); }
    }
    LDS_WAIT(); __syncthreads();
    { const int ti = w >> 1;
#pragma unroll
        for (int jj = 0; jj < 2; ++jj) { const int sj = 2 * (w & 1) + jj; f32x4 a = (f32x4){0.f, 0.f, 0.f, 0.f};
            if (sj <= ti) {
#pragma unroll
                for (int ks = 0; ks < 4; ++ks) { const bf16x8 qa = *(const MK_LAS bf16x8*)(QH + (16 * ti + fr) * LDQ + 64 * ks + 16 * g), kb = *(const MK_LAS bf16x8*)(KH + (16 * sj + fr) * LDQ + 64 * ks + 16 * g);
                    a = __builtin_amdgcn_mfma_f32_16x16x32_bf16(qa, kb, a, 0, 0, 0); } }
#pragma unroll
            for (int e = 0; e < 4; ++e) { const int t = 16 * ti + 4 * g + e, s = 16 * sj + fr; *(MK_LAS unsigned short*)(AM + t * LDA + 2 * s) = (unsigned short)f2bf(s <= t ? a[e] : 0.f); } } }
    LDS_WAIT(); __syncthreads();
    const int mt = w & 3, vh = w >> 2; f32x4 o[NT];
#pragma unroll
    for (int n = 0; n < NT; ++n) o[n] = (f32x4){0.f, 0.f, 0.f, 0.f};
    const unsigned vtb = (unsigned)(size_t)VT; const int q4 = fr >> 2, p4 = fr & 3;
#pragma unroll
    for (int ks = 0; ks < 2; ++ks) { if (32 * ks <= 16 * mt + 15) { const bf16x8 aa = *(const MK_LAS bf16x8*)(AM + (16 * mt + fr) * LDA + 64 * ks + 16 * g);
#pragma unroll
            for (int n = 0; n < NT; ++n) { const int vc = (V / 2) * vh + 16 * n; const unsigned a0 = vtb + (32 * ks + 8 * g + q4) * LDV + (vc + 4 * p4) * 2, a1 = a0 + 4 * LDV;
                union { bf16x8 v; s16x4 h[2]; } vf; vf.h[0] = tr_read4(a0); vf.h[1] = tr_read4(a1);
                o[n] = __builtin_amdgcn_mfma_f32_16x16x32_bf16(aa, vf.v, o[n], 0, 0, 0); } } }
    { const bf16_t* SCp = c.sc + (((size_t)(b * c.H + hd) * NCHUNK + ck) * V) * 128;
#pragma unroll
        for (int ks = 0; ks < 4; ++ks) { const bf16x8 qa = *(const MK_LAS bf16x8*)(QE + (16 * mt + fr) * LDQ + 64 * ks + 16 * g);
#pragma unroll
            for (int n = 0; n < NT; ++n) { const int vc = (V / 2) * vh + 16 * n + fr; const bf16x8 sb = *(const bf16x8*)(SCp + (size_t)vc * 128 + 32 * ks + 8 * g);
                o[n] = __builtin_amdgcn_mfma_f32_16x16x32_bf16(qa, sb, o[n], 0, 0, 0); } } }
    float ss[4];
#pragma unroll
    for (int e = 0; e < 4; ++e) { float s = 0.f;
#pragma unroll
        for (int n = 0; n < NT; ++n) s += o[n][e] * o[n][e];
        s += SHX(s, 1); s += SHX(s, 2); s += SHX(s, 4); s += SHX(s, 8); ss[e] = s; }
    if (fr == 0) {
#pragma unroll
        for (int e = 0; e < 4; ++e) SS[vh * 64 + 16 * mt + 4 * g + e] = ss[e]; }
    LDS_WAIT(); __syncthreads();
    bf16_t* MIX = (bf16_t*)(F.ws + WS_MIX) + ((size_t)b * SEQ + tb) * D + c.mixcol + hd * V;
#pragma unroll
    for (int e = 0; e < 4; ++e) { const int t = 16 * mt + 4 * g + e; const float rs = fast_rsq((SS[t] + SS[64 + t]) * (1.0f / V) + EPS);
#pragma unroll
        for (int n = 0; n < NT; ++n) { const int vc = (V / 2) * vh + 16 * n + fr; const float gt = bf2f(Z[(size_t)t * N_CDZ + c.gcol + hd * V + vc]);
            MIX[(size_t)t * D + vc] = (bf16_t)f2bf(o[n][e] * rs * c.gain[vc] * silu_f(gt)); } }
    __syncthreads();
}
__device__ __forceinline__ void x3_unit(Frame& F, int i, int unit) {
    if (unit < NB * HC * NCHUNK) { const GlaCfg c = gla_cfg(F, i, 0); x3_unit_t<DVC>(F, c, unit / (HC * NCHUNK), (unit / NCHUNK) % HC, unit % NCHUNK); }
    else { const int u = unit - NB * HC * NCHUNK; const GlaCfg c = gla_cfg(F, i, 1); x3_unit_t<DVD>(F, c, u / (HD_ * NCHUNK), (u / NCHUNK) % HD_, u % NCHUNK); }
}
__device__ __forceinline__ void mixer_cd_x2(Frame& F, int i, int qid) {
    for (;;) { const int u = q_next(F, qid); if (u >= 256 + 96) break; if (u < 256) x2_unit(F, i, u); else scd_unit(F, i, u - 256); }
}
__device__ __forceinline__ void mixer_cd_x3(Frame& F, int i, int qid) {
    constexpr int NU = NB * HC * NCHUNK + NB * HD_ * NCHUNK;
    (void)qid; for (int u = F.vcu; u < NU; u += F.G) x3_unit(F, i, u);
}
}
namespace mk {
#define PHASE_FRAME(Fp) Frame Fp = F0; asm volatile("" : "+s"(Fp.wave)); Fp.tid = opaque_tid(Fp.wave); Fp.lane = Fp.tid & 63
__device__ __forceinline__ void ffn_part(Frame& F0, const XcdBarrier& bar, int layer, bool last) {
    { PHASE_FRAME(F); Gemm g{(const bf16_t*)(F.ws + WS_XB16), (const bf16_t*)(F.ws + WS_WUP + layer * SZ_WUP), MP, N_UP, D}; StaticOrder S; S.init(MP, N_UP, F.G, opaque_bid());
      EpiUp E{(bf16_t*)(F.ws + WS_Z), rss_ptr(F, 2 * layer + 1), F.in[I_FCW] + (size_t)layer * 3 * FF, F.in[I_FCB] + (size_t)layer * FF, (float*)(F.ws + WS_GHEAD), (float*)(F.ws + WS_GTAIL), F.out + O_FFP + (size_t)layer * NB * 2 * FF};
      gemm_phase<EpiUp>(F.lds, g, S, E, F.wave);
#if MK_PROBE == 9
      gemm_phase<EpiUp>(F.lds, g, S, E, F.wave);
#elif MK_PROBE == 19
      xcd_barrier(bar, F0.wave); gemm_phase<EpiUp>(F.lds, g, S, E, F.wave);
#endif
    }
    { PHASE_FRAME(F); const bf16_t* Bt = (const bf16_t*)(F.ws + WS_WUP + layer * SZ_WUP);
      sample_plain(F, Bt, rss_sptr(F, 2 * layer + 1), N_UP, 32 * (N_UP / 256), (float*)(F.ws + WS_GUS), N_UP, true); }
    xcd_barrier(bar, F0.wave);
    { PHASE_FRAME(F); ffn_fixup(F, layer); }
#if MK_PROBE == 10
    xcd_barrier(bar, F0.wave); { PHASE_FRAME(F); ffn_fixup(F, layer); }
#endif
    xcd_barrier(bar, F0.wave);
    { PHASE_FRAME(F); Gemm g{(const bf16_t*)(F.ws + WS_Z), (const bf16_t*)(F.ws + WS_WDN + layer * SZ_WDN), MP, D, FF}; StaticOrder S; S.init(MP, D, F.G, opaque_bid());
      EpiRes E{(bf16_t*)(F.ws + WS_XB16), last ? F.out + O_YP : nullptr, rss_ptr(F, 2 * layer + 2)};
      gemm_phase<EpiRes>(F.lds, g, S, E, F.wave);
#if MK_PROBE == 12
      { EpiRes E2{(bf16_t*)(F.ws + WS_LG), nullptr, (float*)(F.ws + WS_LG + 104 * MiB)}; gemm_phase<EpiRes>(F.lds, g, S, E2, F.wave); }
#endif
    }
    { PHASE_FRAME(F); const bf16_t* Bt = (const bf16_t*)(F.ws + WS_WDN + layer * SZ_WDN);
      sample_res(F, (const bf16_t*)(F.ws + WS_Z) + (size_t)MP * FF, Bt, FF, last ? F.out + O_YS : nullptr, rss_sptr(F, 2 * layer + 2)); }
    xcd_barrier(bar, F0.wave);
}
__device__ __forceinline__ void out_part(Frame& F0, const XcdBarrier& bar, int layer, const bf16_t* Wt) {
    PHASE_FRAME(F);
    Gemm g{(const bf16_t*)(F.ws + WS_MIX), Wt, MP, D, D}; StaticOrder S; S.init(MP, D, F.G, opaque_bid());
    EpiRes E{(bf16_t*)(F.ws + WS_XB16), nullptr, rss_ptr(F, 2 * layer + 1)};
    gemm_phase<EpiRes>(F.lds, g, S, E, F.wave);
#if MK_PROBE == 11
    { EpiRes E2{(bf16_t*)(F.ws + WS_LG), nullptr, (float*)(F.ws + WS_LG + 104 * MiB)}; gemm_phase<EpiRes>(F.lds, g, S, E2, F.wave); }
#endif
    { PHASE_FRAME(F2); sample_res(F2, (const bf16_t*)(F2.ws + WS_MIX) + (size_t)MP * D, Wt, D, nullptr, rss_sptr(F2, 2 * layer + 1)); }
    xcd_barrier(bar, F0.wave);
}

__global__ void __launch_bounds__(512, 2) mega_fwd(Args args) {
    extern __shared__ __attribute__((aligned(16))) unsigned char lds_raw[];
    Frame F0; Frame& F = F0; F.lds = (MK_LAS unsigned char*)lds_raw; F.ws = args.ws; F.out = args.out; F.in = args.in; F.ctl = (unsigned*)(args.ws + WS_CTL);
    F.wave = __builtin_amdgcn_readfirstlane((int)threadIdx.x >> 6); asm volatile("" : "+s"(F.wave));
    F.tid = opaque_tid(F.wave); F.lane = F.tid & 63;
    F.G = gridDim.x; { const int bx = opaque_bid(); F.vcu = (F.G % 8 == 0) ? (bx % 8) * (F.G / 8) + bx / 8 : bx; }
    for (int u = F.tid; u < (LDS_BYTES - MISC_OFF) / 4; u += 512) ((MK_LAS unsigned*)(F.lds + MISC_OFF))[u] = 0u;
    __syncthreads();
    const XcdBarrier bar = xcd_barrier_post(F.ctl + CW_BAR, (volatile MK_LAS unsigned*)(F.lds + MISC_OFF), F0.wave);
    p0_prologue(F);
    xcd_barrier(bar, F0.wave);
#if MK_PROBE == 7
    p0_prologue(F); xcd_barrier(bar, F0.wave);
#elif MK_PROBE == 6
    for (int r = 0; r < 32; ++r) xcd_barrier(bar, F0.wave);
#endif
    const int nl = args.nlayers;
    for (int lp = 0; lp < 2; ++lp) {
        { const int layer = 2 * lp, i = lp; if (layer >= nl) break;
          { PHASE_FRAME(F); Gemm g{(const bf16_t*)(F.ws + WS_XB16), (const bf16_t*)(F.ws + WS_WINAB + i * SZ_WINAB), MP, N_AB, D}; StaticOrder S; S.init(MP, N_AB, F.G, opaque_bid());
            EpiInAB E{(bf16_t*)(F.ws + WS_Z), rss_ptr(F, 2 * layer), F.in[I_QN] + i * DH, F.in[I_KN] + i * DH, F.out + O_KVP + (size_t)i * NB * LA * 2 * WA, F.out + O_CONVP + (size_t)i * NB * 3 * WB};
            gemm_phase<EpiInAB>(F.lds, g, S, E, F.wave);
#if MK_PROBE == 8
            gemm_phase<EpiInAB>(F.lds, g, S, E, F.wave);
#elif MK_PROBE == 18
            xcd_barrier(bar, F0.wave); gemm_phase<EpiInAB>(F.lds, g, S, E, F.wave);
#endif
          }
          { PHASE_FRAME(F); sample_in_ab(F, i, (const bf16_t*)(F.ws + WS_WINAB + i * SZ_WINAB), rss_sptr(F, 2 * layer)); }
          xcd_barrier(bar, F0.wave);
          { PHASE_FRAME(F); mixer_ab<0>(F, i, 2 * layer); }
          xcd_barrier(bar, F0.wave);
#if MK_PROBE == 21
          { PHASE_FRAME(F); mixer_ab<0>(F, i, 16 + 2 * layer); } xcd_barrier(bar, F0.wave);
#elif MK_PROBE == 22
          { PHASE_FRAME(F); mixer_ab<1>(F, i, 16 + 2 * layer); } xcd_barrier(bar, F0.wave);
#elif MK_PROBE == 23
          { PHASE_FRAME(F); mixer_ab<2>(F, i, 16 + 2 * layer); } xcd_barrier(bar, F0.wave);
#endif
          { PHASE_FRAME(F); mixer_ab_fix(F, i, 2 * layer + 1); }
          xcd_barrier(bar, F0.wave);
#if MK_PROBE == 1
          { PHASE_FRAME(F); mixer_ab<0>(F, i, 16 + 2 * layer); } xcd_barrier(bar, F0.wave);
#elif MK_PROBE == 2
          { PHASE_FRAME(F); mixer_ab<1>(F, i, 16 + 2 * layer); } xcd_barrier(bar, F0.wave);
#elif MK_PROBE == 3
          { PHASE_FRAME(F); mixer_ab<2>(F, i, 16 + 2 * layer); } xcd_barrier(bar, F0.wave);
#endif
          if (args.pad && layer == nl - 1) return;
          out_part(F0, bar, layer, (const bf16_t*)(F.ws + WS_WOUTAB + i * SZ_WOUT));
          ffn_part(F0, bar, layer, layer == nl - 1); }
        { const int layer = 2 * lp + 1, i = lp; if (layer >= nl) break;
          { PHASE_FRAME(F); Gemm g{(const bf16_t*)(F.ws + WS_XB16), (const bf16_t*)(F.ws + WS_WINCD + i * SZ_WINCD), MP, N_CD, D}; StaticOrder S; S.init(MP, N_CD, F.G, opaque_bid());
            EpiInCD E{(bf16_t*)(F.ws + WS_Z), rss_ptr(F, 2 * layer), (const float*)(F.ws + WS_LB) + i * 1024, F.in[I_BG] + i * 512, (float*)(F.ws + WS_LG), (float*)(F.ws + WS_LG) + (size_t)MP * 1024};
            gemm_phase<EpiInCD>(F.lds, g, S, E, F.wave);
#if MK_PROBE == 8
            gemm_phase<EpiInCD>(F.lds, g, S, E, F.wave);
#elif MK_PROBE == 18
            xcd_barrier(bar, F0.wave); gemm_phase<EpiInCD>(F.lds, g, S, E, F.wave);
#endif
          }
          { PHASE_FRAME(F); sample_plain(F, (const bf16_t*)(F.ws + WS_WINCD + i * SZ_WINCD), rss_sptr(F, 2 * layer), N_CD, 32 * (N_CD / 256), (float*)(F.ws + WS_ZS), N_CD, false); }
          xcd_barrier(bar, F0.wave);
          { PHASE_FRAME(F); mixer_cd_x2(F, i, 2 * layer); }
          xcd_barrier(bar, F0.wave);
#if MK_PROBE == 4
          { PHASE_FRAME(F); mixer_cd_x2(F, i, 16 + 2 * layer); } xcd_barrier(bar, F0.wave);
#endif
          { PHASE_FRAME(F); mixer_cd_x3(F, i, 2 * layer + 1); }
          xcd_barrier(bar, F0.wave);
#if MK_PROBE == 5
          { PHASE_FRAME(F); mixer_cd_x3(F, i, 16 + 2 * layer + 1); } xcd_barrier(bar, F0.wave);
#endif
          if (args.pad && layer == nl - 1) return;
          out_part(F0, bar, layer, (const bf16_t*)(F.ws + WS_WOUTCD + i * SZ_WOUT));
          ffn_part(F0, bar, layer, layer == nl - 1); }
    }
}

static int g_grid = 0;
inline void launch_mega(void* const* d_in, float* out, unsigned char* ws, int nlayers, hipStream_t stream, int stop_after_mixer = 0) {
    if (g_grid == 0) {
        int dev = 0, cus = 0;
        if (hipGetDevice(&dev) != hipSuccess || hipDeviceGetAttribute(&cus, hipDeviceAttributeMultiprocessorCount, dev) != hipSuccess) { g_grid = -1; return; }
        if (hipFuncSetAttribute((const void*)mega_fwd, hipFuncAttributeMaxDynamicSharedMemorySize, LDS_BYTES) != hipSuccess) { g_grid = -1; return; }
        int per_cu = 0; (void)hipOccupancyMaxActiveBlocksPerMultiprocessor(&per_cu, (const void*)mega_fwd, 512, LDS_BYTES); (void)hipGetLastError();
        g_grid = (per_cu >= 1) ? cus : -1;
    }
    if (g_grid < 0) return;
    (void)hipMemsetAsync(ws + WS_CTL, 0, CTL_BYTES, stream);
    Args a{}; for (int k = 0; k < 32; ++k) a.in[k] = (const float*)d_in[k];
    a.out = out; a.ws = ws; a.nlayers = nlayers; a.pad = stop_after_mixer;
    hipLaunchKernelGGL(mega_fwd, dim3(g_grid), dim3(512), LDS_BYTES, stream, a);
}
}
extern "C" void kernel_launch(void* const* d_in, const int* in_sizes, int n_in, void* d_out, int out_size, void* d_ws, size_t ws_size, hipStream_t stream) {
    if (n_in != 32 || ws_size < mk::WS_END || (size_t)out_size != mk::O_END) return;
    mk::launch_mega(d_in, (float*)d_out, (unsigned char*)d_ws, 4, stream);
}
```

```cpp
#include <hip/hip_runtime.h>
namespace mk {
#define MK_LAS __attribute__((address_space(3)))
#define MK_GAS __attribute__((address_space(1)))
typedef unsigned short bf16_t;
typedef short bf16x8 __attribute__((ext_vector_type(8)));
typedef short s16x4 __attribute__((ext_vector_type(4)));
typedef float f32x4 __attribute__((ext_vector_type(4)));
typedef float f32x2 __attribute__((ext_vector_type(2)));
typedef unsigned u32x4 __attribute__((ext_vector_type(4)));
typedef unsigned u32x2 __attribute__((ext_vector_type(2)));

constexpr int D = 2048, NB = 2, SEQ = 4096, MP = NB * SEQ, SB = 8, ST = 8, MS = SB * ST, MT = MP + MS;
constexpr int HA = 8, DH = 128, WA = 1024, WB = 1024, HB_ = 8, LA = 2048;
constexpr int N_AB = 5120, N_CD = 7680, N_CD_SRC = 7184, N_CDZ = 7168, FF = 5504, N_UP = 2 * FF;
constexpr int HC = 8, HD_ = 4, DK = 128, DVC = 128, DVD = 256;
constexpr float EPS = 1e-6f;
constexpr int NCHUNK = SEQ / 64;
constexpr int ZC_QC = 0, ZC_KC = 1024, ZC_IC = 2048, ZC_GC = 3072, ZC_QD = 4096, ZC_KD = 4608, ZC_VD = 5120, ZC_RD = 6144;

constexpr size_t MiB = 1u << 20;
constexpr size_t WS_CTL = 0, CTL_BYTES = 1 * MiB;
constexpr size_t WS_WINAB = 1 * MiB, SZ_WINAB = (size_t)N_AB * D * 2;
constexpr size_t WS_WOUTAB = WS_WINAB + 2 * SZ_WINAB, SZ_WOUT = (size_t)D * D * 2;
constexpr size_t WS_WINCD = WS_WOUTAB + 2 * SZ_WOUT, SZ_WINCD = (size_t)N_CD * D * 2;
constexpr size_t WS_WOUTCD = WS_WINCD + 2 * SZ_WINCD;
constexpr size_t WS_WUP = WS_WOUTCD + 2 * SZ_WOUT, SZ_WUP = (size_t)N_UP * D * 2;
constexpr size_t WS_WDN = WS_WUP + 4 * SZ_WUP, SZ_WDN = (size_t)D * FF * 2;
constexpr size_t WS_WLRU = WS_WDN + 4 * SZ_WDN, SZ_WLRU = (size_t)2 * 8 * 2 * 128 * 128 * 2;
constexpr size_t WS_LB = WS_WLRU + SZ_WLRU;
constexpr size_t WS_XB16 = WS_LB + 64 * 1024;
constexpr size_t WS_Z = WS_XB16 + 33 * MiB;
constexpr size_t WS_LG = WS_Z + 112 * MiB;
constexpr size_t WS_SC = WS_LG + 48 * MiB;
constexpr size_t WS_MIX = WS_SC + 64 * MiB;
constexpr size_t WS_ZS = WS_MIX + 33 * MiB;
constexpr size_t WS_GUS = WS_ZS + 2 * MiB;
constexpr size_t WS_GHEAD = WS_GUS + 3 * MiB;
constexpr size_t WS_GTAIL = WS_GHEAD + 3 * MiB;
constexpr size_t WS_RSS = WS_GTAIL + 2 * MiB;
constexpr size_t RSS_P_FLOATS = (size_t)9 * MP * 8, RSS_S_FLOATS = (size_t)9 * MS * 128;
constexpr size_t WS_END = WS_RSS + 3 * MiB;
static_assert((RSS_P_FLOATS + RSS_S_FLOATS) * 4 <= 3 * MiB && (size_t)MT * FF * 2 <= 112 * MiB && (size_t)MP * N_CDZ * 2 <= 112 * MiB && (size_t)MT * D * 2 <= 33 * MiB, "ws map");
constexpr int CW_TMO = 0, CW_CODE = 1, CW_BAR = 4096, CW_Q = 8192;
constexpr int RING_BYTES = 131072, EPI_OFF = RING_BYTES, EPI_BYTES = 12288, MISC_OFF = EPI_OFF + EPI_BYTES, LDS_BYTES = 147456;
static_assert(MISC_OFF + 256 <= LDS_BYTES, "lds");

__device__ __forceinline__ unsigned f2bf(float f) { unsigned u = __builtin_bit_cast(unsigned, f); return (u + 0x7fffu + ((u >> 16) & 1u)) >> 16; }
__device__ __forceinline__ unsigned pk2(float lo, float hi) { return f2bf(lo) | (f2bf(hi) << 16); }
__device__ __forceinline__ float bf2f(unsigned short b) { return __builtin_bit_cast(float, ((unsigned)b) << 16); }
__device__ __forceinline__ float bflo(unsigned w) { return __builtin_bit_cast(float, w << 16); }
__device__ __forceinline__ float bfhi(unsigned w) { return __builtin_bit_cast(float, w & 0xffff0000u); }
__device__ __forceinline__ unsigned cvt_pk_bf16(float lo, float hi) { unsigned r; asm volatile("v_cvt_pk_bf16_f32 %0, %1, %2" : "=v"(r) : "v"(lo), "v"(hi)); return r; }
__device__ __forceinline__ float fast_exp2(float x) { return __builtin_amdgcn_exp2f(x); }
__device__ __forceinline__ float fast_exp(float x) { return __builtin_amdgcn_exp2f(x * 1.44269504089f); }
__device__ __forceinline__ float fast_rcp(float x) { return __builtin_amdgcn_rcpf(x); }
__device__ __forceinline__ float sigmoid_f(float x) { return fast_rcp(1.0f + fast_exp(-x)); }
__device__ __forceinline__ float silu_f(float x) { return x * sigmoid_f(x); }
__device__ __forceinline__ float gelu_tanh_f(float x) { const float u = 0.7978845608028654f * (x + 0.044715f * x * x * x); return x * sigmoid_f(2.0f * u); }
template <class T> __device__ __forceinline__ MK_GAS T* launder(T* p) { MK_GAS T* q = (MK_GAS T*)p; asm volatile("" : "+v"(q)); return q; }
template <class T> __device__ __forceinline__ MK_GAS T* launder(MK_GAS T* q) { asm volatile("" : "+v"(q)); return q; }
__device__ __forceinline__ int opaque_bid() { int b = (int)blockIdx.x; asm volatile("" : "+s"(b)); return b; }
__device__ __forceinline__ int lane_id() { int l; asm volatile("v_mbcnt_lo_u32_b32 %0, -1, 0\n\tv_mbcnt_hi_u32_b32 %0, -1, %0" : "=v"(l)); return l; }
__device__ __forceinline__ int opaque_tid(int wave) { int l; asm volatile("v_mbcnt_lo_u32_b32 %0, -1, 0\n\tv_mbcnt_hi_u32_b32 %0, -1, %0" : "=v"(l)); return wave * 64 + l; }
__device__ __forceinline__ float fast_rsq(float x) { return __builtin_amdgcn_rsqf(x); }
__device__ __forceinline__ float fast_sqrt(float x) { return __builtin_amdgcn_sqrtf(x); }
__device__ __forceinline__ float fast_ln(float x) { return 0.69314718056f * __builtin_amdgcn_logf(x); }
__device__ __forceinline__ float softplus_acc(float x) { if (x > 20.f) return x; const float e = fast_exp(x); const float ser = e * (1.0f + e * (-0.5f + e * (0.33333333f + e * (-0.25f + e * 0.2f)))); return e < 0.06f ? ser : fast_ln(1.0f + e); }
__device__ __forceinline__ float one_minus_exp(float x) { const float ser = -x * (1.0f + x * (0.5f + x * (0.16666667f + x * (0.041666668f + x * 0.0083333338f)))); return x > -0.3f ? ser : 1.0f - fast_exp(x); }
__device__ __forceinline__ float rss_p(const float* part, int row) { const f32x4 a = *(const f32x4*)(part + (size_t)row * 8), b = *(const f32x4*)(part + (size_t)row * 8 + 4); return ((a[0] + a[1]) + (a[2] + a[3])) + ((b[0] + b[1]) + (b[2] + b[3])); }
__device__ __forceinline__ float rss_s(const float* part, int row) { float s = 0.f; const f32x4* p = (const f32x4*)(part + (size_t)row * 128);
#pragma unroll 8
    for (int j = 0; j < 32; ++j) { const f32x4 a = p[j]; s += (a[0] + a[1]) + (a[2] + a[3]); } return s; }
__device__ __forceinline__ float bperm(int srclane, float v) { return __builtin_bit_cast(float, __builtin_amdgcn_ds_bpermute(srclane << 2, __builtin_bit_cast(int, v))); }
#define SHX(v, mask) bperm(lane ^ (mask), (v))
#define SHUP(v, d) bperm(lane >= (d) ? lane - (d) : lane, (v))
#define SHL(v, src) bperm((src), (v))
#define LDS_WAIT() asm volatile("s_waitcnt lgkmcnt(0)" ::: "memory")
#define VM_WAIT() asm volatile("s_waitcnt vmcnt(0)" ::: "memory")

#define XB_TMO      128
#define XB_XCNT(j)  (256  + 64 * (j))
#define XB_XSUB(j)  (1280 + 64 * (j))
#define XB_XGEN(j)  (2304 + 64 * (j))
#define XB_TOP      3328
#define XB_TOPGEN   3392
#define XCD_BAR_WORDS 3456
#define XB_SPIN_CAP (1u << 22)
__device__ __forceinline__ unsigned xb_ld(unsigned* p)              { return __hip_atomic_load(p, __ATOMIC_RELAXED, __HIP_MEMORY_SCOPE_AGENT); }
__device__ __forceinline__ unsigned xb_add(unsigned* p, unsigned v) { return __hip_atomic_fetch_add(p, v, __ATOMIC_RELAXED, __HIP_MEMORY_SCOPE_AGENT); }
__device__ __forceinline__ unsigned xb_xcc_id() { return (unsigned)__builtin_amdgcn_s_getreg((3 << 11) | 20) & 0xFu; }
#define XB_SPIN(cond, bar) do { unsigned _sp = 0; while (cond) { __builtin_amdgcn_s_sleep(1); \
    if ((++_sp & 255u) == 0u) { if (xb_ld(&(bar)[XB_TMO])) break; if (_sp > XB_SPIN_CAP) { atomicAdd(&(bar)[XB_TMO], 1u); break; } } } } while (0)
struct XcdBarrier { unsigned* bar; unsigned x; volatile MK_LAS unsigned* st; };
__device__ __forceinline__ XcdBarrier xcd_barrier_post(unsigned* bar, volatile MK_LAS unsigned* st, int wave) {
    XcdBarrier b; b.bar = bar; b.x = xb_xcc_id(); b.st = st;
    if (wave == 0 && lane_id() == 0) (void)xb_add(&bar[XB_XCNT(b.x)], 1u);
    return b;
}
__device__ __forceinline__ void xcd_barrier_complete(unsigned* bar, unsigned x, unsigned& nloc, unsigned& nx) {
    const unsigned G = gridDim.x * gridDim.y * gridDim.z;
    unsigned sum, cnt, mine, sp = 0u;
    for (;;) {
        sum = 0u; cnt = 0u; mine = 0u;
#pragma unroll
        for (unsigned j = 0; j < 16; ++j) { const unsigned c = xb_ld(&bar[XB_XCNT(j)]); sum += c; cnt += (c > 0u) ? 1u : 0u; mine = (j == x) ? c : mine; }
        if (sum == G) break;
        __builtin_amdgcn_s_sleep(1);
        if ((++sp & 255u) == 0u) { if (xb_ld(&bar[XB_TMO])) break; if (sp > XB_SPIN_CAP) { atomicAdd(&bar[XB_TMO], 1u); break; } }
    }
    nloc = mine > 0u ? mine : 1u; nx = cnt > 0u ? cnt : 1u;
}
__device__ __forceinline__ void xcd_barrier(const XcdBarrier& b, int wave) {
    asm volatile("s_waitcnt vmcnt(0)" ::: "memory");
    __syncthreads();
    if (wave == 0 && lane_id() == 0) {
        unsigned* bar = b.bar; unsigned bx = xb_xcc_id(); asm volatile("" : "+s"(bx));
        __builtin_amdgcn_s_waitcnt(0);
        unsigned nloc = b.st[0], nx = b.st[1];
        if (nloc == 0u) { xcd_barrier_complete(bar, bx, nloc, nx); b.st[0] = nloc; b.st[1] = nx; }
        const unsigned old = xb_add(&bar[XB_XSUB(bx)], 1u);
        const unsigned gen = old / nloc;
        if (old + 1u == (gen + 1u) * nloc) {
            __builtin_amdgcn_fence(__ATOMIC_RELEASE, "agent");
            asm volatile("s_waitcnt vmcnt(0)" ::: "memory");
            const unsigned og = xb_add(&bar[XB_TOP], 1u);
            const unsigned tg = og / nx;
            if (og + 1u == (tg + 1u) * nx) xb_add(&bar[XB_TOPGEN], 1u);
            else XB_SPIN(xb_ld(&bar[XB_TOPGEN]) == tg, bar);
            __builtin_amdgcn_fence(__ATOMIC_ACQUIRE, "agent");
            xb_add(&bar[XB_XGEN(bx)], 1u);
            asm volatile("s_waitcnt vmcnt(0)" ::: "memory");
        } else {
            XB_SPIN(xb_ld(&bar[XB_XGEN(bx)]) == gen, bar);
            __builtin_amdgcn_fence(__ATOMIC_ACQUIRE, "agent");
            asm volatile("s_waitcnt vmcnt(0)" ::: "memory");
        }
    }
    __syncthreads();
}

constexpr int BM = 256, BK = 64, HALF = 128, HTB = HALF * BK * 2, STAGE_BYTES = 8 * HTB, NXCD = 8, WGM = 8;
__host__ __device__ __forceinline__ int lds_byte(int r, int c) { const int st = (r >> 4) * 2 + (c >> 5), rr = r & 15, cc = c & 31, ob = rr * 64 + cc * 2; return st * 1024 + (ob ^ (((ob >> 9) & 1) << 5)); }
__host__ __device__ __forceinline__ void stage_rc(int b, int& R, int& C) { const int st = b / 1024, sb = b % 1024, swz = sb ^ (((sb >> 9) & 1) << 5); R = (st >> 1) * 16 + swz / 64; C = (st & 1) * 32 + (swz % 64) / 2; }
__host__ __device__ __forceinline__ int perm32(int rho) { const int n = rho >> 4, i = rho & 15; return 8 * (i >> 2) + 4 * n + (i & 3); }
struct Unit { int pm, pn; };
struct Gemm { const bf16_t* A; const bf16_t* Bt; int M, N, K; };
struct StaticOrder {
    int nM, nN, nwg, G, c;
    __device__ __forceinline__ void init(int M, int N, int G_, int c_) { nM = M / BM; nN = N / BM; nwg = nM * nN; G = G_; c = c_; }
    __device__ __forceinline__ bool next(int i, Unit& u) const {
        const long L = (long)i * G + c; if (L >= nwg) return false;
        int wgid = (int)L; { const int q = nwg / NXCD, r = nwg % NXCD, xcd = wgid % NXCD, off = wgid / NXCD; wgid = (xcd < r ? xcd * (q + 1) : r * (q + 1) + (xcd - r) * q) + off; }
        const int nig = WGM * nN, gid = wgid / nig, fm = gid * WGM, gsz = (nM - fm) < WGM ? (nM - fm) : WGM;
        u.pm = fm + ((wgid % nig) % gsz); u.pn = (wgid % nig) / gsz; return true;
    }
};
template <class Epi>
__device__ __forceinline__ void gemm_phase(MK_LAS unsigned char* lds, const Gemm g, const StaticOrder& S, const Epi& E, int wave_id) {
    const int tid = opaque_tid(wave_id), wid = wave_id, lane = tid & 63, wr = wid >> 2, wc = wid & 3, fr = lane & 15, fq = lane >> 4;
    const int K = g.K, nt = K / BK;
    unsigned voffA[2], voffB[2];
#pragma unroll
    for (int i = 0; i < 2; ++i) { int R, C; stage_rc(tid * 16 + i * 8192, R, C); const int Rb = Epi::PERM ? ((R & ~31) + perm32(R & 31)) : R;
        voffA[i] = (unsigned)(R * K + C) * 2u; voffB[i] = (unsigned)(Rb * K + C) * 2u; }
    const size_t kstep = (size_t)(BK * 2);
    const size_t hstep = (size_t)HALF * K * 2;
    const size_t tstep = 2 * hstep;
    const unsigned ldsw = (unsigned)wid * 1024u;
    const int aoff = lds_byte(wr * 64 + fr, fq * 8), boff = lds_byte(wc * 32 + fr, fq * 8);
#define PG8_SA(b, h) (((b) * 2 + (h)) * HTB)
#define PG8_SB(b, h) ((4 + (b) * 2 + (h)) * HTB)
#define PG8_STAGE(bufoff, gbase, voff) do { _Pragma("unroll") for (int _i = 0; _i < 2; ++_i) \
        __builtin_amdgcn_global_load_lds((const unsigned*)((const char*)(gbase) + (voff)[_i]), (MK_LAS unsigned*)(lds + (bufoff) + ldsw + _i * 8192), 16, 0, 0); } while (0)
#define PG8_LDA(dst, b, h) do { _Pragma("unroll") for (int m = 0; m < 4; ++m) _Pragma("unroll") for (int k = 0; k < 2; ++k) dst[m][k] = *(const MK_LAS bf16x8*)(lds + PG8_SA(b, h) + aoff + m * 2048 + k * 1024); } while (0)
#define PG8_LDB(dst, b, h) do { _Pragma("unroll") for (int n = 0; n < 2; ++n) _Pragma("unroll") for (int k = 0; k < 2; ++k) dst[n][k] = *(const MK_LAS bf16x8*)(lds + PG8_SB(b, h) + boff + n * 2048 + k * 1024); } while (0)
#define PG8_MMA(ai, bj, At, Bt) do { __builtin_amdgcn_s_setprio(1); _Pragma("unroll") for (int m = 0; m < 4; ++m) _Pragma("unroll") for (int n = 0; n < 2; ++n) _Pragma("unroll") for (int k = 0; k < 2; ++k) \
        acc[ai][bj][m][n] = __builtin_amdgcn_mfma_f32_16x16x32_bf16(Bt[n][k], At[m][k], acc[ai][bj][m][n], 0, 0, 0); __builtin_amdgcn_s_setprio(0); } while (0)
#define PG8_WAIT_V(n) asm volatile("s_waitcnt vmcnt(" #n ")" ::: "memory")
#define PG8_WAIT_L(n) asm volatile("s_waitcnt lgkmcnt(" #n ")" ::: "memory")
#define PG8_BAR __builtin_amdgcn_s_barrier()
#define PG8_SCHED __builtin_amdgcn_sched_barrier(0)
    Unit cur, nxt; int ui = 0;
    if (!S.next(0, cur)) return;
    f32x4 acc[2][2][4][2];
#pragma unroll
    for (int a = 0; a < 2; ++a)
#pragma unroll
        for (int b = 0; b < 2; ++b)
#pragma unroll
            for (int m = 0; m < 4; ++m)
#pragma unroll
                for (int n = 0; n < 2; ++n) acc[a][b][m][n] = (f32x4){0.f, 0.f, 0.f, 0.f};
    bf16x8 At[4][2], B0[2][2], B1[2][2];
    const char* cA = (const char*)g.A + (size_t)cur.pm * tstep; const char* cB = (const char*)g.Bt + (size_t)cur.pn * tstep;
    PG8_STAGE(PG8_SB(0, 0), cB, voffB); PG8_STAGE(PG8_SB(0, 1), cB + hstep, voffB); PG8_STAGE(PG8_SA(0, 0), cA, voffA); PG8_STAGE(PG8_SA(0, 1), cA + hstep, voffA);
    if (wr == 1) PG8_BAR;
    PG8_WAIT_V(2); PG8_BAR;
    PG8_STAGE(PG8_SB(1, 0), cB + kstep, voffB); PG8_STAGE(PG8_SA(1, 0), cA + kstep, voffA); PG8_STAGE(PG8_SB(1, 1), cB + hstep + kstep, voffB);
    PG8_WAIT_V(6); PG8_BAR;
    for (;;) {
        const bool has_next = S.next(ui + 1, nxt);
        const char* nA = has_next ? (const char*)g.A + (size_t)nxt.pm * tstep : cA; const char* nB = has_next ? (const char*)g.Bt + (size_t)nxt.pn * tstep : cB;
        for (int t = 0; t < nt; t += 2) {
            const bool last = (t == nt - 2);
            const char* a1 = cA + (size_t)(t + 1) * kstep;
            const char* a2 = last ? nA : cA + (size_t)(t + 2) * kstep; const char* b2 = last ? nB : cB + (size_t)(t + 2) * kstep;
            const char* a3 = a2 + kstep; const char* b3 = b2 + kstep;
            PG8_LDB(B0, 0, 0); PG8_LDB(B1, 0, 1); PG8_SCHED; PG8_LDA(At, 0, 0); PG8_STAGE(PG8_SA(1, 1), a1 + hstep, voffA);
            PG8_WAIT_V(8); PG8_WAIT_L(0); PG8_BAR; PG8_MMA(0, 0, At, B0); PG8_MMA(0, 1, At, B1); PG8_BAR; PG8_SCHED;
            PG8_LDA(At, 0, 1); PG8_STAGE(PG8_SB(0, 0), b2, voffB); PG8_STAGE(PG8_SB(0, 1), b2 + hstep, voffB); PG8_STAGE(PG8_SA(0, 0), a2, voffA);
            PG8_WAIT_V(8); PG8_WAIT_L(0); PG8_BAR; PG8_MMA(1, 0, At, B0); PG8_MMA(1, 1, At, B1); PG8_BAR; PG8_SCHED;
            PG8_LDB(B0, 1, 0); PG8_LDB(B1, 1, 1); PG8_SCHED; PG8_LDA(At, 1, 0); PG8_STAGE(PG8_SA(0, 1), a2 + hstep, voffA);
            PG8_WAIT_V(8); PG8_WAIT_L(0); PG8_BAR; PG8_MMA(0, 0, At, B0); PG8_MMA(0, 1, At, B1); PG8_BAR; PG8_SCHED;
            PG8_LDA(At, 1, 1); PG8_STAGE(PG8_SB(1, 0), b3, voffB); PG8_STAGE(PG8_SB(1, 1), b3 + hstep, voffB); PG8_STAGE(PG8_SA(1, 0), a3, voffA);
            PG8_WAIT_V(8); PG8_WAIT_L(0); PG8_BAR; PG8_MMA(1, 0, At, B0); PG8_MMA(1, 1, At, B1); PG8_BAR; PG8_SCHED;
        }
        if (wr == 0) PG8_BAR;
        E(acc, cur, wr, wc, fr, fq, lds + EPI_OFF);
        if (!has_next) break;
#pragma unroll
        for (int a = 0; a < 2; ++a)
#pragma unroll
            for (int b = 0; b < 2; ++b)
#pragma unroll
                for (int m = 0; m < 4; ++m)
#pragma unroll
                    for (int n = 0; n < 2; ++n) acc[a][b][m][n] = (f32x4){0.f, 0.f, 0.f, 0.f};
        cur = nxt; cA = nA; cB = nB; ++ui;
        if (wr == 1) PG8_BAR;
    }
    PG8_WAIT_V(0);
    PG8_BAR;
#undef PG8_SA
#undef PG8_SB
#undef PG8_STAGE
#undef PG8_LDA
#undef PG8_LDB
#undef PG8_MMA
#undef PG8_WAIT_V
#undef PG8_WAIT_L
#undef PG8_SCHED
}
}
namespace mk {
typedef f32x4 Acc[2][2][4][2];

struct EpiRes {
    static constexpr bool PERM = false;
    bf16_t* xb16; float* yout; float* rssp;
    __device__ __forceinline__ void operator()(Acc& acc, const Unit& u, int wr, int wc, int fr, int fq, MK_LAS unsigned char* lds) const {
        asm volatile("" : "+v"(fr), "+v"(fq)); const int lane = fq * 16 + fr;
        const int row0 = u.pm * BM + wr * 64 + fr, col0 = u.pn * BM + wc * 32 + 4 * fq;
        MK_LAS float* P = (MK_LAS float*)lds;
#pragma unroll
        for (int ai = 0; ai < 2; ++ai)
#pragma unroll
            for (int m = 0; m < 4; ++m) { const int row = row0 + ai * HALF + m * 16; const unsigned off = (unsigned)row * D + col0; float ss = 0.f;
#pragma unroll
                for (int bj = 0; bj < 2; ++bj)
#pragma unroll
                    for (int n = 0; n < 2; ++n) { const unsigned o = off + bj * HALF + n * 16; const u32x2 xo = *(const u32x2*)(xb16 + o);
                        const f32x4 v = acc[ai][bj][m][n] + (f32x4){bflo(xo.x), bfhi(xo.x), bflo(xo.y), bfhi(xo.y)};
                        u32x2 w; w.x = cvt_pk_bf16(v[0], v[1]); w.y = cvt_pk_bf16(v[2], v[3]); *(u32x2*)(xb16 + o) = w;
                        if (yout) *(f32x4*)(yout + o) = v;
                        ss += (v[0] * v[0] + v[1] * v[1]) + (v[2] * v[2] + v[3] * v[3]); }
                ss += SHX(ss, 16); ss += SHX(ss, 32);
                if (fq == 0) P[(ai * HALF + wr * 64 + m * 16 + fr) * 4 + wc] = ss;
                asm volatile("" ::: "memory"); }
        LDS_WAIT(); __builtin_amdgcn_s_barrier(); asm volatile("" ::: "memory");
        if (fq == 0) {
#pragma unroll
            for (int ai = 0; ai < 2; ++ai)
#pragma unroll
                for (int m = 0; m < 4; ++m) if (((ai * 4 + m) >> 1) == wc) { const int rl = ai * HALF + wr * 64 + m * 16 + fr; const f32x4 p = *(const MK_LAS f32x4*)(P + rl * 4);
                    rssp[(unsigned)(u.pm * BM + rl) * 8 + u.pn] = (p[0] + p[1]) + (p[2] + p[3]); } }
    }
};

struct EpiInAB {
    static constexpr bool PERM = true;
    bf16_t* Z; const float* rss; const float* qn; const float* kn; float* kv_out; float* conv_out;
    __device__ __forceinline__ void operator()(Acc& acc, const Unit& u, int wr, int wc, int fr, int fq, MK_LAS unsigned char* lds) const {
        asm volatile("" : "+v"(fr), "+v"(fq)); const int lane = fq * 16 + fr;
        const int kind = u.pn >> 2; const int row0 = u.pm * BM + wr * 64 + fr; const int cw = (u.pn & 3) * 256 + wc * 32 + 8 * fq;
        MK_LAS float* P = (MK_LAS float*)lds;
#pragma unroll
        for (int ai = 0; ai < 2; ++ai)
#pragma unroll
            for (int m = 0; m < 4; ++m) { const float rs = fast_rsq(rss_p(rss, row0 + ai * HALF + m * 16) * (1.0f / D) + EPS);
#pragma unroll
                for (int bj = 0; bj < 2; ++bj) { acc[ai][bj][m][0] = acc[ai][bj][m][0] * rs; acc[ai][bj][m][1] = acc[ai][bj][m][1] * rs;
                    if (kind <= 1) { const f32x4 v = acc[ai][bj][m][0], x = acc[ai][bj][m][1]; float s = ((v[0] * v[0] + v[1] * v[1]) + (v[2] * v[2] + v[3] * v[3])) + ((x[0] * x[0] + x[1] * x[1]) + (x[2] * x[2] + x[3] * x[3]));
                        s += SHX(s, 16); s += SHX(s, 32);
                        if (fq == 0) P[((ai * HALF + wr * 64 + m * 16 + fr) * 2 + bj) * 4 + wc] = s; } }
                asm volatile("" ::: "memory"); }
        f32x4 g0 = (f32x4){1.f, 1.f, 1.f, 1.f}, g1 = g0;
        if (kind <= 1) { LDS_WAIT(); __builtin_amdgcn_s_barrier(); asm volatile("" ::: "memory");
            const float* gp = (kind == 0 ? qn : kn) + wc * 32 + 8 * fq; g0 = *(const f32x4*)gp; g1 = *(const f32x4*)(gp + 4); }
#pragma unroll
        for (int ai = 0; ai < 2; ++ai)
#pragma unroll
            for (int m = 0; m < 4; ++m) { const int row = row0 + ai * HALF + m * 16; const int t = row & (SEQ - 1), b = row >> 12;
#pragma unroll
                for (int bj = 0; bj < 2; ++bj) { f32x4 v0 = acc[ai][bj][m][0], v1 = acc[ai][bj][m][1];
                    if (kind <= 1) { const f32x4 p = *(const MK_LAS f32x4*)(P + ((ai * HALF + wr * 64 + m * 16 + fr) * 2 + bj) * 4);
                        const float hs = fast_rsq(((p[0] + p[1]) + (p[2] + p[3])) * (1.0f / DH) + EPS); v0 = v0 * hs * g0; v1 = v1 * hs * g1; }
                    u32x4 w; w.x = cvt_pk_bf16(v0[0], v0[1]); w.y = cvt_pk_bf16(v0[2], v0[3]); w.z = cvt_pk_bf16(v1[0], v1[1]); w.w = cvt_pk_bf16(v1[2], v1[3]);
                    *(u32x4*)(Z + (unsigned)row * N_AB + kind * 1024 + cw + bj * HALF) = w;
                    if ((kind == 1 || kind == 2) && t >= SEQ - LA) { float* o = kv_out + (((unsigned)b * LA + (t - (SEQ - LA))) * 2 + (kind - 1)) * WA + cw + bj * HALF; *(f32x4*)o = v0; *(f32x4*)(o + 4) = v1; }
                    if (kind == 3 && t >= SEQ - 3) { float* o = conv_out + ((unsigned)b * 3 + (t - (SEQ - 3))) * WB + cw + bj * HALF; *(f32x4*)o = v0; *(f32x4*)(o + 4) = v1; } }
                asm volatile("" ::: "memory"); }
    }
};

struct EpiInCD {
    static constexpr bool PERM = true;
    bf16_t* Z; const float* rss; const float* lb; const float* bg; float* lgc; float* lgd;
    __device__ __forceinline__ void operator()(Acc& acc, const Unit& u, int wr, int wc, int fr, int fq, MK_LAS unsigned char*) const {
        asm volatile("" : "+v"(fr), "+v"(fq));
        const int pn = u.pn; const int row0 = u.pm * BM + wr * 64 + fr; const int c8 = wc * 32 + 8 * fq;
        const int mode = (pn >= 4 && pn < 8) ? 1 : (pn >= 28 ? 2 : 0);
        const float sc = (pn == 16 || pn == 17) ? 0.08838834764831845f : 1.0f;
#pragma unroll
        for (int ai = 0; ai < 2; ++ai)
#pragma unroll
            for (int m = 0; m < 4; ++m) { const int row = row0 + ai * HALF + m * 16; const float rs = sc * fast_rsq(rss_p(rss, row) * (1.0f / D) + EPS);
#pragma unroll
                for (int bj = 0; bj < 2; ++bj) { f32x4 v0 = acc[ai][bj][m][0] * rs, v1 = acc[ai][bj][m][1] * rs; const int ct = c8 + bj * HALF;
                    if (mode == 1) { const int ck = (pn - 4) * 256 + ct; const f32x4 l0 = *(const f32x4*)(lb + ck), l1 = *(const f32x4*)(lb + ck + 4); f32x4 g0, g1;
#pragma unroll
                        for (int j = 0; j < 4; ++j) { const float s0 = sigmoid_f(v0[j]), s1 = sigmoid_f(v1[j]);
                            g0[j] = fmaxf(fast_ln(l0[j] + (1.0f - l0[j]) * s0), -60.0f); g1[j] = fmaxf(fast_ln(l1[j] + (1.0f - l1[j]) * s1), -60.0f);
                            v0[j] = (1.0f - l0[j]) * (1.0f - s0); v1[j] = (1.0f - l1[j]) * (1.0f - s1); }
                        float* o = lgc + (unsigned)row * 1024 + ck; *(f32x4*)o = g0; *(f32x4*)(o + 4) = g1; }
                    if (mode == 2) { const int ck = (pn - 28) * 256 + ct; const f32x4 b0 = *(const f32x4*)(bg + ck), b1 = *(const f32x4*)(bg + ck + 4); f32x4 g0, g1;
#pragma unroll
                        for (int j = 0; j < 4; ++j) { const float x0 = v0[j] + b0[j], x1 = v1[j] + b1[j];
                            g0[j] = (fminf(x0, 0.f) - fast_ln(1.0f + fast_exp(-fabsf(x0)))) * 0.0625f;
                            g1[j] = (fminf(x1, 0.f) - fast_ln(1.0f + fast_exp(-fabsf(x1)))) * 0.0625f; }
                        float* o = lgd + (unsigned)row * 512 + ck; *(f32x4*)o = g0; *(f32x4*)(o + 4) = g1; }
                    else { u32x4 w; w.x = cvt_pk_bf16(v0[0], v0[1]); w.y = cvt_pk_bf16(v0[2], v0[3]); w.z = cvt_pk_bf16(v1[0], v1[1]); w.w = cvt_pk_bf16(v1[2], v1[3]);
                        *(u32x4*)(Z + (unsigned)row * N_CDZ + pn * 256 + ct) = w; } } }
    }
};

struct EpiUp {
    static constexpr bool PERM = true;
    bf16_t* HB; const float* rss; const float* cw; const float* cb; float* ghead; float* gtail; float* ffn_out;
    __device__ __forceinline__ void operator()(Acc& acc, const Unit& u, int wr, int wc, int fr, int fq, MK_LAS unsigned char* lds) const {
        asm volatile("" : "+v"(fr), "+v"(fq));
        const int lane = fq * 16 + fr; const int row0 = u.pm * BM + wr * 64 + fr; const int c8 = wc * 32 + 8 * fq, cg = u.pn * 128 + c8;
        MK_LAS float* T = (MK_LAS float*)lds;
        f32x4 w0 = *(const f32x4*)(cw + cg), w1 = *(const f32x4*)(cw + FF + cg), w2 = *(const f32x4*)(cw + 2 * FF + cg), bb = *(const f32x4*)(cb + cg);
#pragma unroll
        for (int ai = 0; ai < 2; ++ai)
#pragma unroll
            for (int m = 0; m < 4; ++m) { const float rs = fast_rsq(rss_p(rss, row0 + ai * HALF + m * 16) * (1.0f / D) + EPS);
#pragma unroll
                for (int bj = 0; bj < 2; ++bj) { acc[ai][bj][m][0] = acc[ai][bj][m][0] * rs; acc[ai][bj][m][1] = acc[ai][bj][m][1] * rs; } }
        if (fr >= 14) {
#pragma unroll
            for (int ai = 0; ai < 2; ++ai) { MK_LAS float* t = T + ((2 * ai + wr) * 2 + (fr - 14)) * 128 + c8; *(MK_LAS f32x4*)t = acc[ai][0][3][0]; *(MK_LAS f32x4*)(t + 4) = acc[ai][0][3][1]; }
        }
        LDS_WAIT(); __builtin_amdgcn_s_barrier(); asm volatile("" ::: "memory");
        const int s1 = (lane & 48) | ((fr + 15) & 15), s2 = (lane & 48) | ((fr + 14) & 15);
        const bool first_tile = (u.pm & 15) == 0;
#pragma unroll
        for (int n = 0; n < 2; ++n) {
            if (n == 1) { w0 = *(const f32x4*)(cw + cg + 4); w1 = *(const f32x4*)(cw + FF + cg + 4); w2 = *(const f32x4*)(cw + 2 * FF + cg + 4); bb = *(const f32x4*)(cb + cg + 4); }
#pragma unroll
            for (int ai = 0; ai < 2; ++ai) { const int grp = 2 * ai + wr; f32x4 prev1, prev2;
                if (grp == 0) { prev1 = (f32x4){0.f, 0.f, 0.f, 0.f}; prev2 = prev1; }
                else { const f32x4 r63 = *(const MK_LAS f32x4*)(T + ((grp - 1) * 2 + 1) * 128 + c8 + 4 * n), r62 = *(const MK_LAS f32x4*)(T + ((grp - 1) * 2 + 0) * 128 + c8 + 4 * n); prev1 = r63; prev2 = (fr == 0) ? r62 : r63; }
#pragma unroll
                for (int m = 0; m < 4; ++m) { const int row = row0 + ai * HALF + m * 16; const f32x4 x = acc[ai][0][m][n]; f32x4 r1, r2, hv;
#pragma unroll
                    for (int j = 0; j < 4; ++j) { r1[j] = SHL(x[j], s1); r2[j] = SHL(x[j], s2); }
                    const f32x4 p1 = (fr >= 1) ? r1 : prev1, p2 = (fr >= 2) ? r2 : prev2;
                    prev1 = r1; prev2 = r2;
                    const f32x4 gc = bb + w0 * p2 + w1 * p1 + w2 * x; const f32x4 uu = acc[ai][1][m][n];
#pragma unroll
                    for (int j = 0; j < 4; ++j) hv[j] = silu_f(gc[j]) * uu[j];
                    const bool deferred = (grp == 0) && (m == 0) && (fr < 2) && !first_tile;
                    if (deferred) { float* o = ghead + ((unsigned)u.pm * 2 + fr) * (2 * FF) + cg + 4 * n; *(f32x4*)o = x; *(f32x4*)(o + FF) = uu; }
                    if (grp == 3 && m == 3 && fr >= 14) { *(f32x4*)(gtail + ((unsigned)u.pm * 2 + (fr - 14)) * FF + cg + 4 * n) = x;
                        if ((u.pm & 15) == 15) *(f32x4*)(ffn_out + ((unsigned)(u.pm >> 4) * 2 + (fr - 14)) * FF + cg + 4 * n) = x; }
                    if (!deferred) { u32x2 w; w.x = cvt_pk_bf16(hv[0], hv[1]); w.y = cvt_pk_bf16(hv[2], hv[3]); *(u32x2*)(HB + (unsigned)row * FF + cg + 4 * n) = w; }
                    asm volatile("" ::: "memory"); } } }
    }
};

template <int NT> struct SgLd { static constexpr int LDR = 16 * NT + 4, SLAB = 64 * LDR; };
template <int NT> __device__ __forceinline__ float sred4(const MK_LAS float* red, int row, int col) { constexpr int LDR = SgLd<NT>::LDR, SLAB = SgLd<NT>::SLAB; const MK_LAS float* p = red + row * LDR + col; return (p[0] + p[SLAB]) + (p[2 * SLAB] + p[3 * SLAB]); }
template <int NT> __device__ __forceinline__ void sgemm_tile(MK_LAS float* red, const bf16_t* A, const bf16_t* Bt, int K, int n0, int wave, int lane) {
    constexpr int LDR = SgLd<NT>::LDR, SLAB = SgLd<NT>::SLAB;
    f32x4 acc[4][NT];
#pragma unroll
    for (int a = 0; a < 4; ++a)
#pragma unroll
        for (int b = 0; b < NT; ++b) acc[a][b] = (f32x4){0.f, 0.f, 0.f, 0.f};
    const int fr = lane & 15, g = lane >> 4;
    const bf16_t* ap = A + (size_t)fr * K + 8 * g; const bf16_t* bp = Bt + (size_t)(n0 + fr) * K + 8 * g;
    bf16x8 a[4], b[NT], a2[4], b2[NT];
    if (wave < K / 32) {
#pragma unroll
        for (int mt = 0; mt < 4; ++mt) a[mt] = *(const bf16x8*)(ap + (size_t)(16 * mt) * K + 32 * wave);
#pragma unroll
        for (int nt = 0; nt < NT; ++nt) b[nt] = *(const bf16x8*)(bp + (size_t)(16 * nt) * K + 32 * wave); }
    for (int ks = wave; ks < K / 32; ks += 8) { const int kn = (ks + 8 < K / 32) ? ks + 8 : ks;
#pragma unroll
        for (int mt = 0; mt < 4; ++mt) a2[mt] = *(const bf16x8*)(ap + (size_t)(16 * mt) * K + 32 * kn);
#pragma unroll
        for (int nt = 0; nt < NT; ++nt) b2[nt] = *(const bf16x8*)(bp + (size_t)(16 * nt) * K + 32 * kn);
#pragma unroll
        for (int mt = 0; mt < 4; ++mt)
#pragma unroll
            for (int nt = 0; nt < NT; ++nt) acc[mt][nt] = __builtin_amdgcn_mfma_f32_16x16x32_bf16(a[mt], b[nt], acc[mt][nt], 0, 0, 0);
#pragma unroll
        for (int mt = 0; mt < 4; ++mt) a[mt] = a2[mt];
#pragma unroll
        for (int nt = 0; nt < NT; ++nt) b[nt] = b2[nt]; }
    MK_LAS float* slab = red + (wave & 3) * SLAB;
    if (wave < 4) {
#pragma unroll
        for (int mt = 0; mt < 4; ++mt)
#pragma unroll
            for (int nt = 0; nt < NT; ++nt)
#pragma unroll
                for (int e = 0; e < 4; ++e) slab[(16 * mt + 4 * g + e) * LDR + 16 * nt + fr] = acc[mt][nt][e]; }
    LDS_WAIT(); __syncthreads();
    if (wave >= 4) {
#pragma unroll
        for (int mt = 0; mt < 4; ++mt)
#pragma unroll
            for (int nt = 0; nt < NT; ++nt)
#pragma unroll
                for (int e = 0; e < 4; ++e) slab[(16 * mt + 4 * g + e) * LDR + 16 * nt + fr] += acc[mt][nt][e]; }
    LDS_WAIT(); __syncthreads();
}
}
namespace mk {
struct Args { const float* in[32]; float* out; unsigned char* ws; int nlayers; int pad; };
struct Frame {
    MK_LAS unsigned char* lds; unsigned* ctl; unsigned char* ws; float* out; const float* const* in;
    int tid, lane, wave, vcu, G;
};
constexpr size_t O_YP = 0, O_YS = O_YP + (size_t)MP * D, O_KVP = O_YS + (size_t)MS * D, O_KVS = O_KVP + (size_t)2 * NB * LA * 2 * WA, O_CONVP = O_KVS + (size_t)2 * SB * ST * 2 * WA,
    O_CONVS = O_CONVP + (size_t)2 * NB * 3 * WB, O_HP = O_CONVS + (size_t)2 * SB * 3 * WB, O_HS = O_HP + (size_t)2 * NB * WB, O_HGP = O_HS + (size_t)2 * SB * WB,
    O_HGS = O_HGP + (size_t)2 * NB * HC * DK * DVC, O_GLP = O_HGS + (size_t)2 * SB * HC * DK * DVC, O_GLS = O_GLP + (size_t)2 * NB * HD_ * DK * DVD, O_FFP = O_GLS + (size_t)2 * SB * HD_ * DK * DVD,
    O_FFS = O_FFP + (size_t)4 * NB * 2 * FF, O_END = O_FFS + (size_t)4 * SB * 2 * FF;
enum { I_XP = 0, I_XS, I_KV, I_SCONV, I_SH, I_SHG, I_SGL, I_SFF, I_NMIX, I_NFFN, I_WINAB, I_QN, I_KN, I_LCW, I_LCB, I_LWA, I_LBA, I_LWX, I_LBX, I_LLAM, I_WOUTAB, I_WINCD, I_LBL, I_HGN, I_WG2, I_BG, I_GLN, I_WOUTCD, I_WUP, I_FCW, I_FCB, I_WDN };

__device__ __forceinline__ float* rss_ptr(Frame& F, int idx) { return (float*)(F.ws + WS_RSS) + (size_t)idx * MP * 8; }
__device__ __forceinline__ float* rss_sptr(Frame& F, int idx) { return (float*)(F.ws + WS_RSS) + RSS_P_FLOATS + (size_t)idx * MS * 128; }
__device__ __forceinline__ float wave_sum(float v, int lane) {
#pragma unroll
    for (int o = 1; o < 64; o <<= 1) v += SHX(v, o);
    return v;
}
__device__ __forceinline__ int q_next(Frame& F, int q) {
    volatile MK_LAS int* slot = (volatile MK_LAS int*)(F.lds + MISC_OFF + 64);
    __syncthreads();
    if (F.tid == 0) *slot = (int)__hip_atomic_fetch_add(F.ctl + CW_Q + 64 * q, 1u, __ATOMIC_RELAXED, __HIP_MEMORY_SCOPE_AGENT);
    __syncthreads();
    return *slot;
}

struct P0Item { const float* W; bf16_t* WT; const float* gain; int K, ldw, n0, k0, upmap; };
__device__ __forceinline__ P0Item p0_decode(Frame& F, int it) {
    constexpr int I_AB = 32 * 20, I_O = 32 * 8, I_CD = 32 * 28, I_UP = 32 * 43, I_DN = 86 * 8;
    constexpr int PER_PAIR = I_AB + I_O + I_CD + I_O, PER_LAYER = I_UP + I_DN;
    P0Item p; int r = it; p.upmap = 0; p.gain = nullptr;
    if (r < 2 * PER_PAIR) { const int i = r / PER_PAIR; r -= i * PER_PAIR;
        if (r < I_AB) { p.W = F.in[I_WINAB] + (size_t)i * D * N_AB; p.WT = (bf16_t*)(F.ws + WS_WINAB + i * SZ_WINAB); p.gain = F.in[I_NMIX] + (2 * i) * D; p.K = D; p.ldw = N_AB; p.k0 = 64 * (r / 20); p.n0 = 256 * (r % 20); return p; } r -= I_AB;
        if (r < I_O) { p.W = F.in[I_WOUTAB] + (size_t)i * D * D; p.WT = (bf16_t*)(F.ws + WS_WOUTAB + i * SZ_WOUT); p.K = D; p.ldw = D; p.k0 = 64 * (r / 8); p.n0 = 256 * (r % 8); return p; } r -= I_O;
        if (r < I_CD) { p.W = F.in[I_WINCD] + (size_t)i * D * N_CD_SRC; p.WT = (bf16_t*)(F.ws + WS_WINCD + i * SZ_WINCD); p.gain = F.in[I_NMIX] + (2 * i + 1) * D; p.K = D; p.ldw = N_CD_SRC; p.k0 = 64 * (r / 28); p.n0 = 256 * (r % 28); return p; } r -= I_CD;
        p.W = F.in[I_WOUTCD] + (size_t)i * D * D; p.WT = (bf16_t*)(F.ws + WS_WOUTCD + i * SZ_WOUT); p.K = D; p.ldw = D; p.k0 = 64 * (r / 8); p.n0 = 256 * (r % 8); return p; }
    r -= 2 * PER_PAIR; const int l = r / PER_LAYER; r -= l * PER_LAYER;
    if (r < I_UP) { p.W = F.in[I_WUP] + (size_t)l * D * N_UP; p.WT = (bf16_t*)(F.ws + WS_WUP + l * SZ_WUP); p.gain = F.in[I_NFFN] + l * D; p.K = D; p.ldw = N_UP; p.k0 = 64 * (r / 43); p.n0 = 256 * (r % 43); p.upmap = 1; return p; } r -= I_UP;
    p.W = F.in[I_WDN] + (size_t)l * FF * D; p.WT = (bf16_t*)(F.ws + WS_WDN + l * SZ_WDN); p.K = FF; p.ldw = D; p.k0 = 64 * (r / 8); p.n0 = 256 * (r % 8); return p;
}
__device__ __forceinline__ void p0_load(const P0Item& p, int wave, int lane, f32x4 (&v)[8]) {
    const float* src = p.W + (size_t)(p.k0 + 8 * wave) * p.ldw + p.n0 + 4 * lane;
#pragma unroll
    for (int r = 0; r < 8; ++r) v[r] = *(const f32x4*)(src + (size_t)r * p.ldw);
}
__device__ __forceinline__ void p0_store(const P0Item& p, int tid, int wave, int lane, f32x4 (&v)[8], MK_LAS unsigned char* img) {
    if (p.gain) {
#pragma unroll
        for (int r = 0; r < 8; ++r) v[r] = v[r] * p.gain[p.k0 + 8 * wave + r]; }
#pragma unroll
    for (int j = 0; j < 4; ++j) { u32x4 o; o.x = pk2(v[0][j], v[1][j]); o.y = pk2(v[2][j], v[3][j]); o.z = pk2(v[4][j], v[5][j]); o.w = pk2(v[6][j], v[7][j]);
        *(MK_LAS u32x4*)(img + (4 * lane + j) * 144 + 16 * wave) = o; }
    LDS_WAIT(); __syncthreads();
#pragma unroll
    for (int q = 0; q < 4; ++q) { const int n = (tid >> 3) + 64 * q, ch = tid & 7; const int c = p.n0 + n; int drow = c;
        if (p.upmap) { const int cc = c < FF ? c : c - FF; drow = (cc >> 7) * 256 + (cc & 127) + (c < FF ? 0 : 128); }
        *(u32x4*)(p.WT + (size_t)drow * p.K + p.k0 + 8 * ch) = *(const MK_LAS u32x4*)(img + n * 144 + 16 * ch); }
}
__device__ __forceinline__ void p0_prologue(Frame& F) {
    const int gw = F.vcu * 8 + F.wave, NGW = F.G * 8; const int lane = F.lane;
    constexpr int NITEMS = 2 * (32 * 20 + 32 * 8 + 32 * 28 + 32 * 8) + 4 * (32 * 43 + 86 * 8);
    { f32x4 va[8], vb[8]; int it = F.vcu; P0Item pa, pb; MK_LAS unsigned char* img0 = F.lds; MK_LAS unsigned char* img1 = F.lds + 40960;
      if (it < NITEMS) { pa = p0_decode(F, it); p0_load(pa, F.wave, lane, va); }
      while (it < NITEMS) {
          const int it1 = it + F.G; if (it1 < NITEMS) { pb = p0_decode(F, it1); p0_load(pb, F.wave, lane, vb); }
          p0_store(pa, F.tid, F.wave, lane, va, img0);
          if (it1 >= NITEMS) break;
          const int it2 = it1 + F.G; if (it2 < NITEMS) { pa = p0_decode(F, it2); p0_load(pa, F.wave, lane, va); }
          p0_store(pb, F.tid, F.wave, lane, vb, img1);
          it = it2; }
      __syncthreads(); }
    const int gt = F.vcu * 512 + F.tid, NGT = F.G * 512;
    for (int it = gt; it < 2 * 512 * (D / 8); it += NGT) { const int k8 = it % (D / 8), n = (it / (D / 8)) % 512, i = it / (512 * (D / 8));
        const float* W = F.in[I_WINCD] + (size_t)i * D * N_CD_SRC; const float* g2 = F.in[I_WG2] + (size_t)i * 16 * 512; const float* gn = F.in[I_NMIX] + (2 * i + 1) * D; float v[8];
#pragma unroll
        for (int j = 0; j < 8; ++j) { const int k = 8 * k8 + j; float s = 0.f;
#pragma unroll
            for (int r = 0; r < 16; ++r) s += W[(size_t)k * N_CD_SRC + N_CDZ + r] * g2[r * 512 + n];
            v[j] = s * gn[k]; }
        u32x4 o; o.x = pk2(v[0], v[1]); o.y = pk2(v[2], v[3]); o.z = pk2(v[4], v[5]); o.w = pk2(v[6], v[7]);
        *(u32x4*)((bf16_t*)(F.ws + WS_WINCD + i * SZ_WINCD) + (size_t)(N_CDZ + n) * D + 8 * k8) = o; }
    for (int it = gt; it < 2 * 8 * 2 * 128 * 16; it += NGT) { const int i8 = it % 16, o_ = (it / 16) % 128, gate = (it / 2048) % 2, h = (it / 4096) % 8, i = it / 32768;
        const float* W = F.in[gate ? I_LWX : I_LWA] + ((size_t)(i * 8 + h) * 128) * 128; float v[8];
#pragma unroll
        for (int j = 0; j < 8; ++j) v[j] = W[(size_t)(8 * i8 + j) * 128 + o_];
        u32x4 o; o.x = pk2(v[0], v[1]); o.y = pk2(v[2], v[3]); o.z = pk2(v[4], v[5]); o.w = pk2(v[6], v[7]);
        *(u32x4*)((bf16_t*)(F.ws + WS_WLRU) + ((size_t)((i * 8 + h) * 2 + gate) * 128 + o_) * 128 + 8 * i8) = o; }
    for (int k = gt; k < 1024; k += NGT) { const float a = F.in[I_LBL][k], b = F.in[I_LBL][1024 + k]; const float m = fmaxf(a, b), ea = expf(a - m), eb = expf(b - m), p0 = ea / (ea + eb), p1 = eb / (ea + eb);
        float* lb = (float*)(F.ws + WS_LB); lb[k] = p0 - p0; lb[1024 + k] = (p0 + p1) - p0; }
    for (int m = gw; m < MT; m += NGW) { const float* xr = (m < MP) ? F.in[I_XP] + (size_t)m * D : F.in[I_XS] + (size_t)(m - MP) * D; bf16_t* orow = (bf16_t*)(F.ws + WS_XB16) + (size_t)m * D; float s = 0.f;
#pragma unroll
        for (int j = 0; j < 8; ++j) { const f32x4 v = *(const f32x4*)(xr + 4 * lane + 256 * j); s += (v[0] * v[0] + v[1] * v[1]) + (v[2] * v[2] + v[3] * v[3]);
            u32x2 w; w.x = pk2(v[0], v[1]); w.y = pk2(v[2], v[3]); *(u32x2*)(orow + 4 * lane + 256 * j) = w; }
        s = wave_sum(s, lane);
        if (m < MP) { if (lane < 8) rss_ptr(F, 0)[(size_t)m * 8 + lane] = lane == 0 ? s : 0.f; } else { rss_sptr(F, 0)[(size_t)(m - MP) * 128 + lane] = lane == 0 ? s : 0.f; rss_sptr(F, 0)[(size_t)(m - MP) * 128 + 64 + lane] = 0.f; } }
}

__device__ __forceinline__ void sample_units_range(Frame& F, int nwg_main, int nsu, int& s0, int& sstep) {
    const int rem = nwg_main % F.G; const int c = opaque_bid();
    if (rem == 0) { s0 = c; sstep = F.G; } else if (c >= rem) { s0 = c - rem; sstep = F.G - rem; } else { s0 = nsu; sstep = 1; }
}
__device__ __forceinline__ void sample_in_ab(Frame& F, int i, const bf16_t* Wt, const float* rss) {
    MK_LAS float* red = (MK_LAS float*)F.lds; int s0, sstep; sample_units_range(F, 32 * (N_AB / 256), N_AB / 128, s0, sstep);
    const bf16_t* A = (const bf16_t*)(F.ws + WS_XB16) + (size_t)MP * D; float* zs = (float*)(F.ws + WS_ZS);
    for (int su = s0; su < N_AB / 128; su += sstep) {
        sgemm_tile<8>(red, A, Wt, D, 128 * su, F.wave, F.lane);
        const int lane = F.lane; const int row = F.tid >> 3, part = F.tid & 7, kind = su >> 3, cw = (su & 7) * 128 + 16 * part; const float rs = fast_rsq(rss_s(rss, row) * (1.0f / D) + EPS);
        float v[16]; float ss = 0.f;
#pragma unroll
        for (int j = 0; j < 16; ++j) { v[j] = sred4<8>(red, row, 16 * part + j) * rs; ss += v[j] * v[j]; }
        if (kind <= 1) { ss += SHX(ss, 1); ss += SHX(ss, 2); ss += SHX(ss, 4); const float hs = fast_rsq(ss * (1.0f / DH) + EPS); const float* gp = F.in[kind ? I_KN : I_QN] + i * DH + 16 * part;
#pragma unroll
            for (int j = 0; j < 16; ++j) v[j] = v[j] * hs * gp[j]; }
        float* zo = zs + (size_t)row * N_CD + 128 * su + 16 * part;
#pragma unroll
        for (int j = 0; j < 16; ++j) zo[j] = v[j];
        if (kind == 1 || kind == 2) { float* o = F.out + O_KVS + (((size_t)i * MS + row) * 2 + (kind - 1)) * WA + cw;
#pragma unroll
            for (int j = 0; j < 16; ++j) o[j] = v[j]; }
        if (kind == 3 && (row & 7) >= 5) { float* o = F.out + O_CONVS + (((size_t)i * SB + (row >> 3)) * 3 + ((row & 7) - 5)) * WB + cw;
#pragma unroll
            for (int j = 0; j < 16; ++j) o[j] = v[j]; }
        __syncthreads();
    }
}
__device__ __forceinline__ void sample_plain(Frame& F, const bf16_t* Wt, const float* rss, int N, int nwg_main, float* dst, int ldd, bool up_map) {
    MK_LAS float* red = (MK_LAS float*)F.lds; int s0, sstep; sample_units_range(F, nwg_main, N / 128, s0, sstep);
    const bf16_t* A = (const bf16_t*)(F.ws + WS_XB16) + (size_t)MP * D;
    for (int su = s0; su < N / 128; su += sstep) {
        sgemm_tile<8>(red, A, Wt, D, 128 * su, F.wave, F.lane);
        const int row = F.tid >> 3, part = F.tid & 7; const float rs = fast_rsq(rss_s(rss, row) * (1.0f / D) + EPS);
        const int col = up_map ? ((su & 1) * FF + (su >> 1) * 128) : 128 * su;
        float* o = dst + (size_t)row * ldd + col + 16 * part;
#pragma unroll
        for (int j = 0; j < 16; ++j) o[j] = sred4<8>(red, row, 16 * part + j) * rs;
        __syncthreads();
    }
}
__device__ __forceinline__ void sample_res(Frame& F, const bf16_t* A, const bf16_t* Wt, int K, float* yout, float* rss_next) {
    MK_LAS float* red = (MK_LAS float*)F.lds; int s0, sstep; sample_units_range(F, 256, D / 16, s0, sstep);
    bf16_t* xb = (bf16_t*)(F.ws + WS_XB16) + (size_t)MP * D;
    for (int su = s0; su < D / 16; su += sstep) {
        sgemm_tile<1>(red, A, Wt, K, 16 * su, F.wave, F.lane);
        const int lane = F.lane; const int row = F.tid >> 3, c2 = 2 * (F.tid & 7); const size_t o = (size_t)row * D + 16 * su + c2;
        const unsigned xo = *(const unsigned*)(xb + o);
        const float v0 = bflo(xo) + sred4<1>(red, row, c2), v1 = bfhi(xo) + sred4<1>(red, row, c2 + 1);
        *(unsigned*)(xb + o) = pk2(v0, v1); if (yout) { yout[o] = v0; yout[o + 1] = v1; }
        float ss = v0 * v0 + v1 * v1; ss += SHX(ss, 1); ss += SHX(ss, 2); ss += SHX(ss, 4);
        if ((F.tid & 7) == 0) rss_next[(size_t)row * 128 + su] = ss;
        __syncthreads();
    }
}

__device__ __forceinline__ void ffn_fixup(Frame& F, int layer) {
    const int gt = F.vcu * 512 + F.tid, NGT = F.G * 512;
    const float* cw = F.in[I_FCW] + (size_t)layer * 3 * FF; const float* cb = F.in[I_FCB] + (size_t)layer * FF;
    const float* ghead = (const float*)(F.ws + WS_GHEAD); const float* gtail = (const float*)(F.ws + WS_GTAIL); bf16_t* HBp = (bf16_t*)(F.ws + WS_Z);
    for (int it = gt; it < 30 * 2 * FF; it += NGT) { const int f = it % FF, r = (it / FF) & 1, ti = it / (2 * FF); const int pm = ti + 1 + (ti >= 15 ? 1 : 0);
        const float g0 = ghead[((size_t)pm * 2 + 0) * (2 * FF) + f], t0 = gtail[((size_t)(pm - 1) * 2 + 0) * FF + f], t1 = gtail[((size_t)(pm - 1) * 2 + 1) * FF + f];
        float gc, uu;
        if (r == 0) { gc = cb[f] + cw[f] * t0 + cw[FF + f] * t1 + cw[2 * FF + f] * g0; uu = ghead[((size_t)pm * 2 + 0) * (2 * FF) + FF + f]; }
        else { const float g1 = ghead[((size_t)pm * 2 + 1) * (2 * FF) + f]; gc = cb[f] + cw[f] * t1 + cw[FF + f] * g0 + cw[2 * FF + f] * g1; uu = ghead[((size_t)pm * 2 + 1) * (2 * FF) + FF + f]; }
        HBp[(size_t)(pm * 256 + r) * FF + f] = (bf16_t)f2bf(silu_f(gc) * uu); }
    const float* gus = (const float*)(F.ws + WS_GUS); const float* sbuf = F.in[I_SFF] + (size_t)layer * SB * 2 * FF;
    for (int it = gt; it < MS * FF; it += NGT) { const int f = it % FF, row = it / FF, t = row & 7, b = row >> 3;
        const float x0 = gus[(size_t)row * N_UP + f];
        const float x1 = (t >= 1) ? gus[(size_t)(row - 1) * N_UP + f] : sbuf[((size_t)b * 2 + 1) * FF + f];
        const float x2 = (t >= 2) ? gus[(size_t)(row - 2) * N_UP + f] : sbuf[((size_t)b * 2 + t) * FF + f];
        const float gc = cb[f] + cw[f] * x2 + cw[FF + f] * x1 + cw[2 * FF + f] * x0;
        HBp[(size_t)(MP + row) * FF + f] = (bf16_t)f2bf(silu_f(gc) * gus[(size_t)row * N_UP + FF + f]);
        if (t >= 6) F.out[O_FFS + (((size_t)layer * SB + b) * 2 + (t - 6)) * FF + f] = x0; }
}
}
namespace mk {
__device__ __forceinline__ s16x4 tr_read4(unsigned addr) { s16x4 r; asm volatile("ds_read_b64_tr_b16 %0, %1\n\ts_waitcnt lgkmcnt(0)" : "=&v"(r) : "v"(addr) : "memory"); return r; }

constexpr int ATT_VSTRIDE = 288;
constexpr int ATT_PLD = 132;
struct AttTile { int tq0, tqs, kb0, dil, win, nst; };
__device__ __forceinline__ void att_load(const bf16_t* Zb, int h, int base, int dil, int lane, bf16x8 (&kf)[2][4], u32x4 (&vv)[8]) {
    const int qi = lane & 15, g = lane >> 4;
#pragma unroll
    for (int kt = 0; kt < 2; ++kt) { int s = base + dil * (16 * kt + qi); s = s < 0 ? 0 : (s > SEQ - 1 ? SEQ - 1 : s); const bf16_t* kp = Zb + (size_t)s * N_AB + WA + h * DH + 8 * g;
#pragma unroll
        for (int q = 0; q < 4; ++q) kf[kt][q] = *(const bf16x8*)(kp + 32 * q); }
#pragma unroll
    for (int j = 0; j < 8; ++j) { const int c = lane + 64 * j, r = c >> 4, ch = c & 15; int s = base + dil * r; s = s < 0 ? 0 : (s > SEQ - 1 ? SEQ - 1 : s);
        vv[j] = *(const u32x4*)(Zb + (size_t)s * N_AB + 2 * WA + h * DH + 8 * ch); }
}
struct AttState { f32x4 o[8]; float mrun, lrun; };
__device__ __forceinline__ void attn_step(AttState& A, const bf16_t* Zb, int h, int tq, int base, int dil, int win, int nbase, int ndil, int lane, MK_LAS unsigned char* vt, unsigned trb, const bf16x8 (&qf)[4],
                                          bf16x8 (&kf)[2][4], u32x4 (&vv)[8], bf16x8 (&kn)[2][4], u32x4 (&vn)[8]) {
    const int g = lane >> 4; const float sc = 0.08838834764831845f * 1.44269504089f;
#pragma unroll
    for (int j = 0; j < 8; ++j) { const int c = lane + 64 * j, r = c >> 4, ch = c & 15; *(MK_LAS u32x4*)(vt + r * ATT_VSTRIDE + 16 * ch) = vv[j]; }
    att_load(Zb, h, nbase, ndil, lane, kn, vn);
    f32x4 sv[2];
#pragma unroll
    for (int kt = 0; kt < 2; ++kt) { sv[kt] = (f32x4){0.f, 0.f, 0.f, 0.f};
#pragma unroll
        for (int q = 0; q < 4; ++q) sv[kt] = __builtin_amdgcn_mfma_f32_16x16x32_bf16(kf[kt][q], qf[q], sv[kt], 0, 0, 0); }
    float mx = -1e30f; bool val[2][4];
#pragma unroll
    for (int kt = 0; kt < 2; ++kt)
#pragma unroll
        for (int e = 0; e < 4; ++e) { const int s = base + dil * (16 * kt + 4 * g + e); const int dist = tq - s; val[kt][e] = (s >= 0) && (dist >= 0) && (dist <= win);
            sv[kt][e] = val[kt][e] ? sv[kt][e] * sc : -1e30f; mx = fmaxf(mx, sv[kt][e]); }
    mx = fmaxf(mx, SHX(mx, 16)); mx = fmaxf(mx, SHX(mx, 32));
    const float mnew = fmaxf(A.mrun, mx), alpha = fast_exp2(A.mrun - mnew); A.mrun = mnew;
    float ps = 0.f; float p[2][4];
#pragma unroll
    for (int kt = 0; kt < 2; ++kt)
#pragma unroll
        for (int e = 0; e < 4; ++e) { p[kt][e] = val[kt][e] ? fast_exp2(sv[kt][e] - mnew) : 0.f; ps += p[kt][e]; }
    A.lrun = A.lrun * alpha + ps;
    union { bf16x8 v; unsigned u[4]; } pf; pf.u[0] = cvt_pk_bf16(p[0][0], p[0][1]); pf.u[1] = cvt_pk_bf16(p[0][2], p[0][3]); pf.u[2] = cvt_pk_bf16(p[1][0], p[1][1]); pf.u[3] = cvt_pk_bf16(p[1][2], p[1][3]);
    s16x4 t0a, t1a, t2a, t3a, t4a, t5a, t6a, t7a, t0b, t1b, t2b, t3b, t4b, t5b, t6b, t7b;
    asm volatile("s_waitcnt lgkmcnt(0)\n\t"
                 "ds_read_b64_tr_b16 %0, %16\n\tds_read_b64_tr_b16 %1, %16 offset:32\n\tds_read_b64_tr_b16 %2, %16 offset:64\n\tds_read_b64_tr_b16 %3, %16 offset:96\n\t"
                 "ds_read_b64_tr_b16 %4, %16 offset:128\n\tds_read_b64_tr_b16 %5, %16 offset:160\n\tds_read_b64_tr_b16 %6, %16 offset:192\n\tds_read_b64_tr_b16 %7, %16 offset:224\n\t"
                 "ds_read_b64_tr_b16 %8, %16 offset:4608\n\tds_read_b64_tr_b16 %9, %16 offset:4640\n\tds_read_b64_tr_b16 %10, %16 offset:4672\n\tds_read_b64_tr_b16 %11, %16 offset:4704\n\t"
                 "ds_read_b64_tr_b16 %12, %16 offset:4736\n\tds_read_b64_tr_b16 %13, %16 offset:4768\n\tds_read_b64_tr_b16 %14, %16 offset:4800\n\tds_read_b64_tr_b16 %15, %16 offset:4832\n\t"
                 "s_waitcnt lgkmcnt(0)"
                 : "=&v"(t0a), "=&v"(t1a), "=&v"(t2a), "=&v"(t3a), "=&v"(t4a), "=&v"(t5a), "=&v"(t6a), "=&v"(t7a), "=&v"(t0b), "=&v"(t1b), "=&v"(t2b), "=&v"(t3b), "=&v"(t4b), "=&v"(t5b), "=&v"(t6b), "=&v"(t7b)
                 : "v"(trb) : "memory");
#define ATT_PV(d, ta, tb) { union { bf16x8 v; s16x4 hh[2]; } vf; vf.hh[0] = ta; vf.hh[1] = tb; A.o[d] = A.o[d] * alpha; A.o[d] = __builtin_amdgcn_mfma_f32_16x16x32_bf16(vf.v, pf.v, A.o[d], 0, 0, 0); }
    ATT_PV(0, t0a, t0b) ATT_PV(1, t1a, t1b) ATT_PV(2, t2a, t2b) ATT_PV(3, t3a, t3b) ATT_PV(4, t4a, t4b) ATT_PV(5, t5a, t5b) ATT_PV(6, t6a, t6b) ATT_PV(7, t7a, t7b)
#undef ATT_PV
}
__device__ __forceinline__ void att_seg(bool passB, int t0, int st, int& base, int& dil, int& win) {
    if (!passB) { base = t0 - 128 + 32 * st; dil = 1; win = 128; }
    else if (st < 6) { base = t0 - 512 + 128 * st; dil = 4; win = 512; } else { base = t0 - 2048 + 512 * (st - 6); dil = 16; win = 2048; }
}
template <bool PASSB> __device__ __forceinline__ void attn_tile(Frame& F, const bf16_t* Zb, bf16_t* MIXb, float* PB, int h, int t0blk, int tile, MK_LAS unsigned char* vt) {
    constexpr int NST = PASSB ? 11 : 5;
    const int lane = F.lane, qi = lane & 15, g = lane >> 4;
    const int t0 = PASSB ? t0blk + tile : t0blk + 16 * tile;
    const int tq = PASSB ? t0 + 16 * qi : t0 + qi; const int tl = tq - t0blk;
    bf16x8 qf[4];
#pragma unroll
    for (int s = 0; s < 4; ++s) qf[s] = *(const bf16x8*)(Zb + (size_t)tq * N_AB + h * DH + 32 * s + 8 * g);
    AttState A; float* pb = PB + (size_t)tl * ATT_PLD;
    if (PASSB) {
#pragma unroll
        for (int d = 0; d < 8; ++d) A.o[d] = *(const f32x4*)(pb + 16 * d + 4 * g);
        A.mrun = pb[128]; A.lrun = g == 0 ? pb[129] : 0.f;
    } else {
#pragma unroll
        for (int d = 0; d < 8; ++d) A.o[d] = (f32x4){0.f, 0.f, 0.f, 0.f};
        A.mrun = -1e30f; A.lrun = 0.f; }
    const unsigned vbase = (unsigned)(size_t)vt;
    const unsigned trb = vbase + (4 * g + (qi >> 2)) * ATT_VSTRIDE + (4 * (qi & 3)) * 2;
    bf16x8 k0[2][4], k1[2][4]; u32x4 v0[8], v1[8];
    { int base, dil, win; att_seg(PASSB, t0, 0, base, dil, win); att_load(Zb, h, base, dil, lane, k0, v0); }
#pragma unroll 1
    for (int st = 0; st + 1 < NST; st += 2) { int b0, d0, w0, b1, d1, w1, b2, d2, w2; att_seg(PASSB, t0, st, b0, d0, w0); att_seg(PASSB, t0, st + 1, b1, d1, w1); att_seg(PASSB, t0, st + 2 < NST ? st + 2 : st + 1, b2, d2, w2);
        attn_step(A, Zb, h, tq, b0, d0, w0, b1, d1, lane, vt, trb, qf, k0, v0, k1, v1); attn_step(A, Zb, h, tq, b1, d1, w1, b2, d2, lane, vt, trb, qf, k1, v1, k0, v0); }
    { int b0, d0, w0; att_seg(PASSB, t0, NST - 1, b0, d0, w0); attn_step(A, Zb, h, tq, b0, d0, w0, b0, d0, lane, vt, trb, qf, k0, v0, k1, v1); }
    float lrun = A.lrun; lrun += SHX(lrun, 16); lrun += SHX(lrun, 32);
    if (PASSB) { const float inv = fast_rcp(lrun); bf16_t* op = MIXb + (size_t)tq * D + h * DH + 4 * g;
#pragma unroll
        for (int d = 0; d < 8; ++d) { u32x2 w; w.x = cvt_pk_bf16(A.o[d][0] * inv, A.o[d][1] * inv); w.y = cvt_pk_bf16(A.o[d][2] * inv, A.o[d][3] * inv); *(u32x2*)(op + 16 * d) = w; }
    } else {
#pragma unroll
        for (int d = 0; d < 8; ++d) *(f32x4*)(pb + 16 * d + 4 * g) = A.o[d];
        if (g == 0) { pb[128] = A.mrun; pb[129] = lrun; } }
}
__device__ __forceinline__ void attn_block(Frame& F, const bf16_t* Z, bf16_t* MIX, int item) {
    const int blk = item & 15, h = (item >> 4) & 7, b = item >> 7; const int w = F.wave;
    const bf16_t* Zb = Z + (size_t)b * SEQ * N_AB; bf16_t* MIXb = MIX + (size_t)b * SEQ * D; float* PB = (float*)(F.ws + WS_LG + MiB) + (size_t)item * 256 * ATT_PLD;
    MK_LAS unsigned char* vt = F.lds + w * (32 * ATT_VSTRIDE);
    attn_tile<false>(F, Zb, MIXb, PB, h, 256 * blk, 2 * w, vt); attn_tile<false>(F, Zb, MIXb, PB, h, 256 * blk, 2 * w + 1, vt);
    VM_WAIT(); __syncthreads();
    attn_tile<true>(F, Zb, MIXb, PB, h, 256 * blk, 2 * w, vt); attn_tile<true>(F, Zb, MIXb, PB, h, 256 * blk, 2 * w + 1, vt);
}

__device__ __forceinline__ void sattn_item(Frame& F, int i, int item) {
    const int lane = F.lane, li = lane & 15, g = lane >> 4; const int h = item & 7, t = (item >> 3) & 7, b = item >> 6; const int row = b * 8 + t;
    const float* zs = (const float*)(F.ws + WS_ZS); const float* cache = F.in[I_KV] + (size_t)(i * SB + b) * LA * 2 * WA; const float* kvn = F.out + O_KVS + (size_t)(i * SB + b) * ST * 2 * WA;
    float q[8]; { const f32x4 a = *(const f32x4*)(zs + (size_t)row * N_CD + h * DH + 8 * li), c = *(const f32x4*)(zs + (size_t)row * N_CD + h * DH + 8 * li + 4);
#pragma unroll
        for (int j = 0; j < 4; ++j) { q[j] = a[j]; q[4 + j] = c[j]; } }
    float m = -1e30f, l = 0.f, acc[8];
#pragma unroll
    for (int j = 0; j < 8; ++j) acc[j] = 0.f;
    const float sc = 0.08838834764831845f;
    for (int kb = g; kb < 3 * 129; kb += 16) {
        f32x4 kq[4][2], vq[4][2]; bool ok[4];
#pragma unroll
        for (int u = 0; u < 4; ++u) { const int kk = kb + 4 * u; ok[u] = kk < 3 * 129; const int k2 = ok[u] ? kk : 0; const int grp = k2 / 129, j = k2 - grp * 129; const int dil = grp == 0 ? 1 : (grp == 1 ? 4 : 16); const int idx = LA + t - dil * j;
            const float* kp = (idx < LA) ? cache + ((size_t)idx * 2) * WA + h * DH + 8 * li : kvn + ((size_t)(idx - LA) * 2) * WA + h * DH + 8 * li;
            kq[u][0] = *(const f32x4*)kp; kq[u][1] = *(const f32x4*)(kp + 4); vq[u][0] = *(const f32x4*)(kp + WA); vq[u][1] = *(const f32x4*)(kp + WA + 4); }
#pragma unroll
        for (int u = 0; u < 4; ++u) { const f32x4 k0 = kq[u][0], k1 = kq[u][1], v0 = vq[u][0], v1 = vq[u][1];
            float s = (q[0] * k0[0] + q[1] * k0[1]) + (q[2] * k0[2] + q[3] * k0[3]) + (q[4] * k1[0] + q[5] * k1[1]) + (q[6] * k1[2] + q[7] * k1[3]);
            s += SHX(s, 1); s += SHX(s, 2); s += SHX(s, 4); s += SHX(s, 8); s *= sc;
            if (ok[u]) { const float mn = fmaxf(m, s), al = fast_exp(m - mn), pw = fast_exp(s - mn); l = l * al + pw; m = mn;
#pragma unroll
                for (int jj = 0; jj < 4; ++jj) { acc[jj] = acc[jj] * al + pw * v0[jj]; acc[4 + jj] = acc[4 + jj] * al + pw * v1[jj]; } } } }
    float mm = fmaxf(m, SHX(m, 16)); mm = fmaxf(mm, SHX(mm, 32)); const float f = fast_exp(m - mm); l *= f; l += SHX(l, 16); l += SHX(l, 32);
#pragma unroll
    for (int j = 0; j < 8; ++j) { acc[j] *= f; acc[j] += SHX(acc[j], 16); acc[j] += SHX(acc[j], 32); }
    if (g == 0) { const float inv = fast_rcp(l); u32x4 w; w.x = pk2(acc[0] * inv, acc[1] * inv); w.y = pk2(acc[2] * inv, acc[3] * inv); w.z = pk2(acc[4] * inv, acc[5] * inv); w.w = pk2(acc[6] * inv, acc[7] * inv);
        *(u32x4*)((bf16_t*)(F.ws + WS_MIX) + (size_t)(MP + row) * D + h * DH + 8 * li) = w; }
}

constexpr int LRU_SEG = 256, LRU_NSEG = SEQ / LRU_SEG;
__device__ __forceinline__ void lru_unit(Frame& F, int i, int unit, const bf16_t* Z, bf16_t* MIX) {
    const int seg = unit & 15, hB = (unit >> 4) & 7, b = unit >> 7; const int tid = F.tid, lane = F.lane, w = F.wave, fr = lane & 15, g = lane >> 4;
    MK_LAS float* xc = (MK_LAS float*)F.lds; constexpr int LDX = 132;
    const int ch0 = hB * 128; const int c = ch0 + 16 * w + fr;
    bf16_t* CB = (bf16_t*)(F.ws + WS_SC); float* SUM = (float*)(F.ws + WS_LG);
    const bf16_t* Wl = (const bf16_t*)(F.ws + WS_WLRU) + (size_t)((i * 8 + hB) * 2) * 128 * 128;
    bf16x8 wf[2][4];
#pragma unroll
    for (int gt = 0; gt < 2; ++gt)
#pragma unroll
        for (int s = 0; s < 4; ++s) wf[gt][s] = *(const bf16x8*)(Wl + ((size_t)gt * 128 + 16 * w + fr) * 128 + 32 * s + 8 * g);
    const float ba = F.in[I_LBA][i * WB + c], bx = F.in[I_LBX][i * WB + c]; const float lam = F.in[I_LLAM][i * WB + c];
    const float dk = -8.0f * softplus_acc(-lam);
    const int sc8 = 8 * (tid & 15), stl = tid >> 4;
    float cwv[4][8], cbv[8];
#pragma unroll
    for (int j = 0; j < 8; ++j) { cbv[j] = F.in[I_LCB][i * WB + ch0 + sc8 + j];
#pragma unroll
        for (int tp = 0; tp < 4; ++tp) cwv[tp][j] = F.in[I_LCW][((size_t)i * 4 + tp) * WB + ch0 + sc8 + j]; }
    float hcar = 0.f, pcar = 1.f;
    const bf16_t* Zb = Z + (size_t)b * SEQ * N_AB;
    for (int ck = 0; ck < LRU_SEG / 128; ++ck) { const int tb = seg * LRU_SEG + 128 * ck;
#pragma unroll
        for (int ps = 0; ps < 4; ++ps) { const int tl = stl + 32 * ps, t = tb + tl; float a[8];
#pragma unroll
            for (int j = 0; j < 8; ++j) a[j] = cbv[j];
#pragma unroll
            for (int tp = 0; tp < 4; ++tp) { const int tt = t - 3 + tp; if (tt >= 0) { const u32x4 v = *(const u32x4*)(Zb + (size_t)tt * N_AB + 3 * WA + ch0 + sc8);
                    a[0] += cwv[tp][0] * bflo(v.x); a[1] += cwv[tp][1] * bfhi(v.x); a[2] += cwv[tp][2] * bflo(v.y); a[3] += cwv[tp][3] * bfhi(v.y);
                    a[4] += cwv[tp][4] * bflo(v.z); a[5] += cwv[tp][5] * bfhi(v.z); a[6] += cwv[tp][6] * bflo(v.w); a[7] += cwv[tp][7] * bfhi(v.w); } }
            *(MK_LAS f32x4*)(xc + tl * LDX + sc8) = (f32x4){a[0], a[1], a[2], a[3]}; *(MK_LAS f32x4*)(xc + tl * LDX + sc8 + 4) = (f32x4){a[4], a[5], a[6], a[7]}; }
        LDS_WAIT(); __syncthreads();
#pragma unroll 2
        for (int mt = 0; mt < 8; ++mt) {
            float gbv[4];
#pragma unroll
            for (int e = 0; e < 4; ++e) gbv[e] = bf2f(Zb[(size_t)(tb + 16 * mt + 4 * g + e) * N_AB + 3 * WA + WB + c]);
            f32x4 cr = (f32x4){0.f, 0.f, 0.f, 0.f}, ci = (f32x4){0.f, 0.f, 0.f, 0.f};
#pragma unroll
            for (int s = 0; s < 4; ++s) { const MK_LAS float* xp = xc + (16 * mt + fr) * LDX + 32 * s + 8 * g; const f32x4 x0 = *(const MK_LAS f32x4*)xp, x1 = *(const MK_LAS f32x4*)(xp + 4);
                union { bf16x8 v; unsigned u[4]; } af; af.u[0] = cvt_pk_bf16(x0[0], x0[1]); af.u[1] = cvt_pk_bf16(x0[2], x0[3]); af.u[2] = cvt_pk_bf16(x1[0], x1[1]); af.u[3] = cvt_pk_bf16(x1[2], x1[3]);
                cr = __builtin_amdgcn_mfma_f32_16x16x32_bf16(af.v, wf[0][s], cr, 0, 0, 0); ci = __builtin_amdgcn_mfma_f32_16x16x32_bf16(af.v, wf[1][s], ci, 0, 0, 0); }
            float P[4], H[4]; float pa = 1.f, hh = 0.f;
#pragma unroll
            for (int e = 0; e < 4; ++e) { const float r = sigmoid_f(cr[e] + ba), ig = sigmoid_f(ci[e] + bx); const float la = dk * r; const float a = fast_exp(la);
                const float xv = xc[(16 * mt + 4 * g + e) * LDX + 16 * w + fr]; const float u = fast_sqrt(one_minus_exp(2.0f * la)) * ig * xv;
                pa = pa * a; hh = a * hh + u; P[e] = pa; H[e] = hh; }
            float ip = pa, ih = hh;
            { const float pp = SHUP(ip, 16), ph = SHUP(ih, 16); if (g >= 1) { ih = ip * ph + ih; ip = ip * pp; } }
            { const float pp = SHUP(ip, 32), ph = SHUP(ih, 32); if (g >= 2) { ih = ip * ph + ih; ip = ip * pp; } }
            float ep = SHUP(ip, 16), eh = SHUP(ih, 16); if (g == 0) { ep = 1.f; eh = 0.f; }
            const float hin = ep * hcar + eh;
            const float pin = pcar * ep;
            const float tot_p = SHL(ip, 48 + fr), tot_h = SHL(ih, 48 + fr);
            hcar = tot_p * hcar + tot_h; pcar = pcar * tot_p;
#pragma unroll
            for (int e = 0; e < 4; ++e) { const float hv = P[e] * hin + H[e]; const size_t row = (size_t)b * SEQ + tb + 16 * mt + 4 * g + e; const float ge = gelu_tanh_f(gbv[e]);
                MIX[row * D + WA + c] = (bf16_t)f2bf(hv * ge); CB[row * WB + c] = (bf16_t)f2bf(pin * P[e] * ge); }
        }
        __syncthreads();
    }
    if (g == 0) { float* sp = SUM + ((size_t)((b * 8 + hB) * LRU_NSEG + seg) * 2) * 128 + 16 * w + fr; sp[0] = pcar; sp[128] = hcar; }
}
__device__ __forceinline__ void lru_fix_item(Frame& F, int i, int item) {
    const int tid = F.tid; MK_LAS float* hin = (MK_LAS float*)F.lds;
    const float* SUM = (const float*)(F.ws + WS_LG); const bf16_t* CB = (const bf16_t*)(F.ws + WS_SC); bf16_t* MIX = (bf16_t*)(F.ws + WS_MIX);
    int b, seg, sub; if (item < 240) { b = item / 120; const int r = item % 120; seg = 1 + r / 8; sub = r % 8; } else { b = item - 240; seg = LRU_NSEG; sub = 0; }
    for (int c = tid; c < WB; c += 512) { const int hB = c >> 7, cc = c & 127; float h = 0.f; const float* sp = SUM + ((size_t)((b * 8 + hB) * LRU_NSEG) * 2) * 128 + cc;
        for (int s = 0; s < seg; ++s) h = sp[(size_t)s * 256] * h + sp[(size_t)s * 256 + 128];
        if (item < 240) hin[c] = h; else F.out[O_HP + ((size_t)i * NB + b) * WB + c] = h; }
    LDS_WAIT(); __syncthreads();
    if (item < 240) {
#pragma unroll
        for (int j = 0; j < 8; ++j) { const int gi = tid + 512 * j, tl = gi >> 7, c8 = (gi & 127) * 8; const size_t row = (size_t)b * SEQ + seg * LRU_SEG + 32 * sub + tl;
            const u32x4 cv = *(const u32x4*)(CB + row * WB + c8); u32x4 mv = *(const u32x4*)(MIX + row * D + WA + c8); const f32x4 h0 = *(const MK_LAS f32x4*)(hin + c8), h1 = *(const MK_LAS f32x4*)(hin + c8 + 4);
            mv.x = pk2(bflo(mv.x) + bflo(cv.x) * h0[0], bfhi(mv.x) + bfhi(cv.x) * h0[1]); mv.y = pk2(bflo(mv.y) + bflo(cv.y) * h0[2], bfhi(mv.y) + bfhi(cv.y) * h0[3]);
            mv.z = pk2(bflo(mv.z) + bflo(cv.z) * h1[0], bfhi(mv.z) + bfhi(cv.z) * h1[1]); mv.w = pk2(bflo(mv.w) + bflo(cv.w) * h1[2], bfhi(mv.w) + bfhi(cv.w) * h1[3]);
            *(u32x4*)(MIX + row * D + WA + c8) = mv; } }
    __syncthreads();
}
__device__ __forceinline__ void slru_unit(Frame& F, int i, int unit) {
    const int b = unit >> 3, hB = unit & 7, tid = F.tid; const float* zs = (const float*)(F.ws + WS_ZS);
    MK_LAS float* xc = (MK_LAS float*)F.lds;
    MK_LAS float* gr = xc + 1024;
    MK_LAS float* gi = gr + 1024;
    const int ch0 = hB * 128;
    for (int e = tid; e < 1024; e += 512) { const int cc = e & 127, t = e >> 7; const int c = ch0 + cc; float y = F.in[I_LCB][i * WB + c];
#pragma unroll
        for (int tp = 0; tp < 4; ++tp) { const int tt = t - 3 + tp; const float v = (tt >= 0) ? zs[(size_t)(b * 8 + tt) * N_CD + 3 * WA + c] : F.in[I_SCONV][(((size_t)i * SB + b) * 3 + (tt + 3)) * WB + c];
            y += F.in[I_LCW][((size_t)i * 4 + tp) * WB + c] * v; }
        xc[t * 128 + cc] = y; }
    __syncthreads();
    for (int e = tid; e < 2048; e += 512) { const int cc = e & 127, t = (e >> 7) & 7, gate = e >> 10; const float* W = F.in[gate ? I_LWX : I_LWA] + (size_t)(i * 8 + hB) * 128 * 128; float s = 0.f;
        for (int k = 0; k < 128; ++k) s += xc[t * 128 + k] * W[(size_t)k * 128 + cc];
        const int c = ch0 + cc; s += F.in[gate ? I_LBX : I_LBA][i * WB + c]; (gate ? gi : gr)[t * 128 + cc] = sigmoid_f(s); }
    __syncthreads();
    if (tid < 128) { const int cc = tid, c = ch0 + cc; const float lam = F.in[I_LLAM][i * WB + c]; const float spl = softplus_acc(-lam);
        float h = F.in[I_SH][((size_t)i * SB + b) * WB + c];
        for (int t = 0; t < 8; ++t) { const float la = -8.0f * gr[t * 128 + cc] * spl, a = fast_exp(la); const float u = fast_sqrt(one_minus_exp(2.0f * la)) * gi[t * 128 + cc] * xc[t * 128 + cc];
            h = a * h + u; const float gb = zs[(size_t)(b * 8 + t) * N_CD + 3 * WA + WB + c];
            const float ge = gelu_tanh_f(gb);
            ((bf16_t*)(F.ws + WS_MIX))[(size_t)(MP + b * 8 + t) * D + WA + c] = (bf16_t)f2bf(h * ge); }
        F.out[O_HS + ((size_t)i * SB + b) * WB + c] = h; }
    __syncthreads();
}

template <int WHAT  > __device__ __forceinline__ void mixer_ab(Frame& F0, int i, int qid) {
    const bf16_t* Z = (const bf16_t*)(F0.ws + WS_Z); bf16_t* MIX = (bf16_t*)(F0.ws + WS_MIX);
    constexpr int N_LRU = 256, N_SLRU = 64, N_SATT = 64, N_ATT = 256, N_ALL = N_LRU + N_SLRU + N_SATT + N_ATT;
    for (;;) { const int u = q_next(F0, qid); if (u >= N_ALL) break;
        Frame F = F0; F.tid = opaque_tid(F0.wave); F.lane = F.tid & 63;
        if (WHAT == 1 && u < N_LRU + N_SLRU + N_SATT) continue; if (WHAT == 2 && u >= N_LRU) break;
        if (u < N_LRU) lru_unit(F, i, u, Z, MIX);
        else if (u < N_LRU + N_SLRU) slru_unit(F, i, u - N_LRU);
        else if (u < N_LRU + N_SLRU + N_SATT) sattn_item(F, i, (u - N_LRU - N_SLRU) * 8 + F.wave);
        else attn_block(F, Z, MIX, u - N_LRU - N_SLRU - N_SATT); }
}
__device__ __forceinline__ void mixer_ab_fix(Frame& F, int i, int qid) { (void)qid; for (int u = F.vcu; u < 242; u += F.G) lru_fix_item(F, i, u); }
}
namespace mk {
struct GlaCfg { int H, V, qcol, kcol, vcol, gcol, lgld, mixcol; const float* lg; const float* gain; bf16_t* sc; };
__device__ __forceinline__ GlaCfg gla_cfg(Frame& F, int i, int kind) {
    GlaCfg c;
    if (kind == 0) { c.H = HC; c.V = DVC; c.qcol = ZC_QC; c.kcol = ZC_KC; c.vcol = ZC_IC; c.gcol = ZC_GC; c.lgld = 1024; c.mixcol = 0; c.lg = (const float*)(F.ws + WS_LG); c.gain = F.in[I_HGN] + i * DVC; c.sc = (bf16_t*)(F.ws + WS_SC); }
    else { c.H = HD_; c.V = DVD; c.qcol = ZC_QD; c.kcol = ZC_KD; c.vcol = ZC_VD; c.gcol = ZC_RD; c.lgld = 512; c.mixcol = 1024; c.lg = (const float*)(F.ws + WS_LG) + (size_t)MP * 1024; c.gain = F.in[I_GLN] + i * DVD; c.sc = (bf16_t*)(F.ws + WS_SC) + (size_t)NB * HC * NCHUNK * DVC * 128; }
    return c;
}
__device__ __forceinline__ void x2_unit(Frame& F, int i, int unit) {
    const int kind = unit >> 7; const int u = unit & 127; const GlaCfg c = gla_cfg(F, i, kind);
    const int nvs = c.V / 16; const int vs = u % nvs, hd = (u / nvs) % c.H, b = u / (nvs * c.H);
    const int lane = F.lane, w = F.wave, fr = lane & 15, g = lane >> 4;
    const bf16_t* Z = (const bf16_t*)(F.ws + WS_Z) + (size_t)b * SEQ * N_CDZ; const float* LG = c.lg + (size_t)b * SEQ * c.lgld + hd * 128 + 16 * w + fr;
    const bf16_t* Kp = Z + c.kcol + hd * 128 + 16 * w + fr; const bf16_t* Vp = Z + c.vcol + hd * c.V + 16 * vs + fr;
    bf16_t* SCp = c.sc + ((size_t)(b * c.H + hd) * NCHUNK) * c.V * 128 + (size_t)(16 * vs + fr) * 128 + 16 * w + 4 * g;
    f32x4 S = (f32x4){0.f, 0.f, 0.f, 0.f};
    float nlg[2][8]; unsigned short nkv[2][8], nvv[2][8];
#pragma unroll
    for (int ks = 0; ks < 2; ++ks)
#pragma unroll
        for (int j = 0; j < 8; ++j) { const size_t t = 32 * ks + 8 * g + j; nlg[ks][j] = LG[t * c.lgld]; nkv[ks][j] = Kp[t * N_CDZ]; nvv[ks][j] = Vp[t * N_CDZ]; }
#pragma unroll 1
    for (int ck = 0; ck < NCHUNK; ++ck) {
        float lg[2][8]; unsigned short kv[2][8], vv[2][8];
#pragma unroll
        for (int ks = 0; ks < 2; ++ks)
#pragma unroll
            for (int j = 0; j < 8; ++j) { lg[ks][j] = nlg[ks][j]; kv[ks][j] = nkv[ks][j]; vv[ks][j] = nvv[ks][j]; }
        if (ck + 1 < NCHUNK) { const size_t t0 = 64 * (ck + 1) + 8 * g;
            auto pl = launder(LG + t0 * c.lgld); auto pk = launder(Kp + t0 * N_CDZ); auto pv = launder(Vp + t0 * N_CDZ);
#pragma unroll
            for (int ks = 0; ks < 2; ++ks) {
#pragma unroll
                for (int j = 0; j < 8; ++j) { nlg[ks][j] = pl[(size_t)j * c.lgld]; nkv[ks][j] = pk[(size_t)j * N_CDZ]; nvv[ks][j] = pv[(size_t)j * N_CDZ]; }
                pl = launder(pl + (size_t)32 * c.lgld); pk = launder(pk + (size_t)32 * N_CDZ); pv = launder(pv + (size_t)32 * N_CDZ); } }
        { u32x2 wv; wv.x = cvt_pk_bf16(S[0], S[1]); wv.y = cvt_pk_bf16(S[2], S[3]); *(u32x2*)(SCp + (size_t)ck * c.V * 128) = wv; }
        float tot[2];
#pragma unroll
        for (int ks = 0; ks < 2; ++ks) {
#pragma unroll
            for (int j = 1; j < 8; ++j) lg[ks][j] += lg[ks][j - 1];
            float inc = lg[ks][7];
            { const float p = SHUP(inc, 16); if (g >= 1) inc += p; }
            { const float p = SHUP(inc, 32); if (g >= 2) inc += p; }
            float ex = SHUP(inc, 16); if (g == 0) ex = 0.f;
            tot[ks] = SHL(inc, 48 + fr);
#pragma unroll
            for (int j = 0; j < 8; ++j) lg[ks][j] += ex + (ks ? tot[0] : 0.f);
        }
        const float blast = tot[0] + tot[1];
        union { bf16x8 v; unsigned u[4]; } af[2], bf[2];
#pragma unroll
        for (int ks = 0; ks < 2; ++ks) { float kd[8];
#pragma unroll
            for (int j = 0; j < 8; ++j) kd[j] = bf2f(kv[ks][j]) * fast_exp(blast - lg[ks][j]);
#pragma unroll
            for (int j = 0; j < 4; ++j) { af[ks].u[j] = cvt_pk_bf16(kd[2 * j], kd[2 * j + 1]); bf[ks].u[j] = (unsigned)vv[ks][2 * j] | ((unsigned)vv[ks][2 * j + 1] << 16); } }
#pragma unroll
        for (int e = 0; e < 4; ++e) S[e] *= fast_exp(SHL(blast, 4 * g + e));
        S = __builtin_amdgcn_mfma_f32_16x16x32_bf16(af[0].v, bf[0].v, S, 0, 0, 0);
        S = __builtin_amdgcn_mfma_f32_16x16x32_bf16(af[1].v, bf[1].v, S, 0, 0, 0);
    }
    float* so = F.out + (kind == 0 ? O_HGP : O_GLP) + (((size_t)i * NB + b) * c.H + hd) * 128 * c.V + (size_t)(16 * w + 4 * g) * c.V + 16 * vs + fr;
#pragma unroll
    for (int e = 0; e < 4; ++e) so[(size_t)e * c.V] = S[e];
}

template <int V> __device__ __forceinline__ void scd_unit_t(Frame& F, int i, int kind, int b, int hd) {
    constexpr int KQ = 512 / V, KN = 128 / KQ;
    const int tid = F.tid; const float* zs = (const float*)(F.ws + WS_ZS);
    MK_LAS float* sq = (MK_LAS float*)F.lds;
    MK_LAS float* sk = sq + 1024;
    MK_LAS float* sl = sk + 1024;
    MK_LAS float* sv = sl + 1024;
    MK_LAS float* po = sv + 8 * V;
    MK_LAS float* rsd = po + KQ * 8 * V;
    const float* lb = (const float*)(F.ws + WS_LB) + i * 1024;
    for (int e = tid; e < 1024; e += 512) { const int k = e & 127, t = e >> 7; const float* zr = zs + (size_t)(b * 8 + t) * N_CD;
        if (kind == 0) { const float z = zr[ZC_KC + hd * 128 + k], l = lb[hd * 128 + k]; const float sg = sigmoid_f(z); sq[e] = zr[ZC_QC + hd * 128 + k]; sk[e] = (1.0f - l) * (1.0f - sg); sl[e] = l + (1.0f - l) * sg; }
        else { const float x = zr[N_CDZ + hd * 128 + k] + F.in[I_BG][i * 512 + hd * 128 + k]; const float ls = fminf(x, 0.f) - fast_ln(1.0f + fast_exp(-fabsf(x))); sq[e] = zr[ZC_QD + hd * 128 + k] * 0.08838834764831845f; sk[e] = zr[ZC_KD + hd * 128 + k]; sl[e] = fast_exp(ls * 0.0625f); } }
    for (int e = tid; e < 8 * V; e += 512) { const int v = e % V, t = e / V; sv[e] = zs[(size_t)(b * 8 + t) * N_CD + (kind == 0 ? ZC_IC : ZC_VD) + hd * V + v]; }
    __syncthreads();
    const int v = tid % V, kq = tid / V; const float* s0 = F.in[kind == 0 ? I_SHG : I_SGL] + ((((size_t)i * SB + b) * (kind == 0 ? HC : HD_) + hd) * 128) * V;
    float S[KN];
    { auto sp = launder(s0 + (size_t)(kq * KN) * V + v);
#pragma unroll
      for (int kk = 0; kk < KN; ++kk) { S[kk] = *sp; sp = launder(sp + V); } }
    for (int t = 0; t < 8; ++t) { const float vt = sv[t * V + v]; float acc = 0.f;
#pragma unroll
        for (int kk = 0; kk < KN; ++kk) { const int k = kq * KN + kk; S[kk] = sl[t * 128 + k] * S[kk] + sk[t * 128 + k] * vt; acc += sq[t * 128 + k] * S[kk]; }
        po[(kq * 8 + t) * V + v] = acc; }
    float* so = F.out + (kind == 0 ? O_HGS : O_GLS) + ((((size_t)i * SB + b) * (kind == 0 ? HC : HD_) + hd) * 128) * V;
    { auto sp = launder(so + (size_t)(kq * KN) * V + v);
#pragma unroll
      for (int kk = 0; kk < KN; ++kk) { *sp = S[kk]; sp = launder(sp + V); } }
    __syncthreads();
    for (int e = tid; e < 8 * V; e += 512) { float a = 0.f;
#pragma unroll
        for (int q = 0; q < KQ; ++q) a += po[q * 8 * V + e];
        po[e] = a; }
    __syncthreads();
    if (tid < 8) { float s = 0.f; for (int vv = 0; vv < V; ++vv) s += po[tid * V + vv] * po[tid * V + vv]; rsd[tid] = fast_rsq(s * (1.0f / V) + EPS); }
    __syncthreads();
    const float* gain = F.in[kind == 0 ? I_HGN : I_GLN] + i * V;
    for (int e = tid; e < 8 * V; e += 512) { const int vv = e % V, t = e / V; const float gt = zs[(size_t)(b * 8 + t) * N_CD + (kind == 0 ? ZC_GC : ZC_RD) + hd * V + vv];
        const float y = po[e] * rsd[t] * gain[vv] * silu_f(gt);
        ((bf16_t*)(F.ws + WS_MIX))[(size_t)(MP + b * 8 + t) * D + (kind == 0 ? 0 : 1024) + hd * V + vv] = (bf16_t)f2bf(y); }
    __syncthreads();
}
__device__ __forceinline__ void scd_unit(Frame& F, int i, int unit) {
    if (unit < 64) scd_unit_t<DVC>(F, i, 0, unit >> 3, unit & 7); else { const int u = unit - 64; scd_unit_t<DVD>(F, i, 1, u >> 2, u & 3); }
}

template <int V> __device__ __forceinline__ void x3_unit_t(Frame& F, const GlaCfg& c, int b, int hd, int ck) {
    constexpr int LDQ = 272, LDV = 2 * V + 32, LDA = 144;
    constexpr int NT = V / 32;
    MK_LAS unsigned char* QE = F.lds; MK_LAS unsigned char* QH = QE + 64 * LDQ; MK_LAS unsigned char* KH = QH + 64 * LDQ; MK_LAS unsigned char* VT = KH + 64 * LDQ;
    MK_LAS unsigned char* AM = VT + 64 * LDV; MK_LAS float* QT = (MK_LAS float*)(AM + 64 * LDA);
    MK_LAS float* SS = QT + 512;
    const int tid = F.tid, lane = F.lane, w = F.wave, fr = lane & 15, g = lane >> 4; const int tb = 64 * ck;
    const bf16_t* Z = (const bf16_t*)(F.ws + WS_Z) + ((size_t)b * SEQ + tb) * N_CDZ; const float* LG = c.lg + ((size_t)b * SEQ + tb) * c.lgld + hd * 128;
    { const int ch = tid & 127, tq = tid >> 7; float cum[16]; float run = 0.f;
        { auto pl = launder(LG + (size_t)(16 * tq) * c.lgld + ch);
#pragma unroll
          for (int j = 0; j < 16; ++j) { run += *pl; cum[j] = run; pl = launder(pl + c.lgld); } }
        QT[tq * 128 + ch] = run;
        unsigned short qv[16], kv[16];
        { auto pq = launder(Z + (size_t)(16 * tq) * N_CDZ + c.qcol + hd * 128 + ch); const int kdelta = c.kcol - c.qcol;
#pragma unroll
          for (int j = 0; j < 16; ++j) { qv[j] = pq[0]; kv[j] = pq[kdelta]; pq = launder(pq + N_CDZ); } }
        LDS_WAIT(); __syncthreads();
        const float q0 = QT[ch], q1 = QT[128 + ch], q2 = QT[256 + ch]; const float off = tq == 0 ? 0.f : (tq == 1 ? q0 : (tq == 2 ? q0 + q1 : q0 + q1 + q2)); const float bmid = q0 + q1;
#pragma unroll
        for (int j = 0; j < 16; ++j) { const float bb = cum[j] + off; const float qf = bf2f(qv[j]), kf = bf2f(kv[j]); const int t = 16 * tq + j;
            *(MK_LAS unsigned short*)(QE + t * LDQ + 2 * ch) = (unsigned short)f2bf(qf * fast_exp(bb));
            *(MK_LAS unsigned short*)(QH + t * LDQ + 2 * ch) = (unsigned short)f2bf(qf * fast_exp(fminf(bb - bmid, 80.f)));
            *(MK_LAS unsigned short*)(KH + t * LDQ + 2 * ch) = (unsigned short)f2bf(kf * fast_exp(fminf(bmid - bb, 80.f))); }
        constexpr int CPR = V / 8;
        for (int e = tid; e < 64 * CPR; e += 512) { const int t = e / CPR, chk = e % CPR; *(MK_LAS u32x4*)(VT + t * LDV + 16 * chk) = *(const u32x4*)(Z + (size_t)t * N_CDZ + c.vcol + hd * V + 8 * chk); }
    }
    LDS_WAIT(); __syncthreads();
    { const int ti = w >> 1;
#pragma unroll
        for (int jj = 0; jj < 2; ++jj) { const int sj = 2 * (w & 1) + jj; f32x4 a = (f32x4){0.f, 0.f, 0.f, 0.f};
            if (sj <= ti) {
#pragma unroll
                for (int ks = 0; ks < 4; ++ks) { const bf16x8 qa = *(const MK_LAS bf16x8*)(QH + (16 * ti + fr) * LDQ + 64 * ks + 16 * g), kb = *(const MK_LAS bf16x8*)(KH + (16 * sj + fr) * LDQ + 64 * ks + 16 * g);
                    a = __builtin_amdgcn_mfma_f32_16x16x32_bf16(qa, kb, a, 0, 0, 0); } }
#pragma unroll
            for (int e = 0; e < 4; ++e) { const int t = 16 * ti + 4 * g + e, s = 16 * sj + fr; *(MK_LAS unsigned short*)(AM + t * LDA + 2 * s) = (unsigned short)f2bf(s <= t ? a[e] : 0.f); } } }
    LDS_WAIT(); __syncthreads();
    const int mt = w & 3, vh = w >> 2; f32x4 o[NT];
#pragma unroll
    for (int n = 0; n < NT; ++n) o[n] = (f32x4){0.f, 0.f, 0.f, 0.f};
    const unsigned vtb = (unsigned)(size_t)VT; const int q4 = fr >> 2, p4 = fr & 3;
#pragma unroll
    for (int ks = 0; ks < 2; ++ks) { if (32 * ks <= 16 * mt + 15) { const bf16x8 aa = *(const MK_LAS bf16x8*)(AM + (16 * mt + fr) * LDA + 64 * ks + 16 * g);
#pragma unroll
            for (int n = 0; n < NT; ++n) { const int vc = (V / 2) * vh + 16 * n; const unsigned a0 = vtb + (32 * ks + 8 * g + q4) * LDV + (vc + 4 * p4) * 2, a1 = a0 + 4 * LDV;
                union { bf16x8 v; s16x4 h[2]; } vf; vf.h[0] = tr_read4(a0); vf.h[1] = tr_read4(a1);
                o[n] = __builtin_amdgcn_mfma_f32_16x16x32_bf16(aa, vf.v, o[n], 0, 0, 0); } } }
    { const bf16_t* SCp = c.sc + (((size_t)(b * c.H + hd) * NCHUNK + ck) * V) * 128;
#pragma unroll
        for (int ks = 0; ks < 4; ++ks) { const bf16x8 qa = *(const MK_LAS bf16x8*)(QE + (16 * mt + fr) * LDQ + 64 * ks + 16 * g);
#pragma unroll
            for (int n = 0; n < NT; ++n) { const int vc = (V / 2) * vh + 16 * n + fr; const bf16x8 sb = *(const bf16x8*)(SCp + (size_t)vc * 128 + 32 * ks + 8 * g);
                o[n] = __builtin_amdgcn_mfma_f32_16x16x32_bf16(qa, sb, o[n], 0, 0, 0); } } }
    float ss[4];
#pragma unroll
    for (int e = 0; e < 4; ++e) { float s = 0.f;
#pragma unroll
        for (int n = 0; n < NT; ++n) s += o[n][e] * o[n][e];
        s += SHX(s, 1); s += SHX(s, 2); s += SHX(s, 4); s += SHX(s, 8); ss[e] = s; }
    if (fr == 0) {
#pragma unroll
        for (int e = 0; e < 4; ++e) SS[vh * 64 + 16 * mt + 4 * g + e] = ss[e]; }
    LDS_WAIT(); __syncthreads();
    bf16_t* MIX = (bf16_t*)(F.ws + WS_MIX) + ((size_t)b * SEQ + tb) * D + c.mixcol + hd * V;
#pragma unroll
    for (int e = 0; e < 4; ++e) { const int t = 16 * mt + 4 * g + e; const float rs = fast_rsq((SS[t] + SS[64 + t]) * (1.0f / V) + EPS);
#pragma unroll
        for (int n = 0; n < NT; ++n) { const int vc = (V / 2) * vh + 16 * n + fr; const float gt = bf2f(Z[(size_t)t * N_CDZ + c.gcol + hd * V + vc]);
            MIX[(size_t)t * D + vc] = (bf16_t)f2bf(o[n][e] * rs * c.gain[vc] * silu_f(gt)); } }
    __syncthreads();
}
__device__ __forceinline__ void x3_unit(Frame& F, int i, int unit) {
    if (unit < NB * HC * NCHUNK) { const GlaCfg c = gla_cfg(F, i, 0); x3_unit_t<DVC>(F, c, unit / (HC * NCHUNK), (unit / NCHUNK) % HC, unit % NCHUNK); }
    else { const int u = unit - NB * HC * NCHUNK; const GlaCfg c = gla_cfg(F, i, 1); x3_unit_t<DVD>(F, c, u / (HD_ * NCHUNK), (u / NCHUNK) % HD_, u % NCHUNK); }
}
__device__ __forceinline__ void mixer_cd_x2(Frame& F0, int i, int qid) {
    for (;;) { const int u = q_next(F0, qid); if (u >= 256 + 96) break; Frame F = F0; F.tid = opaque_tid(F0.wave); F.lane = F.tid & 63; if (u < 256) x2_unit(F, i, u); else scd_unit(F, i, u - 256); }
}
__device__ __forceinline__ void mixer_cd_x3(Frame& F, int i, int qid) {
    constexpr int NU = NB * HC * NCHUNK + NB * HD_ * NCHUNK;
    (void)qid; for (int u = F.vcu; u < NU; u += F.G) x3_unit(F, i, u);
}
}
namespace mk {
#define PHASE_FRAME(Fp) Frame Fp = F0; asm volatile("" : "+s"(Fp.wave)); Fp.tid = opaque_tid(Fp.wave); Fp.lane = Fp.tid & 63
__device__ __forceinline__ void ffn_part(Frame& F0, const XcdBarrier& bar, int layer, bool last) {
    { PHASE_FRAME(F); Gemm g{(const bf16_t*)(F.ws + WS_XB16), (const bf16_t*)(F.ws + WS_WUP + layer * SZ_WUP), MP, N_UP, D}; StaticOrder S; S.init(MP, N_UP, F.G, opaque_bid());
      EpiUp E{(bf16_t*)(F.ws + WS_Z), rss_ptr(F, 2 * layer + 1), F.in[I_FCW] + (size_t)layer * 3 * FF, F.in[I_FCB] + (size_t)layer * FF, (float*)(F.ws + WS_GHEAD), (float*)(F.ws + WS_GTAIL), F.out + O_FFP + (size_t)layer * NB * 2 * FF};
      gemm_phase<EpiUp>(F.lds, g, S, E, F.wave);
#if MK_PROBE == 9
      gemm_phase<EpiUp>(F.lds, g, S, E, F.wave);
#elif MK_PROBE == 19
      xcd_barrier(bar, F0.wave); gemm_phase<EpiUp>(F.lds, g, S, E, F.wave);
#endif
    }
    { PHASE_FRAME(F); const bf16_t* Bt = (const bf16_t*)(F.ws + WS_WUP + layer * SZ_WUP);
      sample_plain(F, Bt, rss_sptr(F, 2 * layer + 1), N_UP, 32 * (N_UP / 256), (float*)(F.ws + WS_GUS), N_UP, true); }
    xcd_barrier(bar, F0.wave);
    { PHASE_FRAME(F); ffn_fixup(F, layer); }
#if MK_PROBE == 10
    xcd_barrier(bar, F0.wave); { PHASE_FRAME(F); ffn_fixup(F, layer); }
#endif
    xcd_barrier(bar, F0.wave);
    { PHASE_FRAME(F); Gemm g{(const bf16_t*)(F.ws + WS_Z), (const bf16_t*)(F.ws + WS_WDN + layer * SZ_WDN), MP, D, FF}; StaticOrder S; S.init(MP, D, F.G, opaque_bid());
      EpiRes E{(bf16_t*)(F.ws + WS_XB16), last ? F.out + O_YP : nullptr, rss_ptr(F, 2 * layer + 2)};
      gemm_phase<EpiRes>(F.lds, g, S, E, F.wave);
#if MK_PROBE == 12
      { EpiRes E2{(bf16_t*)(F.ws + WS_LG), nullptr, (float*)(F.ws + WS_LG + 104 * MiB)}; gemm_phase<EpiRes>(F.lds, g, S, E2, F.wave); }
#endif
    }
    { PHASE_FRAME(F); const bf16_t* Bt = (const bf16_t*)(F.ws + WS_WDN + layer * SZ_WDN);
      sample_res(F, (const bf16_t*)(F.ws + WS_Z) + (size_t)MP * FF, Bt, FF, last ? F.out + O_YS : nullptr, rss_sptr(F, 2 * layer + 2)); }
    xcd_barrier(bar, F0.wave);
}
__device__ __forceinline__ void out_part(Frame& F0, const XcdBarrier& bar, int layer, const bf16_t* Wt) {
    PHASE_FRAME(F);
    Gemm g{(const bf16_t*)(F.ws + WS_MIX), Wt, MP, D, D}; StaticOrder S; S.init(MP, D, F.G, opaque_bid());
    EpiRes E{(bf16_t*)(F.ws + WS_XB16), nullptr, rss_ptr(F, 2 * layer + 1)};
    gemm_phase<EpiRes>(F.lds, g, S, E, F.wave);
#if MK_PROBE == 11
    { EpiRes E2{(bf16_t*)(F.ws + WS_LG), nullptr, (float*)(F.ws + WS_LG + 104 * MiB)}; gemm_phase<EpiRes>(F.lds, g, S, E2, F.wave); }
#endif
    { PHASE_FRAME(F2); sample_res(F2, (const bf16_t*)(F2.ws + WS_MIX) + (size_t)MP * D, Wt, D, nullptr, rss_sptr(F2, 2 * layer + 1)); }
    xcd_barrier(bar, F0.wave);
}

__global__ void __launch_bounds__(512, 2) mega_fwd(Args args) {
    extern __shared__ __attribute__((aligned(16))) unsigned char lds_raw[];
    Frame F0; Frame& F = F0; F.lds = (MK_LAS unsigned char*)lds_raw; F.ws = args.ws; F.out = args.out; F.in = args.in; F.ctl = (unsigned*)(args.ws + WS_CTL);
    F.wave = __builtin_amdgcn_readfirstlane((int)threadIdx.x >> 6); asm volatile("" : "+s"(F.wave));
    F.tid = opaque_tid(F.wave); F.lane = F.tid & 63;
    F.G = gridDim.x; { const int bx = opaque_bid(); F.vcu = (F.G % 8 == 0) ? (bx % 8) * (F.G / 8) + bx / 8 : bx; }
    for (int u = F.tid; u < (LDS_BYTES - MISC_OFF) / 4; u += 512) ((MK_LAS unsigned*)(F.lds + MISC_OFF))[u] = 0u;
    __syncthreads();
    const XcdBarrier bar = xcd_barrier_post(F.ctl + CW_BAR, (volatile MK_LAS unsigned*)(F.lds + MISC_OFF), F0.wave);
    p0_prologue(F);
    xcd_barrier(bar, F0.wave);
#if MK_PROBE == 7
    p0_prologue(F); xcd_barrier(bar, F0.wave);
#elif MK_PROBE == 6
    for (int r = 0; r < 32; ++r) xcd_barrier(bar, F0.wave);
#endif
    const int nl = args.nlayers;
    for (int lp = 0; lp < 2; ++lp) {
        { const int layer = 2 * lp, i = lp; if (layer >= nl) break;
          { PHASE_FRAME(F); Gemm g{(const bf16_t*)(F.ws + WS_XB16), (const bf16_t*)(F.ws + WS_WINAB + i * SZ_WINAB), MP, N_AB, D}; StaticOrder S; S.init(MP, N_AB, F.G, opaque_bid());
            EpiInAB E{(bf16_t*)(F.ws + WS_Z), rss_ptr(F, 2 * layer), F.in[I_QN] + i * DH, F.in[I_KN] + i * DH, F.out + O_KVP + (size_t)i * NB * LA * 2 * WA, F.out + O_CONVP + (size_t)i * NB * 3 * WB};
            gemm_phase<EpiInAB>(F.lds, g, S, E, F.wave);
#if MK_PROBE == 8
            gemm_phase<EpiInAB>(F.lds, g, S, E, F.wave);
#elif MK_PROBE == 18
            xcd_barrier(bar, F0.wave); gemm_phase<EpiInAB>(F.lds, g, S, E, F.wave);
#endif
          }
          { PHASE_FRAME(F); sample_in_ab(F, i, (const bf16_t*)(F.ws + WS_WINAB + i * SZ_WINAB), rss_sptr(F, 2 * layer)); }
          xcd_barrier(bar, F0.wave);
          { PHASE_FRAME(F); mixer_ab<0>(F, i, 2 * layer); }
          xcd_barrier(bar, F0.wave);
#if MK_PROBE == 21
          { PHASE_FRAME(F); mixer_ab<0>(F, i, 16 + 2 * layer); } xcd_barrier(bar, F0.wave);
#elif MK_PROBE == 22
          { PHASE_FRAME(F); mixer_ab<1>(F, i, 16 + 2 * layer); } xcd_barrier(bar, F0.wave);
#elif MK_PROBE == 23
          { PHASE_FRAME(F); mixer_ab<2>(F, i, 16 + 2 * layer); } xcd_barrier(bar, F0.wave);
#endif
          { PHASE_FRAME(F); mixer_ab_fix(F, i, 2 * layer + 1); }
          xcd_barrier(bar, F0.wave);
#if MK_PROBE == 1
          { PHASE_FRAME(F); mixer_ab<0>(F, i, 16 + 2 * layer); } xcd_barrier(bar, F0.wave);
#elif MK_PROBE == 2
          { PHASE_FRAME(F); mixer_ab<1>(F, i, 16 + 2 * layer); } xcd_barrier(bar, F0.wave);
#elif MK_PROBE == 3
          { PHASE_FRAME(F); mixer_ab<2>(F, i, 16 + 2 * layer); } xcd_barrier(bar, F0.wave);
#endif
          if (args.pad && layer == nl - 1) return;
          out_part(F0, bar, layer, (const bf16_t*)(F.ws + WS_WOUTAB + i * SZ_WOUT));
          ffn_part(F0, bar, layer, layer == nl - 1); }
        { const int layer = 2 * lp + 1, i = lp; if (layer >= nl) break;
          { PHASE_FRAME(F); Gemm g{(const bf16_t*)(F.ws + WS_XB16), (const bf16_t*)(F.ws + WS_WINCD + i * SZ_WINCD), MP, N_CD, D}; StaticOrder S; S.init(MP, N_CD, F.G, opaque_bid());
            EpiInCD E{(bf16_t*)(F.ws + WS_Z), rss_ptr(F, 2 * layer), (const float*)(F.ws + WS_LB) + i * 1024, F.in[I_BG] + i * 512, (float*)(F.ws + WS_LG), (float*)(F.ws + WS_LG) + (size_t)MP * 1024};
            gemm_phase<EpiInCD>(F.lds, g, S, E, F.wave);
#if MK_PROBE == 8
            gemm_phase<EpiInCD>(F.lds, g, S, E, F.wave);
#elif MK_PROBE == 18
            xcd_barrier(bar, F0.wave); gemm_phase<EpiInCD>(F.lds, g, S, E, F.wave);
#endif
          }
          { PHASE_FRAME(F); sample_plain(F, (const bf16_t*)(F.ws + WS_WINCD + i * SZ_WINCD), rss_sptr(F, 2 * layer), N_CD, 32 * (N_CD / 256), (float*)(F.ws + WS_ZS), N_CD, false); }
          xcd_barrier(bar, F0.wave);
          { PHASE_FRAME(F); mixer_cd_x2(F, i, 2 * layer); }
          xcd_barrier(bar, F0.wave);
#if MK_PROBE == 4
          { PHASE_FRAME(F); mixer_cd_x2(F, i, 16 + 2 * layer); } xcd_barrier(bar, F0.wave);
#endif
          { PHASE_FRAME(F); mixer_cd_x3(F, i, 2 * layer + 1); }
          xcd_barrier(bar, F0.wave);
#if MK_PROBE == 5
          { PHASE_FRAME(F); mixer_cd_x3(F, i, 16 + 2 * layer + 1); } xcd_barrier(bar, F0.wave);
#endif
          if (args.pad && layer == nl - 1) return;
          out_part(F0, bar, layer, (const bf16_t*)(F.ws + WS_WOUTCD + i * SZ_WOUT));
          ffn_part(F0, bar, layer, layer == nl - 1); }
    }
}

static int g_grid = 0;
inline void launch_mega(void* const* d_in, float* out, unsigned char* ws, int nlayers, hipStream_t stream, int stop_after_mixer = 0) {
    if (g_grid == 0) {
        int dev = 0, cus = 0;
        if (hipGetDevice(&dev) != hipSuccess || hipDeviceGetAttribute(&cus, hipDeviceAttributeMultiprocessorCount, dev) != hipSuccess) { g_grid = -1; return; }
        if (hipFuncSetAttribute((const void*)mega_fwd, hipFuncAttributeMaxDynamicSharedMemorySize, LDS_BYTES) != hipSuccess) { g_grid = -1; return; }
        int per_cu = 0; (void)hipOccupancyMaxActiveBlocksPerMultiprocessor(&per_cu, (const void*)mega_fwd, 512, LDS_BYTES); (void)hipGetLastError();
        g_grid = (per_cu >= 1) ? cus : -1;
    }
    if (g_grid < 0) return;
    (void)hipMemsetAsync(ws + WS_CTL, 0, CTL_BYTES, stream);
    Args a{}; for (int k = 0; k < 32; ++k) a.in[k] = (const float*)d_in[k];
    a.out = out; a.ws = ws; a.nlayers = nlayers; a.pad = stop_after_mixer;
    hipLaunchKernelGGL(mega_fwd, dim3(g_grid), dim3(512), LDS_BYTES, stream, a);
}
}
extern "C" void kernel_launch(void* const* d_in, const int* in_sizes, int n_in, void* d_out, int out_size, void* d_ws, size_t ws_size, hipStream_t stream) {
    if (n_in != 32 || ws_size < mk::WS_END || (size_t)out_size != mk::O_END) return;
    mk::launch_mega(d_in, (float*)d_out, (unsigned char*)d_ws, 4, stream);
}
```

```cpp
#include <hip/hip_runtime.h>
namespace mk {
#define MK_LAS __attribute__((address_space(3)))
#define MK_GAS __attribute__((address_space(1)))
typedef unsigned short bf16_t;
typedef short bf16x8 __attribute__((ext_vector_type(8)));
typedef short s16x4 __attribute__((ext_vector_type(4)));
typedef float f32x4 __attribute__((ext_vector_type(4)));
typedef float f32x2 __attribute__((ext_vector_type(2)));
typedef unsigned u32x4 __attribute__((ext_vector_type(4)));
typedef unsigned u32x2 __attribute__((ext_vector_type(2)));

constexpr int D = 2048, NB = 2, SEQ = 4096, MP = NB * SEQ, SB = 8, ST = 8, MS = SB * ST, MT = MP + MS;
constexpr int HA = 8, DH = 128, WA = 1024, WB = 1024, HB_ = 8, LA = 2048;
constexpr int N_AB = 5120, N_CD = 7680, N_CD_SRC = 7184, N_CDZ = 7168, FF = 5504, N_UP = 2 * FF;
constexpr int HC = 8, HD_ = 4, DK = 128, DVC = 128, DVD = 256;
constexpr float EPS = 1e-6f;
constexpr int NCHUNK = SEQ / 64;
constexpr int ZC_QC = 0, ZC_KC = 1024, ZC_IC = 2048, ZC_GC = 3072, ZC_QD = 4096, ZC_KD = 4608, ZC_VD = 5120, ZC_RD = 6144;

constexpr size_t MiB = 1u << 20;
constexpr size_t WS_CTL = 0, CTL_BYTES = 1 * MiB;
constexpr size_t WS_WINAB = 1 * MiB, SZ_WINAB = (size_t)N_AB * D * 2;
constexpr size_t WS_WOUTAB = WS_WINAB + 2 * SZ_WINAB, SZ_WOUT = (size_t)D * D * 2;
constexpr size_t WS_WINCD = WS_WOUTAB + 2 * SZ_WOUT, SZ_WINCD = (size_t)N_CD * D * 2;
constexpr size_t WS_WOUTCD = WS_WINCD + 2 * SZ_WINCD;
constexpr size_t WS_WUP = WS_WOUTCD + 2 * SZ_WOUT, SZ_WUP = (size_t)N_UP * D * 2;
constexpr size_t WS_WDN = WS_WUP + 4 * SZ_WUP, SZ_WDN = (size_t)D * FF * 2;
constexpr size_t WS_WLRU = WS_WDN + 4 * SZ_WDN, SZ_WLRU = (size_t)2 * 8 * 2 * 128 * 128 * 2;
constexpr size_t WS_LB = WS_WLRU + SZ_WLRU;
constexpr size_t WS_XB16 = WS_LB + 64 * 1024;
constexpr size_t WS_Z = WS_XB16 + 33 * MiB;
constexpr size_t WS_LG = WS_Z + 112 * MiB;
constexpr size_t WS_SC = WS_LG + 48 * MiB;
constexpr size_t WS_MIX = WS_SC + 64 * MiB;
constexpr size_t WS_ZS = WS_MIX + 33 * MiB;
constexpr size_t WS_GUS = WS_ZS + 2 * MiB;
constexpr size_t WS_GHEAD = WS_GUS + 3 * MiB;
constexpr size_t WS_GTAIL = WS_GHEAD + 3 * MiB;
constexpr size_t WS_RSS = WS_GTAIL + 2 * MiB;
constexpr size_t RSS_P_FLOATS = (size_t)9 * MP * 8, RSS_S_FLOATS = (size_t)9 * MS * 128;
constexpr size_t WS_END = WS_RSS + 3 * MiB;
static_assert((RSS_P_FLOATS + RSS_S_FLOATS) * 4 <= 3 * MiB && (size_t)MT * FF * 2 <= 112 * MiB && (size_t)MP * N_CDZ * 2 <= 112 * MiB && (size_t)MT * D * 2 <= 33 * MiB, "ws map");
constexpr int CW_TMO = 0, CW_CODE = 1, CW_BAR = 4096, CW_Q = 8192;
constexpr int RING_BYTES = 131072, EPI_OFF = RING_BYTES, EPI_BYTES = 12288, MISC_OFF = EPI_OFF + EPI_BYTES, LDS_BYTES = 147456;
static_assert(MISC_OFF + 256 <= LDS_BYTES, "lds");

__device__ __forceinline__ unsigned f2bf(float f) { unsigned u = __builtin_bit_cast(unsigned, f); return (u + 0x7fffu + ((u >> 16) & 1u)) >> 16; }
__device__ __forceinline__ unsigned pk2(float lo, float hi) { return f2bf(lo) | (f2bf(hi) << 16); }
__device__ __forceinline__ float bf2f(unsigned short b) { return __builtin_bit_cast(float, ((unsigned)b) << 16); }
__device__ __forceinline__ float bflo(unsigned w) { return __builtin_bit_cast(float, w << 16); }
__device__ __forceinline__ float bfhi(unsigned w) { return __builtin_bit_cast(float, w & 0xffff0000u); }
__device__ __forceinline__ unsigned cvt_pk_bf16(float lo, float hi) { unsigned r; asm volatile("v_cvt_pk_bf16_f32 %0, %1, %2" : "=v"(r) : "v"(lo), "v"(hi)); return r; }
__device__ __forceinline__ float fast_exp2(float x) { return __builtin_amdgcn_exp2f(x); }
__device__ __forceinline__ float fast_exp(float x) { return __builtin_amdgcn_exp2f(x * 1.44269504089f); }
__device__ __forceinline__ float fast_rcp(float x) { return __builtin_amdgcn_rcpf(x); }
__device__ __forceinline__ float sigmoid_f(float x) { return fast_rcp(1.0f + fast_exp(-x)); }
__device__ __forceinline__ float silu_f(float x) { return x * sigmoid_f(x); }
__device__ __forceinline__ float gelu_tanh_f(float x) { const float u = 0.7978845608028654f * (x + 0.044715f * x * x * x); return x * sigmoid_f(2.0f * u); }
template <class T> __device__ __forceinline__ MK_GAS T* launder(T* p) { MK_GAS T* q = (MK_GAS T*)p; asm volatile("" : "+v"(q)); return q; }
template <class T> __device__ __forceinline__ MK_GAS T* launder(MK_GAS T* q) { asm volatile("" : "+v"(q)); return q; }
__device__ __forceinline__ int opaque_bid() { int b = (int)blockIdx.x; asm volatile("" : "+s"(b)); return b; }
__device__ __forceinline__ int lane_id() { int l; asm volatile("v_mbcnt_lo_u32_b32 %0, -1, 0\n\tv_mbcnt_hi_u32_b32 %0, -1, %0" : "=v"(l)); return l; }
__device__ __forceinline__ int opaque_tid(int wave) { int l; asm volatile("v_mbcnt_lo_u32_b32 %0, -1, 0\n\tv_mbcnt_hi_u32_b32 %0, -1, %0" : "=v"(l)); return wave * 64 + l; }
__device__ __forceinline__ float fast_rsq(float x) { return __builtin_amdgcn_rsqf(x); }
__device__ __forceinline__ float fast_sqrt(float x) { return __builtin_amdgcn_sqrtf(x); }
__device__ __forceinline__ float fast_ln(float x) { return 0.69314718056f * __builtin_amdgcn_logf(x); }
__device__ __forceinline__ float softplus_acc(float x) { if (x > 20.f) return x; const float e = fast_exp(x); const float ser = e * (1.0f + e * (-0.5f + e * (0.33333333f + e * (-0.25f + e * 0.2f)))); return e < 0.06f ? ser : fast_ln(1.0f + e); }
__device__ __forceinline__ float one_minus_exp(float x) { const float ser = -x * (1.0f + x * (0.5f + x * (0.16666667f + x * (0.041666668f + x * 0.0083333338f)))); return x > -0.3f ? ser : 1.0f - fast_exp(x); }
__device__ __forceinline__ float rss_p(const float* part, int row) { const f32x4 a = *(const f32x4*)(part + (size_t)row * 8), b = *(const f32x4*)(part + (size_t)row * 8 + 4); return ((a[0] + a[1]) + (a[2] + a[3])) + ((b[0] + b[1]) + (b[2] + b[3])); }
__device__ __forceinline__ float rss_s(const float* part, int row) { float s = 0.f; const f32x4* p = (const f32x4*)(part + (size_t)row * 128);
#pragma unroll 8
    for (int j = 0; j < 32; ++j) { const f32x4 a = p[j]; s += (a[0] + a[1]) + (a[2] + a[3]); } return s; }
__device__ __forceinline__ float bperm(int srclane, float v) { return __builtin_bit_cast(float, __builtin_amdgcn_ds_bpermute(srclane << 2, __builtin_bit_cast(int, v))); }
#define SHX(v, mask) bperm(lane ^ (mask), (v))
#define SHUP(v, d) bperm(lane >= (d) ? lane - (d) : lane, (v))
#define SHL(v, src) bperm((src), (v))
#define LDS_WAIT() asm volatile("s_waitcnt lgkmcnt(0)" ::: "memory")
#define VM_WAIT() asm volatile("s_waitcnt vmcnt(0)" ::: "memory")

#define XB_TMO      128
#define XB_XCNT(j)  (256  + 64 * (j))
#define XB_XSUB(j)  (1280 + 64 * (j))
#define XB_XGEN(j)  (2304 + 64 * (j))
#define XB_TOP      3328
#define XB_TOPGEN   3392
#define XCD_BAR_WORDS 3456
#define XB_SPIN_CAP (1u << 22)
__device__ __forceinline__ unsigned xb_ld(unsigned* p)              { return __hip_atomic_load(p, __ATOMIC_RELAXED, __HIP_MEMORY_SCOPE_AGENT); }
__device__ __forceinline__ unsigned xb_add(unsigned* p, unsigned v) { return __hip_atomic_fetch_add(p, v, __ATOMIC_RELAXED, __HIP_MEMORY_SCOPE_AGENT); }
__device__ __forceinline__ unsigned xb_xcc_id() { return (unsigned)__builtin_amdgcn_s_getreg((3 << 11) | 20) & 0xFu; }
#define XB_SPIN(cond, bar) do { unsigned _sp = 0; while (cond) { __builtin_amdgcn_s_sleep(1); \
    if ((++_sp & 255u) == 0u) { if (xb_ld(&(bar)[XB_TMO])) break; if (_sp > XB_SPIN_CAP) { atomicAdd(&(bar)[XB_TMO], 1u); break; } } } } while (0)
struct XcdBarrier { unsigned* bar; unsigned x; volatile MK_LAS unsigned* st; };
__device__ __forceinline__ XcdBarrier xcd_barrier_post(unsigned* bar, volatile MK_LAS unsigned* st, int wave) {
    XcdBarrier b; b.bar = bar; b.x = xb_xcc_id(); b.st = st;
    if (wave == 0 && lane_id() == 0) (void)xb_add(&bar[XB_XCNT(b.x)], 1u);
    return b;
}
__device__ __forceinline__ void xcd_barrier_complete(unsigned* bar, unsigned x, unsigned& nloc, unsigned& nx) {
    const unsigned G = gridDim.x * gridDim.y * gridDim.z;
    unsigned sum, cnt, mine, sp = 0u;
    for (;;) {
        sum = 0u; cnt = 0u; mine = 0u;
#pragma unroll
        for (unsigned j = 0; j < 16; ++j) { const unsigned c = xb_ld(&bar[XB_XCNT(j)]); sum += c; cnt += (c > 0u) ? 1u : 0u; mine = (j == x) ? c : mine; }
        if (sum == G) break;
        __builtin_amdgcn_s_sleep(1);
        if ((++sp & 255u) == 0u) { if (xb_ld(&bar[XB_TMO])) break; if (sp > XB_SPIN_CAP) { atomicAdd(&bar[XB_TMO], 1u); break; } }
    }
    nloc = mine > 0u ? mine : 1u; nx = cnt > 0u ? cnt : 1u;
}
__device__ __forceinline__ void xcd_barrier(const XcdBarrier& b, int wave) {
    asm volatile("s_waitcnt vmcnt(0)" ::: "memory");
    __syncthreads();
    if (wave == 0 && lane_id() == 0) {
        unsigned* bar = b.bar; unsigned bx = xb_xcc_id(); asm volatile("" : "+s"(bx));
        __builtin_amdgcn_s_waitcnt(0);
        unsigned nloc = b.st[0], nx = b.st[1];
        if (nloc == 0u) { xcd_barrier_complete(bar, bx, nloc, nx); b.st[0] = nloc; b.st[1] = nx; }
        const unsigned old = xb_add(&bar[XB_XSUB(bx)], 1u);
        const unsigned gen = old / nloc;
        if (old + 1u == (gen + 1u) * nloc) {
            __builtin_amdgcn_fence(__ATOMIC_RELEASE, "agent");
            asm volatile("s_waitcnt vmcnt(0)" ::: "memory");
            const unsigned og = xb_add(&bar[XB_TOP], 1u);
            const unsigned tg = og / nx;
            if (og + 1u == (tg + 1u) * nx) xb_add(&bar[XB_TOPGEN], 1u);
            else XB_SPIN(xb_ld(&bar[XB_TOPGEN]) == tg, bar);
            __builtin_amdgcn_fence(__ATOMIC_ACQUIRE, "agent");
            xb_add(&bar[XB_XGEN(bx)], 1u);
            asm volatile("s_waitcnt vmcnt(0)" ::: "memory");
        } else {
            XB_SPIN(xb_ld(&bar[XB_XGEN(bx)]) == gen, bar);
            __builtin_amdgcn_fence(__ATOMIC_ACQUIRE, "agent");
            asm volatile("s_waitcnt vmcnt(0)" ::: "memory");
        }
    }
    __syncthreads();
}

constexpr int BM = 256, BK = 64, HALF = 128, HTB = HALF * BK * 2, STAGE_BYTES = 8 * HTB, NXCD = 8, WGM = 8;
__host__ __device__ __forceinline__ int lds_byte(int r, int c) { const int st = (r >> 4) * 2 + (c >> 5), rr = r & 15, cc = c & 31, ob = rr * 64 + cc * 2; return st * 1024 + (ob ^ (((ob >> 9) & 1) << 5)); }
__host__ __device__ __forceinline__ void stage_rc(int b, int& R, int& C) { const int st = b / 1024, sb = b % 1024, swz = sb ^ (((sb >> 9) & 1) << 5); R = (st >> 1) * 16 + swz / 64; C = (st & 1) * 32 + (swz % 64) / 2; }
__host__ __device__ __forceinline__ int perm32(int rho) { const int n = rho >> 4, i = rho & 15; return 8 * (i >> 2) + 4 * n + (i & 3); }
struct Unit { int pm, pn; };
struct Gemm { const bf16_t* A; const bf16_t* Bt; int M, N, K; };
struct StaticOrder {
    int nM, nN, nwg, G, c;
    __device__ __forceinline__ void init(int M, int N, int G_, int c_) { nM = M / BM; nN = N / BM; nwg = nM * nN; G = G_; c = c_; }
    __device__ __forceinline__ bool next(int i, Unit& u) const {
        const long L = (long)i * G + c; if (L >= nwg) return false;
        int wgid = (int)L; { const int q = nwg / NXCD, r = nwg % NXCD, xcd = wgid % NXCD, off = wgid / NXCD; wgid = (xcd < r ? xcd * (q + 1) : r * (q + 1) + (xcd - r) * q) + off; }
        const int nig = WGM * nN, gid = wgid / nig, fm = gid * WGM, gsz = (nM - fm) < WGM ? (nM - fm) : WGM;
        u.pm = fm + ((wgid % nig) % gsz); u.pn = (wgid % nig) / gsz; return true;
    }
};
template <class Epi>
__device__ __forceinline__ void gemm_phase(MK_LAS unsigned char* lds, const Gemm g, const StaticOrder& S, const Epi& E, int wave_id) {
    const int tid = opaque_tid(wave_id), wid = wave_id, lane = tid & 63, wr = wid >> 2, wc = wid & 3, fr = lane & 15, fq = lane >> 4;
    const int K = g.K, nt = K / BK;
    unsigned voffA[2], voffB[2];
#pragma unroll
    for (int i = 0; i < 2; ++i) { int R, C; stage_rc(tid * 16 + i * 8192, R, C); const int Rb = Epi::PERM ? ((R & ~31) + perm32(R & 31)) : R;
        voffA[i] = (unsigned)(R * K + C) * 2u; voffB[i] = (unsigned)(Rb * K + C) * 2u; }
    const size_t kstep = (size_t)(BK * 2);
    const size_t hstep = (size_t)HALF * K * 2;
    const size_t tstep = 2 * hstep;
    const unsigned ldsw = (unsigned)wid * 1024u;
    const int aoff = lds_byte(wr * 64 + fr, fq * 8), boff = lds_byte(wc * 32 + fr, fq * 8);
#define PG8_SA(b, h) (((b) * 2 + (h)) * HTB)
#define PG8_SB(b, h) ((4 + (b) * 2 + (h)) * HTB)
#define PG8_STAGE(bufoff, gbase, voff) do { _Pragma("unroll") for (int _i = 0; _i < 2; ++_i) \
        __builtin_amdgcn_global_load_lds((const unsigned*)((const char*)(gbase) + (voff)[_i]), (MK_LAS unsigned*)(lds + (bufoff) + ldsw + _i * 8192), 16, 0, 0); } while (0)
#define PG8_LDA(dst, b, h) do { _Pragma("unroll") for (int m = 0; m < 4; ++m) _Pragma("unroll") for (int k = 0; k < 2; ++k) dst[m][k] = *(const MK_LAS bf16x8*)(lds + PG8_SA(b, h) + aoff + m * 2048 + k * 1024); } while (0)
#define PG8_LDB(dst, b, h) do { _Pragma("unroll") for (int n = 0; n < 2; ++n) _Pragma("unroll") for (int k = 0; k < 2; ++k) dst[n][k] = *(const MK_LAS bf16x8*)(lds + PG8_SB(b, h) + boff + n * 2048 + k * 1024); } while (0)
#define PG8_MMA(ai, bj, At, Bt) do { __builtin_amdgcn_s_setprio(1); _Pragma("unroll") for (int m = 0; m < 4; ++m) _Pragma("unroll") for (int n = 0; n < 2; ++n) _Pragma("unroll") for (int k = 0; k < 2; ++k) \
        acc[ai][bj][m][n] = __builtin_amdgcn_mfma_f32_16x16x32_bf16(Bt[n][k], At[m][k], acc[ai][bj][m][n], 0, 0, 0); __builtin_amdgcn_s_setprio(0); } while (0)
#define PG8_WAIT_V(n) asm volatile("s_waitcnt vmcnt(" #n ")" ::: "memory")
#define PG8_WAIT_L(n) asm volatile("s_waitcnt lgkmcnt(" #n ")" ::: "memory")
#define PG8_BAR __builtin_amdgcn_s_barrier()
#define PG8_SCHED __builtin_amdgcn_sched_barrier(0)
    Unit cur, nxt; int ui = 0;
    if (!S.next(0, cur)) return;
    f32x4 acc[2][2][4][2];
#pragma unroll
    for (int a = 0; a < 2; ++a)
#pragma unroll
        for (int b = 0; b < 2; ++b)
#pragma unroll
            for (int m = 0; m < 4; ++m)
#pragma unroll
                for (int n = 0; n < 2; ++n) acc[a][b][m][n] = (f32x4){0.f, 0.f, 0.f, 0.f};
    bf16x8 At[4][2], B0[2][2], B1[2][2];
    const char* cA = (const char*)g.A + (size_t)cur.pm * tstep; const char* cB = (const char*)g.Bt + (size_t)cur.pn * tstep;
    PG8_STAGE(PG8_SB(0, 0), cB, voffB); PG8_STAGE(PG8_SB(0, 1), cB + hstep, voffB); PG8_STAGE(PG8_SA(0, 0), cA, voffA); PG8_STAGE(PG8_SA(0, 1), cA + hstep, voffA);
    if (wr == 1) PG8_BAR;
    PG8_WAIT_V(2); PG8_BAR;
    PG8_STAGE(PG8_SB(1, 0), cB + kstep, voffB); PG8_STAGE(PG8_SA(1, 0), cA + kstep, voffA); PG8_STAGE(PG8_SB(1, 1), cB + hstep + kstep, voffB);
    PG8_WAIT_V(6); PG8_BAR;
    for (;;) {
        const bool has_next = S.next(ui + 1, nxt);
        const char* nA = has_next ? (const char*)g.A + (size_t)nxt.pm * tstep : cA; const char* nB = has_next ? (const char*)g.Bt + (size_t)nxt.pn * tstep : cB;
        for (int t = 0; t < nt; t += 2) {
            const bool last = (t == nt - 2);
            const char* a1 = cA + (size_t)(t + 1) * kstep;
            const char* a2 = last ? nA : cA + (size_t)(t + 2) * kstep; const char* b2 = last ? nB : cB + (size_t)(t + 2) * kstep;
            const char* a3 = a2 + kstep; const char* b3 = b2 + kstep;
            PG8_LDB(B0, 0, 0); PG8_LDB(B1, 0, 1); PG8_SCHED; PG8_LDA(At, 0, 0); PG8_STAGE(PG8_SA(1, 1), a1 + hstep, voffA);
            PG8_WAIT_V(8); PG8_WAIT_L(0); PG8_BAR; PG8_MMA(0, 0, At, B0); PG8_MMA(0, 1, At, B1); PG8_BAR; PG8_SCHED;
            PG8_LDA(At, 0, 1); PG8_STAGE(PG8_SB(0, 0), b2, voffB); PG8_STAGE(PG8_SB(0, 1), b2 + hstep, voffB); PG8_STAGE(PG8_SA(0, 0), a2, voffA);
            PG8_WAIT_V(8); PG8_WAIT_L(0); PG8_BAR; PG8_MMA(1, 0, At, B0); PG8_MMA(1, 1, At, B1); PG8_BAR; PG8_SCHED;
            PG8_LDB(B0, 1, 0); PG8_LDB(B1, 1, 1); PG8_SCHED; PG8_LDA(At, 1, 0); PG8_STAGE(PG8_SA(0, 1), a2 + hstep, voffA);
            PG8_WAIT_V(8); PG8_WAIT_L(0); PG8_BAR; PG8_MMA(0, 0, At, B0); PG8_MMA(0, 1, At, B1); PG8_BAR; PG8_SCHED;
            PG8_LDA(At, 1, 1); PG8_STAGE(PG8_SB(1, 0), b3, voffB); PG8_STAGE(PG8_SB(1, 1), b3 + hstep, voffB); PG8_STAGE(PG8_SA(1, 0), a3, voffA);
            PG8_WAIT_V(8); PG8_WAIT_L(0); PG8_BAR; PG8_MMA(1, 0, At, B0); PG8_MMA(1, 1, At, B1); PG8_BAR; PG8_SCHED;
        }
        if (wr == 0) PG8_BAR;
        E(acc, cur, wr, wc, fr, fq, lds + EPI_OFF);
        if (!has_next) break;
#pragma unroll
        for (int a = 0; a < 2; ++a)
#pragma unroll
            for (int b = 0; b < 2; ++b)
#pragma unroll
                for (int m = 0; m < 4; ++m)
#pragma unroll
                    for (int n = 0; n < 2; ++n) acc[a][b][m][n] = (f32x4){0.f, 0.f, 0.f, 0.f};
        cur = nxt; cA = nA; cB = nB; ++ui;
        if (wr == 1) PG8_BAR;
    }
    PG8_WAIT_V(0);
    PG8_BAR;
#undef PG8_SA
#undef PG8_SB
#undef PG8_STAGE
#undef PG8_LDA
#undef PG8_LDB
#undef PG8_MMA
#undef PG8_WAIT_V
#undef PG8_WAIT_L
#undef PG8_SCHED
}
}
namespace mk {
typedef f32x4 Acc[2][2][4][2];

struct EpiRes {
    static constexpr bool PERM = true;
    bf16_t* xb16; float* yout; float* rssp;
    __device__ __forceinline__ void operator()(Acc& acc, const Unit& u, int wr, int wc, int fr, int fq, MK_LAS unsigned char* lds) const {
        asm volatile("" : "+v"(fr), "+v"(fq)); const int lane = fq * 16 + fr;
        const int row0 = u.pm * BM + wr * 64 + fr, col0 = u.pn * BM + wc * 32 + 8 * fq;
        MK_LAS float* P = (MK_LAS float*)lds;
#pragma unroll
        for (int ai = 0; ai < 2; ++ai)
#pragma unroll
            for (int m = 0; m < 4; ++m) { const int row = row0 + ai * HALF + m * 16; const unsigned off = (unsigned)row * D + col0; float ss = 0.f;
#pragma unroll
                for (int bj = 0; bj < 2; ++bj) { const unsigned o = off + bj * HALF; const u32x4 xo = *(const u32x4*)(xb16 + o);
                    const f32x4 v0 = acc[ai][bj][m][0] + (f32x4){bflo(xo.x), bfhi(xo.x), bflo(xo.y), bfhi(xo.y)}, v1 = acc[ai][bj][m][1] + (f32x4){bflo(xo.z), bfhi(xo.z), bflo(xo.w), bfhi(xo.w)};
                    u32x4 w; w.x = cvt_pk_bf16(v0[0], v0[1]); w.y = cvt_pk_bf16(v0[2], v0[3]); w.z = cvt_pk_bf16(v1[0], v1[1]); w.w = cvt_pk_bf16(v1[2], v1[3]); *(u32x4*)(xb16 + o) = w;
                    if (yout) { *(f32x4*)(yout + o) = v0; *(f32x4*)(yout + o + 4) = v1; }
                    ss += ((v0[0] * v0[0] + v0[1] * v0[1]) + (v0[2] * v0[2] + v0[3] * v0[3])) + ((v1[0] * v1[0] + v1[1] * v1[1]) + (v1[2] * v1[2] + v1[3] * v1[3]));
                    asm volatile("" ::: "memory"); }
                ss += SHX(ss, 16); ss += SHX(ss, 32);
                if (fq == 0) P[(ai * HALF + wr * 64 + m * 16 + fr) * 4 + wc] = ss;
                asm volatile("" ::: "memory"); }
        LDS_WAIT(); __builtin_amdgcn_s_barrier(); asm volatile("" ::: "memory");
        if (fq == 0) {
#pragma unroll
            for (int ai = 0; ai < 2; ++ai)
#pragma unroll
                for (int m = 0; m < 4; ++m) if (((ai * 4 + m) >> 1) == wc) { const int rl = ai * HALF + wr * 64 + m * 16 + fr; const f32x4 p = *(const MK_LAS f32x4*)(P + rl * 4);
                    rssp[(unsigned)(u.pm * BM + rl) * 8 + u.pn] = (p[0] + p[1]) + (p[2] + p[3]); } }
    }
};

struct EpiInAB {
    static constexpr bool PERM = true;
    bf16_t* Z; const float* rss; const float* qn; const float* kn; float* kv_out; float* conv_out;
    __device__ __forceinline__ void operator()(Acc& acc, const Unit& u, int wr, int wc, int fr, int fq, MK_LAS unsigned char* lds) const {
        asm volatile("" : "+v"(fr), "+v"(fq)); const int lane = fq * 16 + fr;
        const int kind = u.pn >> 2; const int row0 = u.pm * BM + wr * 64 + fr; const int cw = (u.pn & 3) * 256 + wc * 32 + 8 * fq;
        MK_LAS float* P = (MK_LAS float*)lds;
#pragma unroll
        for (int ai = 0; ai < 2; ++ai)
#pragma unroll
            for (int m = 0; m < 4; ++m) { const float rs = fast_rsq(rss_p(rss, row0 + ai * HALF + m * 16) * (1.0f / D) + EPS);
#pragma unroll
                for (int bj = 0; bj < 2; ++bj) { acc[ai][bj][m][0] = acc[ai][bj][m][0] * rs; acc[ai][bj][m][1] = acc[ai][bj][m][1] * rs;
                    if (kind <= 1) { const f32x4 v = acc[ai][bj][m][0], x = acc[ai][bj][m][1]; float s = ((v[0] * v[0] + v[1] * v[1]) + (v[2] * v[2] + v[3] * v[3])) + ((x[0] * x[0] + x[1] * x[1]) + (x[2] * x[2] + x[3] * x[3]));
                        s += SHX(s, 16); s += SHX(s, 32);
                        if (fq == 0) P[((ai * HALF + wr * 64 + m * 16 + fr) * 2 + bj) * 4 + wc] = s; } }
                asm volatile("" ::: "memory"); }
        f32x4 g0 = (f32x4){1.f, 1.f, 1.f, 1.f}, g1 = g0;
        if (kind <= 1) { LDS_WAIT(); __builtin_amdgcn_s_barrier(); asm volatile("" ::: "memory");
            const float* gp = (kind == 0 ? qn : kn) + wc * 32 + 8 * fq; g0 = *(const f32x4*)gp; g1 = *(const f32x4*)(gp + 4); }
#pragma unroll
        for (int ai = 0; ai < 2; ++ai)
#pragma unroll
            for (int m = 0; m < 4; ++m) { const int row = row0 + ai * HALF + m * 16; const int t = row & (SEQ - 1), b = row >> 12;
#pragma unroll
                for (int bj = 0; bj < 2; ++bj) { f32x4 v0 = acc[ai][bj][m][0], v1 = acc[ai][bj][m][1];
                    if (kind <= 1) { const f32x4 p = *(const MK_LAS f32x4*)(P + ((ai * HALF + wr * 64 + m * 16 + fr) * 2 + bj) * 4);
                        const float hs = fast_rsq(((p[0] + p[1]) + (p[2] + p[3])) * (1.0f / DH) + EPS); v0 = v0 * hs * g0; v1 = v1 * hs * g1; }
                    u32x4 w; w.x = cvt_pk_bf16(v0[0], v0[1]); w.y = cvt_pk_bf16(v0[2], v0[3]); w.z = cvt_pk_bf16(v1[0], v1[1]); w.w = cvt_pk_bf16(v1[2], v1[3]);
                    *(u32x4*)(Z + (unsigned)row * N_AB + kind * 1024 + cw + bj * HALF) = w;
                    if ((kind == 1 || kind == 2) && t >= SEQ - LA) { float* o = kv_out + (((unsigned)b * LA + (t - (SEQ - LA))) * 2 + (kind - 1)) * WA + cw + bj * HALF; *(f32x4*)o = v0; *(f32x4*)(o + 4) = v1; }
                    if (kind == 3 && t >= SEQ - 3) { float* o = conv_out + ((unsigned)b * 3 + (t - (SEQ - 3))) * WB + cw + bj * HALF; *(f32x4*)o = v0; *(f32x4*)(o + 4) = v1; } }
                asm volatile("" ::: "memory"); }
    }
};

struct EpiInCD {
    static constexpr bool PERM = true;
    bf16_t* Z; const float* rss; const float* lb; const float* bg; float* lgc; float* lgd;
    __device__ __forceinline__ void operator()(Acc& acc, const Unit& u, int wr, int wc, int fr, int fq, MK_LAS unsigned char*) const {
        asm volatile("" : "+v"(fr), "+v"(fq));
        const int pn = u.pn; const int row0 = u.pm * BM + wr * 64 + fr; const int c8 = wc * 32 + 8 * fq;
        const int mode = (pn >= 4 && pn < 8) ? 1 : (pn >= 28 ? 2 : 0);
        const float sc = (pn == 16 || pn == 17) ? 0.08838834764831845f : 1.0f;
#pragma unroll
        for (int ai = 0; ai < 2; ++ai)
#pragma unroll
            for (int m = 0; m < 4; ++m) { const int row = row0 + ai * HALF + m * 16; const float rs = sc * fast_rsq(rss_p(rss, row) * (1.0f / D) + EPS);
#pragma unroll
                for (int bj = 0; bj < 2; ++bj) { f32x4 v0 = acc[ai][bj][m][0] * rs, v1 = acc[ai][bj][m][1] * rs; const int ct = c8 + bj * HALF;
                    if (mode == 1) { const int ck = (pn - 4) * 256 + ct; const f32x4 l0 = *(const f32x4*)(lb + ck), l1 = *(const f32x4*)(lb + ck + 4); f32x4 g0, g1;
#pragma unroll
                        for (int j = 0; j < 4; ++j) { const float s0 = sigmoid_f(v0[j]), s1 = sigmoid_f(v1[j]);
                            g0[j] = fmaxf(fast_ln(l0[j] + (1.0f - l0[j]) * s0), -60.0f); g1[j] = fmaxf(fast_ln(l1[j] + (1.0f - l1[j]) * s1), -60.0f);
                            v0[j] = (1.0f - l0[j]) * (1.0f - s0); v1[j] = (1.0f - l1[j]) * (1.0f - s1); }
                        float* o = lgc + (unsigned)row * 1024 + ck; *(f32x4*)o = g0; *(f32x4*)(o + 4) = g1; }
                    if (mode == 2) { const int ck = (pn - 28) * 256 + ct; const f32x4 b0 = *(const f32x4*)(bg + ck), b1 = *(const f32x4*)(bg + ck + 4); f32x4 g0, g1;
#pragma unroll
                        for (int j = 0; j < 4; ++j) { const float x0 = v0[j] + b0[j], x1 = v1[j] + b1[j];
                            g0[j] = (fminf(x0, 0.f) - fast_ln(1.0f + fast_exp(-fabsf(x0)))) * 0.0625f;
                            g1[j] = (fminf(x1, 0.f) - fast_ln(1.0f + fast_exp(-fabsf(x1)))) * 0.0625f; }
                        float* o = lgd + (unsigned)row * 512 + ck; *(f32x4*)o = g0; *(f32x4*)(o + 4) = g1; }
                    else { u32x4 w; w.x = cvt_pk_bf16(v0[0], v0[1]); w.y = cvt_pk_bf16(v0[2], v0[3]); w.z = cvt_pk_bf16(v1[0], v1[1]); w.w = cvt_pk_bf16(v1[2], v1[3]);
                        *(u32x4*)(Z + (unsigned)row * N_CDZ + pn * 256 + ct) = w; } } }
    }
};

struct EpiUp {
    static constexpr bool PERM = true;
    bf16_t* HB; const float* rss; const float* cw; const float* cb; float* ghead; float* gtail; float* ffn_out;
    __device__ __forceinline__ void operator()(Acc& acc, const Unit& u, int wr, int wc, int fr, int fq, MK_LAS unsigned char* lds) const {
        asm volatile("" : "+v"(fr), "+v"(fq));
        const int lane = fq * 16 + fr; const int row0 = u.pm * BM + wr * 64 + fr; const int c8 = wc * 32 + 8 * fq, cg = u.pn * 128 + c8;
        MK_LAS float* T = (MK_LAS float*)lds;
        f32x4 w0 = *(const f32x4*)(cw + cg), w1 = *(const f32x4*)(cw + FF + cg), w2 = *(const f32x4*)(cw + 2 * FF + cg), bb = *(const f32x4*)(cb + cg);
#pragma unroll
        for (int ai = 0; ai < 2; ++ai)
#pragma unroll
            for (int m = 0; m < 4; ++m) { const float rs = fast_rsq(rss_p(rss, row0 + ai * HALF + m * 16) * (1.0f / D) + EPS);
#pragma unroll
                for (int bj = 0; bj < 2; ++bj) { acc[ai][bj][m][0] = acc[ai][bj][m][0] * rs; acc[ai][bj][m][1] = acc[ai][bj][m][1] * rs; } }
        if (fr >= 14) {
#pragma unroll
            for (int ai = 0; ai < 2; ++ai) { MK_LAS float* t = T + ((2 * ai + wr) * 2 + (fr - 14)) * 128 + c8; *(MK_LAS f32x4*)t = acc[ai][0][3][0]; *(MK_LAS f32x4*)(t + 4) = acc[ai][0][3][1]; }
        }
        LDS_WAIT(); __builtin_amdgcn_s_barrier(); asm volatile("" ::: "memory");
        const int s1 = (lane & 48) | ((fr + 15) & 15), s2 = (lane & 48) | ((fr + 14) & 15);
        const bool first_tile = (u.pm & 15) == 0;
#pragma unroll
        for (int n = 0; n < 2; ++n) {
            if (n == 1) { w0 = *(const f32x4*)(cw + cg + 4); w1 = *(const f32x4*)(cw + FF + cg + 4); w2 = *(const f32x4*)(cw + 2 * FF + cg + 4); bb = *(const f32x4*)(cb + cg + 4); }
#pragma unroll
            for (int ai = 0; ai < 2; ++ai) { const int grp = 2 * ai + wr; f32x4 prev1, prev2;
                if (grp == 0) { prev1 = (f32x4){0.f, 0.f, 0.f, 0.f}; prev2 = prev1; }
                else { const f32x4 r63 = *(const MK_LAS f32x4*)(T + ((grp - 1) * 2 + 1) * 128 + c8 + 4 * n), r62 = *(const MK_LAS f32x4*)(T + ((grp - 1) * 2 + 0) * 128 + c8 + 4 * n); prev1 = r63; prev2 = (fr == 0) ? r62 : r63; }
#pragma unroll
                for (int m = 0; m < 4; ++m) { const int row = row0 + ai * HALF + m * 16; const f32x4 x = acc[ai][0][m][n]; f32x4 r1, r2, hv;
#pragma unroll
                    for (int j = 0; j < 4; ++j) { r1[j] = SHL(x[j], s1); r2[j] = SHL(x[j], s2); }
                    const f32x4 p1 = (fr >= 1) ? r1 : prev1, p2 = (fr >= 2) ? r2 : prev2;
                    prev1 = r1; prev2 = r2;
                    const f32x4 gc = bb + w0 * p2 + w1 * p1 + w2 * x; const f32x4 uu = acc[ai][1][m][n];
#pragma unroll
                    for (int j = 0; j < 4; ++j) hv[j] = silu_f(gc[j]) * uu[j];
                    const bool deferred = (grp == 0) && (m == 0) && (fr < 2) && !first_tile;
                    if (deferred) { float* o = ghead + ((unsigned)u.pm * 2 + fr) * (2 * FF) + cg + 4 * n; *(f32x4*)o = x; *(f32x4*)(o + FF) = uu; }
                    if (grp == 3 && m == 3 && fr >= 14) { *(f32x4*)(gtail + ((unsigned)u.pm * 2 + (fr - 14)) * FF + cg + 4 * n) = x;
                        if ((u.pm & 15) == 15) *(f32x4*)(ffn_out + ((unsigned)(u.pm >> 4) * 2 + (fr - 14)) * FF + cg + 4 * n) = x; }
                    if (!deferred) { u32x2 w; w.x = cvt_pk_bf16(hv[0], hv[1]); w.y = cvt_pk_bf16(hv[2], hv[3]); *(u32x2*)(HB + (unsigned)row * FF + cg + 4 * n) = w; }
                    asm volatile("" ::: "memory"); } } }
    }
};

template <int NT> struct SgLd { static constexpr int LDR = 16 * NT + 4, SLAB = 64 * LDR; };
template <int NT> __device__ __forceinline__ float sred4(const MK_LAS float* red, int row, int col) { constexpr int LDR = SgLd<NT>::LDR, SLAB = SgLd<NT>::SLAB; const MK_LAS float* p = red + row * LDR + col; return (p[0] + p[SLAB]) + (p[2 * SLAB] + p[3 * SLAB]); }
constexpr int SG1_U = 2;
__device__ __forceinline__ void sg1_ld(const bf16_t* ap, const bf16_t* bp, int K, int nks, int wave, int kg, bf16x8 (&aa)[SG1_U][4], bf16x8 (&bb)[SG1_U]) {
    int ks0 = wave + 8 * SG1_U * kg; auto pa = launder(ap + 32 * (ks0 < nks ? ks0 : nks - 1)); auto pb = launder(bp + 32 * (ks0 < nks ? ks0 : nks - 1));
#pragma unroll
    for (int u = 0; u < SG1_U; ++u) {
#pragma unroll
        for (int mt = 0; mt < 4; ++mt) aa[u][mt] = *(const MK_GAS bf16x8*)(pa + (size_t)(16 * mt) * K);
        bb[u] = *(const MK_GAS bf16x8*)pb;
        if (u + 1 < SG1_U) { const int adv = (ks0 + 8 * (u + 1) < nks) ? 256 : 0; pa = launder(pa + adv); pb = launder(pb + adv); } }
}
template <int NTT> __device__ __forceinline__ void sg1_mm(f32x4 (&acc)[4][NTT], int nks, int wave, int kg, const bf16x8 (&aa)[SG1_U][4], const bf16x8 (&bb)[SG1_U]) {
#pragma unroll
    for (int u = 0; u < SG1_U; ++u) if (wave + 8 * (SG1_U * kg + u) < nks) {
#pragma unroll
        for (int mt = 0; mt < 4; ++mt) acc[mt][0] = __builtin_amdgcn_mfma_f32_16x16x32_bf16(aa[u][mt], bb[u], acc[mt][0], 0, 0, 0); }
}
template <int NT> __device__ __forceinline__ void sgemm_tile(MK_LAS float* red, const bf16_t* A, const bf16_t* Bt, int K, int n0, int wave, int lane) {
    constexpr int LDR = SgLd<NT>::LDR, SLAB = SgLd<NT>::SLAB;
    f32x4 acc[4][NT];
#pragma unroll
    for (int a = 0; a < 4; ++a)
#pragma unroll
        for (int b = 0; b < NT; ++b) acc[a][b] = (f32x4){0.f, 0.f, 0.f, 0.f};
    const int fr = lane & 15, g = lane >> 4;
    const bf16_t* ap = A + (size_t)fr * K + 8 * g; const bf16_t* bp = Bt + (size_t)(n0 + fr) * K + 8 * g;
    if constexpr (NT == 1) {
        const int nks = K / 32; bf16x8 a[SG1_U][4], b[SG1_U], a2[SG1_U][4], b2[SG1_U];
        const int ng = (nks + 8 * SG1_U - 1) / (8 * SG1_U);
        sg1_ld(ap, bp, K, nks, wave, 0, a, b);
        for (int kg = 0; kg < ng; kg += 2) { if (kg + 1 < ng) sg1_ld(ap, bp, K, nks, wave, kg + 1, a2, b2); sg1_mm(acc, nks, wave, kg, a, b); if (kg + 1 >= ng) break;
            if (kg + 2 < ng) sg1_ld(ap, bp, K, nks, wave, kg + 2, a, b); sg1_mm(acc, nks, wave, kg + 1, a2, b2); }
    } else {
    bf16x8 a[4], b[NT], a2[4], b2[NT];
    if (wave < K / 32) {
#pragma unroll
        for (int mt = 0; mt < 4; ++mt) a[mt] = *(const bf16x8*)(ap + (size_t)(16 * mt) * K + 32 * wave);
#pragma unroll
        for (int nt = 0; nt < NT; ++nt) b[nt] = *(const bf16x8*)(bp + (size_t)(16 * nt) * K + 32 * wave); }
    for (int ks = wave; ks < K / 32; ks += 8) { const int kn = (ks + 8 < K / 32) ? ks + 8 : ks;
#pragma unroll
        for (int mt = 0; mt < 4; ++mt) a2[mt] = *(const bf16x8*)(ap + (size_t)(16 * mt) * K + 32 * kn);
#pragma unroll
        for (int nt = 0; nt < NT; ++nt) b2[nt] = *(const bf16x8*)(bp + (size_t)(16 * nt) * K + 32 * kn);
#pragma unroll
        for (int mt = 0; mt < 4; ++mt)
#pragma unroll
            for (int nt = 0; nt < NT; ++nt) acc[mt][nt] = __builtin_amdgcn_mfma_f32_16x16x32_bf16(a[mt], b[nt], acc[mt][nt], 0, 0, 0);
#pragma unroll
        for (int mt = 0; mt < 4; ++mt) a[mt] = a2[mt];
#pragma unroll
        for (int nt = 0; nt < NT; ++nt) b[nt] = b2[nt]; }
    }
    MK_LAS float* slab = red + (wave & 3) * SLAB;
    if (wave < 4) {
#pragma unroll
        for (int mt = 0; mt < 4; ++mt)
#pragma unroll
            for (int nt = 0; nt < NT; ++nt)
#pragma unroll
                for (int e = 0; e < 4; ++e) slab[(16 * mt + 4 * g + e) * LDR + 16 * nt + fr] = acc[mt][nt][e]; }
    LDS_WAIT(); __syncthreads();
    if (wave >= 4) {
#pragma unroll
        for (int mt = 0; mt < 4; ++mt)
#pragma unroll
            for (int nt = 0; nt < NT; ++nt)
#pragma unroll
                for (int e = 0; e < 4; ++e) slab[(16 * mt + 4 * g + e) * LDR + 16 * nt + fr] += acc[mt][nt][e]; }
    LDS_WAIT(); __syncthreads();
}
}
namespace mk {
struct Args { const float* in[32]; float* out; unsigned char* ws; int nlayers; int pad; };
struct Frame {
    MK_LAS unsigned char* lds; unsigned* ctl; unsigned char* ws; float* out; const float* const* in;
    int tid, lane, wave, vcu, G;
};
constexpr size_t O_YP = 0, O_YS = O_YP + (size_t)MP * D, O_KVP = O_YS + (size_t)MS * D, O_KVS = O_KVP + (size_t)2 * NB * LA * 2 * WA, O_CONVP = O_KVS + (size_t)2 * SB * ST * 2 * WA,
    O_CONVS = O_CONVP + (size_t)2 * NB * 3 * WB, O_HP = O_CONVS + (size_t)2 * SB * 3 * WB, O_HS = O_HP + (size_t)2 * NB * WB, O_HGP = O_HS + (size_t)2 * SB * WB,
    O_HGS = O_HGP + (size_t)2 * NB * HC * DK * DVC, O_GLP = O_HGS + (size_t)2 * SB * HC * DK * DVC, O_GLS = O_GLP + (size_t)2 * NB * HD_ * DK * DVD, O_FFP = O_GLS + (size_t)2 * SB * HD_ * DK * DVD,
    O_FFS = O_FFP + (size_t)4 * NB * 2 * FF, O_END = O_FFS + (size_t)4 * SB * 2 * FF;
enum { I_XP = 0, I_XS, I_KV, I_SCONV, I_SH, I_SHG, I_SGL, I_SFF, I_NMIX, I_NFFN, I_WINAB, I_QN, I_KN, I_LCW, I_LCB, I_LWA, I_LBA, I_LWX, I_LBX, I_LLAM, I_WOUTAB, I_WINCD, I_LBL, I_HGN, I_WG2, I_BG, I_GLN, I_WOUTCD, I_WUP, I_FCW, I_FCB, I_WDN };

__device__ __forceinline__ float* rss_ptr(Frame& F, int idx) { return (float*)(F.ws + WS_RSS) + (size_t)idx * MP * 8; }
__device__ __forceinline__ float* rss_sptr(Frame& F, int idx) { return (float*)(F.ws + WS_RSS) + RSS_P_FLOATS + (size_t)idx * MS * 128; }
__device__ __forceinline__ float wave_sum(float v, int lane) {
#pragma unroll
    for (int o = 1; o < 64; o <<= 1) v += SHX(v, o);
    return v;
}
__device__ __forceinline__ int q_next(Frame& F, int q) {
    volatile MK_LAS int* slot = (volatile MK_LAS int*)(F.lds + MISC_OFF + 64);
    __syncthreads();
    if (F.tid == 0) *slot = (int)__hip_atomic_fetch_add(F.ctl + CW_Q + 64 * q, 1u, __ATOMIC_RELAXED, __HIP_MEMORY_SCOPE_AGENT);
    __syncthreads();
    return *slot;
}

struct P0Item { const float* W; bf16_t* WT; const float* gain; int K, ldw, n0, k0, upmap; };
__device__ __forceinline__ P0Item p0_decode(Frame& F, int it) {
    constexpr int I_AB = 32 * 20, I_O = 32 * 8, I_CD = 32 * 28, I_UP = 32 * 43, I_DN = 86 * 8;
    constexpr int PER_PAIR = I_AB + I_O + I_CD + I_O, PER_LAYER = I_UP + I_DN;
    P0Item p; int r = it; p.upmap = 0; p.gain = nullptr;
    if (r < 2 * PER_PAIR) { const int i = r / PER_PAIR; r -= i * PER_PAIR;
        if (r < I_AB) { p.W = F.in[I_WINAB] + (size_t)i * D * N_AB; p.WT = (bf16_t*)(F.ws + WS_WINAB + i * SZ_WINAB); p.gain = F.in[I_NMIX] + (2 * i) * D; p.K = D; p.ldw = N_AB; p.k0 = 64 * (r / 20); p.n0 = 256 * (r % 20); return p; } r -= I_AB;
        if (r < I_O) { p.W = F.in[I_WOUTAB] + (size_t)i * D * D; p.WT = (bf16_t*)(F.ws + WS_WOUTAB + i * SZ_WOUT); p.K = D; p.ldw = D; p.k0 = 64 * (r / 8); p.n0 = 256 * (r % 8); return p; } r -= I_O;
        if (r < I_CD) { p.W = F.in[I_WINCD] + (size_t)i * D * N_CD_SRC; p.WT = (bf16_t*)(F.ws + WS_WINCD + i * SZ_WINCD); p.gain = F.in[I_NMIX] + (2 * i + 1) * D; p.K = D; p.ldw = N_CD_SRC; p.k0 = 64 * (r / 28); p.n0 = 256 * (r % 28); return p; } r -= I_CD;
        p.W = F.in[I_WOUTCD] + (size_t)i * D * D; p.WT = (bf16_t*)(F.ws + WS_WOUTCD + i * SZ_WOUT); p.K = D; p.ldw = D; p.k0 = 64 * (r / 8); p.n0 = 256 * (r % 8); return p; }
    r -= 2 * PER_PAIR; const int l = r / PER_LAYER; r -= l * PER_LAYER;
    if (r < I_UP) { p.W = F.in[I_WUP] + (size_t)l * D * N_UP; p.WT = (bf16_t*)(F.ws + WS_WUP + l * SZ_WUP); p.gain = F.in[I_NFFN] + l * D; p.K = D; p.ldw = N_UP; p.k0 = 64 * (r / 43); p.n0 = 256 * (r % 43); p.upmap = 1; return p; } r -= I_UP;
    p.W = F.in[I_WDN] + (size_t)l * FF * D; p.WT = (bf16_t*)(F.ws + WS_WDN + l * SZ_WDN); p.K = FF; p.ldw = D; p.k0 = 64 * (r / 8); p.n0 = 256 * (r % 8); return p;
}
__device__ __forceinline__ void p0_load(const P0Item& p, int wave, int lane, f32x4 (&v)[8]) {
    const float* src = p.W + (size_t)(p.k0 + 8 * wave) * p.ldw + p.n0 + 4 * lane;
#pragma unroll
    for (int r = 0; r < 8; ++r) v[r] = *(const f32x4*)(src + (size_t)r * p.ldw);
}
__device__ __forceinline__ void p0_store(const P0Item& p, int tid, int wave, int lane, f32x4 (&v)[8], MK_LAS unsigned char* img) {
    if (p.gain) {
#pragma unroll
        for (int r = 0; r < 8; ++r) v[r] = v[r] * p.gain[p.k0 + 8 * wave + r]; }
#pragma unroll
    for (int j = 0; j < 4; ++j) { u32x4 o; o.x = pk2(v[0][j], v[1][j]); o.y = pk2(v[2][j], v[3][j]); o.z = pk2(v[4][j], v[5][j]); o.w = pk2(v[6][j], v[7][j]);
        *(MK_LAS u32x4*)(img + (4 * lane + j) * 144 + 16 * wave) = o; }
    LDS_WAIT(); __syncthreads();
#pragma unroll
    for (int q = 0; q < 4; ++q) { const int n = (tid >> 3) + 64 * q, ch = tid & 7; const int c = p.n0 + n; int drow = c;
        if (p.upmap) { const int cc = c < FF ? c : c - FF; drow = (cc >> 7) * 256 + (cc & 127) + (c < FF ? 0 : 128); }
        *(u32x4*)(p.WT + (size_t)drow * p.K + p.k0 + 8 * ch) = *(const MK_LAS u32x4*)(img + n * 144 + 16 * ch); }
}
__device__ __forceinline__ void p0_prologue(Frame& F) {
    const int gw = F.vcu * 8 + F.wave, NGW = F.G * 8; const int lane = F.lane;
    constexpr int NITEMS = 2 * (32 * 20 + 32 * 8 + 32 * 28 + 32 * 8) + 4 * (32 * 43 + 86 * 8);
    { f32x4 va[8], vb[8]; int it = F.vcu; P0Item pa, pb; MK_LAS unsigned char* img0 = F.lds; MK_LAS unsigned char* img1 = F.lds + 40960;
      if (it < NITEMS) { pa = p0_decode(F, it); p0_load(pa, F.wave, lane, va); }
      while (it < NITEMS) {
          const int it1 = it + F.G; if (it1 < NITEMS) { pb = p0_decode(F, it1); p0_load(pb, F.wave, lane, vb); }
          p0_store(pa, F.tid, F.wave, lane, va, img0);
          if (it1 >= NITEMS) break;
          const int it2 = it1 + F.G; if (it2 < NITEMS) { pa = p0_decode(F, it2); p0_load(pa, F.wave, lane, va); }
          p0_store(pb, F.tid, F.wave, lane, vb, img1);
          it = it2; }
      __syncthreads(); }
    const int gt = F.vcu * 512 + F.tid, NGT = F.G * 512;
    for (int it = gt; it < 2 * 512 * (D / 8); it += NGT) { const int k8 = it % (D / 8), n = (it / (D / 8)) % 512, i = it / (512 * (D / 8));
        const float* W = F.in[I_WINCD] + (size_t)i * D * N_CD_SRC; const float* g2 = F.in[I_WG2] + (size_t)i * 16 * 512; const float* gn = F.in[I_NMIX] + (2 * i + 1) * D; float v[8];
#pragma unroll
        for (int j = 0; j < 8; ++j) { const int k = 8 * k8 + j; float s = 0.f;
#pragma unroll
            for (int r = 0; r < 16; ++r) s += W[(size_t)k * N_CD_SRC + N_CDZ + r] * g2[r * 512 + n];
            v[j] = s * gn[k]; }
        u32x4 o; o.x = pk2(v[0], v[1]); o.y = pk2(v[2], v[3]); o.z = pk2(v[4], v[5]); o.w = pk2(v[6], v[7]);
        *(u32x4*)((bf16_t*)(F.ws + WS_WINCD + i * SZ_WINCD) + (size_t)(N_CDZ + n) * D + 8 * k8) = o; }
    for (int it = gt; it < 2 * 8 * 2 * 128 * 16; it += NGT) { const int i8 = it % 16, o_ = (it / 16) % 128, gate = (it / 2048) % 2, h = (it / 4096) % 8, i = it / 32768;
        const float* W = F.in[gate ? I_LWX : I_LWA] + ((size_t)(i * 8 + h) * 128) * 128; float v[8];
#pragma unroll
        for (int j = 0; j < 8; ++j) v[j] = W[(size_t)(8 * i8 + j) * 128 + o_];
        u32x4 o; o.x = pk2(v[0], v[1]); o.y = pk2(v[2], v[3]); o.z = pk2(v[4], v[5]); o.w = pk2(v[6], v[7]);
        *(u32x4*)((bf16_t*)(F.ws + WS_WLRU) + ((size_t)((i * 8 + h) * 2 + gate) * 128 + o_) * 128 + 8 * i8) = o; }
    for (int k = gt; k < 1024; k += NGT) { const float a = F.in[I_LBL][k], b = F.in[I_LBL][1024 + k]; const float m = fmaxf(a, b), ea = expf(a - m), eb = expf(b - m), p0 = ea / (ea + eb), p1 = eb / (ea + eb);
        float* lb = (float*)(F.ws + WS_LB); lb[k] = p0 - p0; lb[1024 + k] = (p0 + p1) - p0; }
    for (int m = gw; m < MT; m += NGW) { const float* xr = (m < MP) ? F.in[I_XP] + (size_t)m * D : F.in[I_XS] + (size_t)(m - MP) * D; bf16_t* orow = (bf16_t*)(F.ws + WS_XB16) + (size_t)m * D; float s = 0.f;
#pragma unroll
        for (int j = 0; j < 8; ++j) { const f32x4 v = *(const f32x4*)(xr + 4 * lane + 256 * j); s += (v[0] * v[0] + v[1] * v[1]) + (v[2] * v[2] + v[3] * v[3]);
            u32x2 w; w.x = pk2(v[0], v[1]); w.y = pk2(v[2], v[3]); *(u32x2*)(orow + 4 * lane + 256 * j) = w; }
        s = wave_sum(s, lane);
        if (m < MP) { if (lane < 8) rss_ptr(F, 0)[(size_t)m * 8 + lane] = lane == 0 ? s : 0.f; } else { rss_sptr(F, 0)[(size_t)(m - MP) * 128 + lane] = lane == 0 ? s : 0.f; rss_sptr(F, 0)[(size_t)(m - MP) * 128 + 64 + lane] = 0.f; } }
}

__device__ __forceinline__ void sample_units_range(Frame& F, int nwg_main, int nsu, int& s0, int& sstep) {
    const int rem = nwg_main % F.G; const int c = opaque_bid();
    if (rem == 0) { s0 = c; sstep = F.G; } else if (c >= rem) { s0 = c - rem; sstep = F.G - rem; } else { s0 = nsu; sstep = 1; }
}
__device__ __forceinline__ void sample_in_ab(Frame& F, int i, const bf16_t* Wt, const float* rss) {
    MK_LAS float* red = (MK_LAS float*)F.lds; int s0, sstep; sample_units_range(F, 32 * (N_AB / 256), N_AB / 128, s0, sstep);
    const bf16_t* A = (const bf16_t*)(F.ws + WS_XB16) + (size_t)MP * D; float* zs = (float*)(F.ws + WS_ZS);
    for (int su = s0; su < N_AB / 128; su += sstep) {
        sgemm_tile<8>(red, A, Wt, D, 128 * su, F.wave, F.lane);
        const int lane = F.lane; const int row = F.tid >> 3, part = F.tid & 7, kind = su >> 3, cw = (su & 7) * 128 + 16 * part; const float rs = fast_rsq(rss_s(rss, row) * (1.0f / D) + EPS);
        float v[16]; float ss = 0.f;
#pragma unroll
        for (int j = 0; j < 16; ++j) { v[j] = sred4<8>(red, row, 16 * part + j) * rs; ss += v[j] * v[j]; }
        if (kind <= 1) { ss += SHX(ss, 1); ss += SHX(ss, 2); ss += SHX(ss, 4); const float hs = fast_rsq(ss * (1.0f / DH) + EPS); const float* gp = F.in[kind ? I_KN : I_QN] + i * DH + 16 * part;
#pragma unroll
            for (int j = 0; j < 16; ++j) v[j] = v[j] * hs * gp[j]; }
        float* zo = zs + (size_t)row * N_CD + 128 * su + 16 * part;
#pragma unroll
        for (int j = 0; j < 16; ++j) zo[j] = v[j];
        if (kind == 1 || kind == 2) { float* o = F.out + O_KVS + (((size_t)i * MS + row) * 2 + (kind - 1)) * WA + cw;
#pragma unroll
            for (int j = 0; j < 16; ++j) o[j] = v[j]; }
        if (kind == 3 && (row & 7) >= 5) { float* o = F.out + O_CONVS + (((size_t)i * SB + (row >> 3)) * 3 + ((row & 7) - 5)) * WB + cw;
#pragma unroll
            for (int j = 0; j < 16; ++j) o[j] = v[j]; }
        __syncthreads();
    }
}
__device__ __forceinline__ void sample_plain(Frame& F, const bf16_t* Wt, const float* rss, int N, int nwg_main, float* dst, int ldd, bool up_map) {
    MK_LAS float* red = (MK_LAS float*)F.lds; int s0, sstep; sample_units_range(F, nwg_main, N / 128, s0, sstep);
    const bf16_t* A = (const bf16_t*)(F.ws + WS_XB16) + (size_t)MP * D;
    for (int su = s0; su < N / 128; su += sstep) {
        sgemm_tile<8>(red, A, Wt, D, 128 * su, F.wave, F.lane);
        const int row = F.tid >> 3, part = F.tid & 7; const float rs = fast_rsq(rss_s(rss, row) * (1.0f / D) + EPS);
        const int col = up_map ? ((su & 1) * FF + (su >> 1) * 128) : 128 * su;
        float* o = dst + (size_t)row * ldd + col + 16 * part;
#pragma unroll
        for (int j = 0; j < 16; ++j) o[j] = sred4<8>(red, row, 16 * part + j) * rs;
        __syncthreads();
    }
}
__device__ __forceinline__ void sample_res(Frame& F, const bf16_t* A, const bf16_t* Wt, int K, float* yout, float* rss_next) {
    MK_LAS float* red = (MK_LAS float*)F.lds; int s0, sstep; sample_units_range(F, 256, D / 16, s0, sstep);
    bf16_t* xb = (bf16_t*)(F.ws + WS_XB16) + (size_t)MP * D;
    for (int su = s0; su < D / 16; su += sstep) {
        sgemm_tile<1>(red, A, Wt, K, 16 * su, F.wave, F.lane);
        const int lane = F.lane; const int row = F.tid >> 3, c2 = 2 * (F.tid & 7); const size_t o = (size_t)row * D + 16 * su + c2;
        const unsigned xo = *(const unsigned*)(xb + o);
        const float v0 = bflo(xo) + sred4<1>(red, row, c2), v1 = bfhi(xo) + sred4<1>(red, row, c2 + 1);
        *(unsigned*)(xb + o) = pk2(v0, v1); if (yout) { yout[o] = v0; yout[o + 1] = v1; }
        float ss = v0 * v0 + v1 * v1; ss += SHX(ss, 1); ss += SHX(ss, 2); ss += SHX(ss, 4);
        if ((F.tid & 7) == 0) rss_next[(size_t)row * 128 + su] = ss;
        __syncthreads();
    }
}

__device__ __forceinline__ void ffn_fixup(Frame& F, int layer) {
    const int gt = F.vcu * 512 + F.tid, NGT = F.G * 512;
    const float* cw = F.in[I_FCW] + (size_t)layer * 3 * FF; const float* cb = F.in[I_FCB] + (size_t)layer * FF;
    const float* ghead = (const float*)(F.ws + WS_GHEAD); const float* gtail = (const float*)(F.ws + WS_GTAIL); bf16_t* HBp = (bf16_t*)(F.ws + WS_Z);
    for (int it = gt; it < 30 * 2 * FF; it += NGT) { const int f = it % FF, r = (it / FF) & 1, ti = it / (2 * FF); const int pm = ti + 1 + (ti >= 15 ? 1 : 0);
        const float g0 = ghead[((size_t)pm * 2 + 0) * (2 * FF) + f], t0 = gtail[((size_t)(pm - 1) * 2 + 0) * FF + f], t1 = gtail[((size_t)(pm - 1) * 2 + 1) * FF + f];
        float gc, uu;
        if (r == 0) { gc = cb[f] + cw[f] * t0 + cw[FF + f] * t1 + cw[2 * FF + f] * g0; uu = ghead[((size_t)pm * 2 + 0) * (2 * FF) + FF + f]; }
        else { const float g1 = ghead[((size_t)pm * 2 + 1) * (2 * FF) + f]; gc = cb[f] + cw[f] * t1 + cw[FF + f] * g0 + cw[2 * FF + f] * g1; uu = ghead[((size_t)pm * 2 + 1) * (2 * FF) + FF + f]; }
        HBp[(size_t)(pm * 256 + r) * FF + f] = (bf16_t)f2bf(silu_f(gc) * uu); }
    const float* gus = (const float*)(F.ws + WS_GUS); const float* sbuf = F.in[I_SFF] + (size_t)layer * SB * 2 * FF;
    for (int it = gt; it < MS * FF; it += NGT) { const int f = it % FF, row = it / FF, t = row & 7, b = row >> 3;
        const float x0 = gus[(size_t)row * N_UP + f];
        const float x1 = (t >= 1) ? gus[(size_t)(row - 1) * N_UP + f] : sbuf[((size_t)b * 2 + 1) * FF + f];
        const float x2 = (t >= 2) ? gus[(size_t)(row - 2) * N_UP + f] : sbuf[((size_t)b * 2 + t) * FF + f];
        const float gc = cb[f] + cw[f] * x2 + cw[FF + f] * x1 + cw[2 * FF + f] * x0;
        HBp[(size_t)(MP + row) * FF + f] = (bf16_t)f2bf(silu_f(gc) * gus[(size_t)row * N_UP + FF + f]);
        if (t >= 6) F.out[O_FFS + (((size_t)layer * SB + b) * 2 + (t - 6)) * FF + f] = x0; }
}
}
namespace mk {
__device__ __forceinline__ s16x4 tr_read4(unsigned addr) { s16x4 r; asm volatile("ds_read_b64_tr_b16 %0, %1\n\ts_waitcnt lgkmcnt(0)" : "=&v"(r) : "v"(addr) : "memory"); return r; }

constexpr int ATT_VSTRIDE = 288;
constexpr int ATT_PLD = 132;
struct AttTile { int tq0, tqs, kb0, dil, win, nst; };
__device__ __forceinline__ void att_load(const bf16_t* Zb, int h, int base, int dil, int lane, bf16x8 (&kf)[2][4], u32x4 (&vv)[8]) {
    const int qi = lane & 15, g = lane >> 4;
#pragma unroll
    for (int kt = 0; kt < 2; ++kt) { int s = base + dil * (16 * kt + qi); s = s < 0 ? 0 : (s > SEQ - 1 ? SEQ - 1 : s); const bf16_t* kp = Zb + (size_t)s * N_AB + WA + h * DH + 8 * g;
#pragma unroll
        for (int q = 0; q < 4; ++q) kf[kt][q] = *(const bf16x8*)(kp + 32 * q); }
#pragma unroll
    for (int j = 0; j < 8; ++j) { const int c = lane + 64 * j, r = c >> 4, ch = c & 15; int s = base + dil * r; s = s < 0 ? 0 : (s > SEQ - 1 ? SEQ - 1 : s);
        vv[j] = *(const u32x4*)(Zb + (size_t)s * N_AB + 2 * WA + h * DH + 8 * ch); }
}
struct AttState { f32x4 o[8]; float mrun, lrun; };
__device__ __forceinline__ void attn_step(AttState& A, const bf16_t* Zb, int h, int tq, int base, int dil, int win, int nbase, int ndil, int lane, MK_LAS unsigned char* vt, unsigned trb, const bf16x8 (&qf)[4],
                                          bf16x8 (&kf)[2][4], u32x4 (&vv)[8], bf16x8 (&kn)[2][4], u32x4 (&vn)[8]) {
    const int g = lane >> 4; const float sc = 0.08838834764831845f * 1.44269504089f;
#pragma unroll
    for (int j = 0; j < 8; ++j) { const int c = lane + 64 * j, r = c >> 4, ch = c & 15; *(MK_LAS u32x4*)(vt + r * ATT_VSTRIDE + 16 * ch) = vv[j]; }
    att_load(Zb, h, nbase, ndil, lane, kn, vn);
    f32x4 sv[2];
#pragma unroll
    for (int kt = 0; kt < 2; ++kt) { sv[kt] = (f32x4){0.f, 0.f, 0.f, 0.f};
#pragma unroll
        for (int q = 0; q < 4; ++q) sv[kt] = __builtin_amdgcn_mfma_f32_16x16x32_bf16(kf[kt][q], qf[q], sv[kt], 0, 0, 0); }
    float mx = -1e30f; bool val[2][4];
#pragma unroll
    for (int kt = 0; kt < 2; ++kt)
#pragma unroll
        for (int e = 0; e < 4; ++e) { const int s = base + dil * (16 * kt + 4 * g + e); const int dist = tq - s; val[kt][e] = (s >= 0) && (dist >= 0) && (dist <= win);
            sv[kt][e] = val[kt][e] ? sv[kt][e] * sc : -1e30f; mx = fmaxf(mx, sv[kt][e]); }
    mx = fmaxf(mx, SHX(mx, 16)); mx = fmaxf(mx, SHX(mx, 32));
    const float mnew = fmaxf(A.mrun, mx), alpha = fast_exp2(A.mrun - mnew); A.mrun = mnew;
    float ps = 0.f; float p[2][4];
#pragma unroll
    for (int kt = 0; kt < 2; ++kt)
#pragma unroll
        for (int e = 0; e < 4; ++e) { p[kt][e] = val[kt][e] ? fast_exp2(sv[kt][e] - mnew) : 0.f; ps += p[kt][e]; }
    A.lrun = A.lrun * alpha + ps;
    union { bf16x8 v; unsigned u[4]; } pf; pf.u[0] = cvt_pk_bf16(p[0][0], p[0][1]); pf.u[1] = cvt_pk_bf16(p[0][2], p[0][3]); pf.u[2] = cvt_pk_bf16(p[1][0], p[1][1]); pf.u[3] = cvt_pk_bf16(p[1][2], p[1][3]);
    s16x4 t0a, t1a, t2a, t3a, t4a, t5a, t6a, t7a, t0b, t1b, t2b, t3b, t4b, t5b, t6b, t7b;
    asm volatile("s_waitcnt lgkmcnt(0)\n\t"
                 "ds_read_b64_tr_b16 %0, %16\n\tds_read_b64_tr_b16 %1, %16 offset:32\n\tds_read_b64_tr_b16 %2, %16 offset:64\n\tds_read_b64_tr_b16 %3, %16 offset:96\n\t"
                 "ds_read_b64_tr_b16 %4, %16 offset:128\n\tds_read_b64_tr_b16 %5, %16 offset:160\n\tds_read_b64_tr_b16 %6, %16 offset:192\n\tds_read_b64_tr_b16 %7, %16 offset:224\n\t"
                 "ds_read_b64_tr_b16 %8, %16 offset:4608\n\tds_read_b64_tr_b16 %9, %16 offset:4640\n\tds_read_b64_tr_b16 %10, %16 offset:4672\n\tds_read_b64_tr_b16 %11, %16 offset:4704\n\t"
                 "ds_read_b64_tr_b16 %12, %16 offset:4736\n\tds_read_b64_tr_b16 %13, %16 offset:4768\n\tds_read_b64_tr_b16 %14, %16 offset:4800\n\tds_read_b64_tr_b16 %15, %16 offset:4832\n\t"
                 "s_waitcnt lgkmcnt(0)"
                 : "=&v"(t0a), "=&v"(t1a), "=&v"(t2a), "=&v"(t3a), "=&v"(t4a), "=&v"(t5a), "=&v"(t6a), "=&v"(t7a), "=&v"(t0b), "=&v"(t1b), "=&v"(t2b), "=&v"(t3b), "=&v"(t4b), "=&v"(t5b), "=&v"(t6b), "=&v"(t7b)
                 : "v"(trb) : "memory");
#define ATT_PV(d, ta, tb) { union { bf16x8 v; s16x4 hh[2]; } vf; vf.hh[0] = ta; vf.hh[1] = tb; A.o[d] = A.o[d] * alpha; A.o[d] = __builtin_amdgcn_mfma_f32_16x16x32_bf16(vf.v, pf.v, A.o[d], 0, 0, 0); }
    ATT_PV(0, t0a, t0b) ATT_PV(1, t1a, t1b) ATT_PV(2, t2a, t2b) ATT_PV(3, t3a, t3b) ATT_PV(4, t4a, t4b) ATT_PV(5, t5a, t5b) ATT_PV(6, t6a, t6b) ATT_PV(7, t7a, t7b)
#undef ATT_PV
}
__device__ __forceinline__ void att_seg(bool passB, int t0, int st, int& base, int& dil, int& win) {
    if (!passB) { base = t0 - 128 + 32 * st; dil = 1; win = 128; }
    else if (st < 6) { base = t0 - 512 + 128 * st; dil = 4; win = 512; } else { base = t0 - 2048 + 512 * (st - 6); dil = 16; win = 2048; }
}
template <bool PASSB> __device__ __forceinline__ void attn_tile(Frame& F, const bf16_t* Zb, bf16_t* MIXb, float* PB, int h, int t0blk, int tile, MK_LAS unsigned char* vt) {
    constexpr int NST = PASSB ? 11 : 5;
    const int lane = F.lane, qi = lane & 15, g = lane >> 4;
    const int t0 = PASSB ? t0blk + tile : t0blk + 16 * tile;
    const int tq = PASSB ? t0 + 16 * qi : t0 + qi; const int tl = tq - t0blk;
    bf16x8 qf[4];
#pragma unroll
    for (int s = 0; s < 4; ++s) qf[s] = *(const bf16x8*)(Zb + (size_t)tq * N_AB + h * DH + 32 * s + 8 * g);
    AttState A; float* pb = PB + (size_t)tl * ATT_PLD;
    if (PASSB) {
#pragma unroll
        for (int d = 0; d < 8; ++d) A.o[d] = *(const f32x4*)(pb + 16 * d + 4 * g);
        A.mrun = pb[128]; A.lrun = g == 0 ? pb[129] : 0.f;
    } else {
#pragma unroll
        for (int d = 0; d < 8; ++d) A.o[d] = (f32x4){0.f, 0.f, 0.f, 0.f};
        A.mrun = -1e30f; A.lrun = 0.f; }
    const unsigned vbase = (unsigned)(size_t)vt;
    const unsigned trb = vbase + (4 * g + (qi >> 2)) * ATT_VSTRIDE + (4 * (qi & 3)) * 2;
    bf16x8 k0[2][4], k1[2][4]; u32x4 v0[8], v1[8];
    { int base, dil, win; att_seg(PASSB, t0, 0, base, dil, win); att_load(Zb, h, base, dil, lane, k0, v0); }
#pragma unroll 1
    for (int st = 0; st + 1 < NST; st += 2) { int b0, d0, w0, b1, d1, w1, b2, d2, w2; att_seg(PASSB, t0, st, b0, d0, w0); att_seg(PASSB, t0, st + 1, b1, d1, w1); att_seg(PASSB, t0, st + 2 < NST ? st + 2 : st + 1, b2, d2, w2);
        attn_step(A, Zb, h, tq, b0, d0, w0, b1, d1, lane, vt, trb, qf, k0, v0, k1, v1); attn_step(A, Zb, h, tq, b1, d1, w1, b2, d2, lane, vt, trb, qf, k1, v1, k0, v0); }
    { int b0, d0, w0; att_seg(PASSB, t0, NST - 1, b0, d0, w0); attn_step(A, Zb, h, tq, b0, d0, w0, b0, d0, lane, vt, trb, qf, k0, v0, k1, v1); }
    float lrun = A.lrun; lrun += SHX(lrun, 16); lrun += SHX(lrun, 32);
    if (PASSB) { const float inv = fast_rcp(lrun); bf16_t* op = MIXb + (size_t)tq * D + h * DH + 4 * g;
#pragma unroll
        for (int d = 0; d < 8; ++d) { u32x2 w; w.x = cvt_pk_bf16(A.o[d][0] * inv, A.o[d][1] * inv); w.y = cvt_pk_bf16(A.o[d][2] * inv, A.o[d][3] * inv); *(u32x2*)(op + 16 * d) = w; }
    } else {
#pragma unroll
        for (int d = 0; d < 8; ++d) *(f32x4*)(pb + 16 * d + 4 * g) = A.o[d];
        if (g == 0) { pb[128] = A.mrun; pb[129] = lrun; } }
}
__device__ __forceinline__ void attn_block(Frame& F, const bf16_t* Z, bf16_t* MIX, int item) {
    const int blk = item & 15, h = (item >> 4) & 7, b = item >> 7; const int w = F.wave;
    const bf16_t* Zb = Z + (size_t)b * SEQ * N_AB; bf16_t* MIXb = MIX + (size_t)b * SEQ * D; float* PB = (float*)(F.ws + WS_LG + MiB) + (size_t)item * 256 * ATT_PLD;
    MK_LAS unsigned char* vt = F.lds + w * (32 * ATT_VSTRIDE);
    attn_tile<false>(F, Zb, MIXb, PB, h, 256 * blk, 2 * w, vt); attn_tile<false>(F, Zb, MIXb, PB, h, 256 * blk, 2 * w + 1, vt);
    VM_WAIT(); __syncthreads();
    attn_tile<true>(F, Zb, MIXb, PB, h, 256 * blk, 2 * w, vt); attn_tile<true>(F, Zb, MIXb, PB, h, 256 * blk, 2 * w + 1, vt);
}

__device__ __forceinline__ void sattn_item(Frame& F, int i, int item) {
    const int lane = F.lane, li = lane & 15, g = lane >> 4; const int h = item & 7, t = (item >> 3) & 7, b = item >> 6; const int row = b * 8 + t;
    const float* zs = (const float*)(F.ws + WS_ZS); const float* cache = F.in[I_KV] + (size_t)(i * SB + b) * LA * 2 * WA; const float* kvn = F.out + O_KVS + (size_t)(i * SB + b) * ST * 2 * WA;
    float q[8]; { const f32x4 a = *(const f32x4*)(zs + (size_t)row * N_CD + h * DH + 8 * li), c = *(const f32x4*)(zs + (size_t)row * N_CD + h * DH + 8 * li + 4);
#pragma unroll
        for (int j = 0; j < 4; ++j) { q[j] = a[j]; q[4 + j] = c[j]; } }
    float m = -1e30f, l = 0.f, acc[8];
#pragma unroll
    for (int j = 0; j < 8; ++j) acc[j] = 0.f;
    const float sc = 0.08838834764831845f;
    for (int kb = g; kb < 3 * 129; kb += 16) {
        f32x4 kq[4][2], vq[4][2]; bool ok[4];
#pragma unroll
        for (int u = 0; u < 4; ++u) { const int kk = kb + 4 * u; ok[u] = kk < 3 * 129; const int k2 = ok[u] ? kk : 0; const int grp = k2 / 129, j = k2 - grp * 129; const int dil = grp == 0 ? 1 : (grp == 1 ? 4 : 16); const int idx = LA + t - dil * j;
            const float* kp = (idx < LA) ? cache + ((size_t)idx * 2) * WA + h * DH + 8 * li : kvn + ((size_t)(idx - LA) * 2) * WA + h * DH + 8 * li;
            kq[u][0] = *(const f32x4*)kp; kq[u][1] = *(const f32x4*)(kp + 4); vq[u][0] = *(const f32x4*)(kp + WA); vq[u][1] = *(const f32x4*)(kp + WA + 4); }
#pragma unroll
        for (int u = 0; u < 4; ++u) { const f32x4 k0 = kq[u][0], k1 = kq[u][1], v0 = vq[u][0], v1 = vq[u][1];
            float s = (q[0] * k0[0] + q[1] * k0[1]) + (q[2] * k0[2] + q[3] * k0[3]) + (q[4] * k1[0] + q[5] * k1[1]) + (q[6] * k1[2] + q[7] * k1[3]);
            s += SHX(s, 1); s += SHX(s, 2); s += SHX(s, 4); s += SHX(s, 8); s *= sc;
            if (ok[u]) { const float mn = fmaxf(m, s), al = fast_exp(m - mn), pw = fast_exp(s - mn); l = l * al + pw; m = mn;
#pragma unroll
                for (int jj = 0; jj < 4; ++jj) { acc[jj] = acc[jj] * al + pw * v0[jj]; acc[4 + jj] = acc[4 + jj] * al + pw * v1[jj]; } } } }
    float mm = fmaxf(m, SHX(m, 16)); mm = fmaxf(mm, SHX(mm, 32)); const float f = fast_exp(m - mm); l *= f; l += SHX(l, 16); l += SHX(l, 32);
#pragma unroll
    for (int j = 0; j < 8; ++j) { acc[j] *= f; acc[j] += SHX(acc[j], 16); acc[j] += SHX(acc[j], 32); }
    if (g == 0) { const float inv = fast_rcp(l); u32x4 w; w.x = pk2(acc[0] * inv, acc[1] * inv); w.y = pk2(acc[2] * inv, acc[3] * inv); w.z = pk2(acc[4] * inv, acc[5] * inv); w.w = pk2(acc[6] * inv, acc[7] * inv);
        *(u32x4*)((bf16_t*)(F.ws + WS_MIX) + (size_t)(MP + row) * D + h * DH + 8 * li) = w; }
}

constexpr int LRU_SEG = 256, LRU_NSEG = SEQ / LRU_SEG;
__device__ __forceinline__ void lru_unit(Frame& F, int i, int unit, const bf16_t* Z, bf16_t* MIX) {
    const int seg = unit & 15, hB = (unit >> 4) & 7, b = unit >> 7; const int tid = F.tid, lane = F.lane, w = F.wave, fr = lane & 15, g = lane >> 4;
    MK_LAS float* xc = (MK_LAS float*)F.lds; constexpr int LDX = 132;
    const int ch0 = hB * 128; const int c = ch0 + 16 * w + fr;
    bf16_t* CB = (bf16_t*)(F.ws + WS_SC); float* SUM = (float*)(F.ws + WS_LG);
    const bf16_t* Wl = (const bf16_t*)(F.ws + WS_WLRU) + (size_t)((i * 8 + hB) * 2) * 128 * 128;
    bf16x8 wf[2][4];
#pragma unroll
    for (int gt = 0; gt < 2; ++gt)
#pragma unroll
        for (int s = 0; s < 4; ++s) wf[gt][s] = *(const bf16x8*)(Wl + ((size_t)gt * 128 + 16 * w + fr) * 128 + 32 * s + 8 * g);
    const float ba = F.in[I_LBA][i * WB + c], bx = F.in[I_LBX][i * WB + c]; const float lam = F.in[I_LLAM][i * WB + c];
    const float dk = -8.0f * softplus_acc(-lam);
    const int sc8 = 8 * (tid & 15), stl = tid >> 4;
    float cwv[4][8], cbv[8];
#pragma unroll
    for (int j = 0; j < 8; ++j) { cbv[j] = F.in[I_LCB][i * WB + ch0 + sc8 + j];
#pragma unroll
        for (int tp = 0; tp < 4; ++tp) cwv[tp][j] = F.in[I_LCW][((size_t)i * 4 + tp) * WB + ch0 + sc8 + j]; }
    float hcar = 0.f, pcar = 1.f;
    const bf16_t* Zb = Z + (size_t)b * SEQ * N_AB;
    for (int ck = 0; ck < LRU_SEG / 128; ++ck) { const int tb = seg * LRU_SEG + 128 * ck;
#pragma unroll
        for (int ps = 0; ps < 4; ++ps) { const int tl = stl + 32 * ps, t = tb + tl; float a[8];
#pragma unroll
            for (int j = 0; j < 8; ++j) a[j] = cbv[j];
#pragma unroll
            for (int tp = 0; tp < 4; ++tp) { const int tt = t - 3 + tp; if (tt >= 0) { const u32x4 v = *(const u32x4*)(Zb + (size_t)tt * N_AB + 3 * WA + ch0 + sc8);
                    a[0] += cwv[tp][0] * bflo(v.x); a[1] += cwv[tp][1] * bfhi(v.x); a[2] += cwv[tp][2] * bflo(v.y); a[3] += cwv[tp][3] * bfhi(v.y);
                    a[4] += cwv[tp][4] * bflo(v.z); a[5] += cwv[tp][5] * bfhi(v.z); a[6] += cwv[tp][6] * bflo(v.w); a[7] += cwv[tp][7] * bfhi(v.w); } }
            *(MK_LAS f32x4*)(xc + tl * LDX + sc8) = (f32x4){a[0], a[1], a[2], a[3]}; *(MK_LAS f32x4*)(xc + tl * LDX + sc8 + 4) = (f32x4){a[4], a[5], a[6], a[7]}; }
        LDS_WAIT(); __syncthreads();
#pragma unroll 2
        for (int mt = 0; mt < 8; ++mt) {
            float gbv[4];
#pragma unroll
            for (int e = 0; e < 4; ++e) gbv[e] = bf2f(Zb[(size_t)(tb + 16 * mt + 4 * g + e) * N_AB + 3 * WA + WB + c]);
            f32x4 cr = (f32x4){0.f, 0.f, 0.f, 0.f}, ci = (f32x4){0.f, 0.f, 0.f, 0.f};
#pragma unroll
            for (int s = 0; s < 4; ++s) { const MK_LAS float* xp = xc + (16 * mt + fr) * LDX + 32 * s + 8 * g; const f32x4 x0 = *(const MK_LAS f32x4*)xp, x1 = *(const MK_LAS f32x4*)(xp + 4);
                union { bf16x8 v; unsigned u[4]; } af; af.u[0] = cvt_pk_bf16(x0[0], x0[1]); af.u[1] = cvt_pk_bf16(x0[2], x0[3]); af.u[2] = cvt_pk_bf16(x1[0], x1[1]); af.u[3] = cvt_pk_bf16(x1[2], x1[3]);
                cr = __builtin_amdgcn_mfma_f32_16x16x32_bf16(af.v, wf[0][s], cr, 0, 0, 0); ci = __builtin_amdgcn_mfma_f32_16x16x32_bf16(af.v, wf[1][s], ci, 0, 0, 0); }
            float P[4], H[4]; float pa = 1.f, hh = 0.f;
#pragma unroll
            for (int e = 0; e < 4; ++e) { const float r = sigmoid_f(cr[e] + ba), ig = sigmoid_f(ci[e] + bx); const float la = dk * r; const float a = fast_exp(la);
                const float xv = xc[(16 * mt + 4 * g + e) * LDX + 16 * w + fr]; const float u = fast_sqrt(one_minus_exp(2.0f * la)) * ig * xv;
                pa = pa * a; hh = a * hh + u; P[e] = pa; H[e] = hh; }
            float ip = pa, ih = hh;
            { const float pp = SHUP(ip, 16), ph = SHUP(ih, 16); if (g >= 1) { ih = ip * ph + ih; ip = ip * pp; } }
            { const float pp = SHUP(ip, 32), ph = SHUP(ih, 32); if (g >= 2) { ih = ip * ph + ih; ip = ip * pp; } }
            float ep = SHUP(ip, 16), eh = SHUP(ih, 16); if (g == 0) { ep = 1.f; eh = 0.f; }
            const float hin = ep * hcar + eh;
            const float pin = pcar * ep;
            const float tot_p = SHL(ip, 48 + fr), tot_h = SHL(ih, 48 + fr);
            hcar = tot_p * hcar + tot_h; pcar = pcar * tot_p;
#pragma unroll
            for (int e = 0; e < 4; ++e) { const float hv = P[e] * hin + H[e]; const size_t row = (size_t)b * SEQ + tb + 16 * mt + 4 * g + e; const float ge = gelu_tanh_f(gbv[e]);
                MIX[row * D + WA + c] = (bf16_t)f2bf(hv * ge); CB[row * WB + c] = (bf16_t)f2bf(pin * P[e] * ge); }
        }
        __syncthreads();
    }
    if (g == 0) { float* sp = SUM + ((size_t)((b * 8 + hB) * LRU_NSEG + seg) * 2) * 128 + 16 * w + fr; sp[0] = pcar; sp[128] = hcar; }
}
__device__ __forceinline__ void lru_fix_item(Frame& F, int i, int item) {
    const int tid = F.tid; MK_LAS float* hin = (MK_LAS float*)F.lds;
    const float* SUM = (const float*)(F.ws + WS_LG); const bf16_t* CB = (const bf16_t*)(F.ws + WS_SC); bf16_t* MIX = (bf16_t*)(F.ws + WS_MIX);
    int b, seg, sub; if (item < 240) { b = item / 120; const int r = item % 120; seg = 1 + r / 8; sub = r % 8; } else { b = item - 240; seg = LRU_NSEG; sub = 0; }
    for (int c = tid; c < WB; c += 512) { const int hB = c >> 7, cc = c & 127; float h = 0.f; const float* sp = SUM + ((size_t)((b * 8 + hB) * LRU_NSEG) * 2) * 128 + cc;
        for (int s = 0; s < seg; ++s) h = sp[(size_t)s * 256] * h + sp[(size_t)s * 256 + 128];
        if (item < 240) hin[c] = h; else F.out[O_HP + ((size_t)i * NB + b) * WB + c] = h; }
    LDS_WAIT(); __syncthreads();
    if (item < 240) {
#pragma unroll
        for (int j = 0; j < 8; ++j) { const int gi = tid + 512 * j, tl = gi >> 7, c8 = (gi & 127) * 8; const size_t row = (size_t)b * SEQ + seg * LRU_SEG + 32 * sub + tl;
            const u32x4 cv = *(const u32x4*)(CB + row * WB + c8); u32x4 mv = *(const u32x4*)(MIX + row * D + WA + c8); const f32x4 h0 = *(const MK_LAS f32x4*)(hin + c8), h1 = *(const MK_LAS f32x4*)(hin + c8 + 4);
            mv.x = pk2(bflo(mv.x) + bflo(cv.x) * h0[0], bfhi(mv.x) + bfhi(cv.x) * h0[1]); mv.y = pk2(bflo(mv.y) + bflo(cv.y) * h0[2], bfhi(mv.y) + bfhi(cv.y) * h0[3]);
            mv.z = pk2(bflo(mv.z) + bflo(cv.z) * h1[0], bfhi(mv.z) + bfhi(cv.z) * h1[1]); mv.w = pk2(bflo(mv.w) + bflo(cv.w) * h1[2], bfhi(mv.w) + bfhi(cv.w) * h1[3]);
            *(u32x4*)(MIX + row * D + WA + c8) = mv; } }
    __syncthreads();
}
__device__ __forceinline__ void slru_unit(Frame& F, int i, int unit) {
    const int b = unit >> 3, hB = unit & 7, tid = F.tid; const float* zs = (const float*)(F.ws + WS_ZS);
    MK_LAS float* xc = (MK_LAS float*)F.lds;
    MK_LAS float* gr = xc + 1024;
    MK_LAS float* gi = gr + 1024;
    const int ch0 = hB * 128;
    for (int e = tid; e < 1024; e += 512) { const int cc = e & 127, t = e >> 7; const int c = ch0 + cc; float y = F.in[I_LCB][i * WB + c];
#pragma unroll
        for (int tp = 0; tp < 4; ++tp) { const int tt = t - 3 + tp; const float v = (tt >= 0) ? zs[(size_t)(b * 8 + tt) * N_CD + 3 * WA + c] : F.in[I_SCONV][(((size_t)i * SB + b) * 3 + (tt + 3)) * WB + c];
            y += F.in[I_LCW][((size_t)i * 4 + tp) * WB + c] * v; }
        xc[t * 128 + cc] = y; }
    __syncthreads();
    for (int e = tid; e < 2048; e += 512) { const int cc = e & 127, t = (e >> 7) & 7, gate = e >> 10; const float* W = F.in[gate ? I_LWX : I_LWA] + (size_t)(i * 8 + hB) * 128 * 128; float s = 0.f;
        for (int k = 0; k < 128; ++k) s += xc[t * 128 + k] * W[(size_t)k * 128 + cc];
        const int c = ch0 + cc; s += F.in[gate ? I_LBX : I_LBA][i * WB + c]; (gate ? gi : gr)[t * 128 + cc] = sigmoid_f(s); }
    __syncthreads();
    if (tid < 128) { const int cc = tid, c = ch0 + cc; const float lam = F.in[I_LLAM][i * WB + c]; const float spl = softplus_acc(-lam);
        float h = F.in[I_SH][((size_t)i * SB + b) * WB + c];
        for (int t = 0; t < 8; ++t) { const float la = -8.0f * gr[t * 128 + cc] * spl, a = fast_exp(la); const float u = fast_sqrt(one_minus_exp(2.0f * la)) * gi[t * 128 + cc] * xc[t * 128 + cc];
            h = a * h + u; const float gb = zs[(size_t)(b * 8 + t) * N_CD + 3 * WA + WB + c];
            const float ge = gelu_tanh_f(gb);
            ((bf16_t*)(F.ws + WS_MIX))[(size_t)(MP + b * 8 + t) * D + WA + c] = (bf16_t)f2bf(h * ge); }
        F.out[O_HS + ((size_t)i * SB + b) * WB + c] = h; }
    __syncthreads();
}

template <int WHAT  > __device__ __forceinline__ void mixer_ab(Frame& F0, int i, int qid) {
    const bf16_t* Z = (const bf16_t*)(F0.ws + WS_Z); bf16_t* MIX = (bf16_t*)(F0.ws + WS_MIX);
    constexpr int N_LRU = 256, N_SLRU = 64, N_SATT = 64, N_ATT = 256, N_ALL = N_LRU + N_SLRU + N_SATT + N_ATT;
    for (;;) { const int u = q_next(F0, qid); if (u >= N_ALL) break;
        Frame F = F0; F.tid = opaque_tid(F0.wave); F.lane = F.tid & 63;
        if (WHAT == 1 && u < N_LRU + N_SLRU + N_SATT) continue; if (WHAT == 2 && u >= N_LRU) break;
        if (u < N_LRU) lru_unit(F, i, u, Z, MIX);
        else if (u < N_LRU + N_SLRU) slru_unit(F, i, u - N_LRU);
        else if (u < N_LRU + N_SLRU + N_SATT) sattn_item(F, i, (u - N_LRU - N_SLRU) * 8 + F.wave);
        else attn_block(F, Z, MIX, u - N_LRU - N_SLRU - N_SATT); }
}
__device__ __forceinline__ void mixer_ab_fix(Frame& F, int i, int qid) { (void)qid; for (int u = F.vcu; u < 242; u += F.G) lru_fix_item(F, i, u); }
}
namespace mk {
struct GlaCfg { int H, V, qcol, kcol, vcol, gcol, lgld, mixcol; const float* lg; const float* gain; bf16_t* sc; };
__device__ __forceinline__ GlaCfg gla_cfg(Frame& F, int i, int kind) {
    GlaCfg c;
    if (kind == 0) { c.H = HC; c.V = DVC; c.qcol = ZC_QC; c.kcol = ZC_KC; c.vcol = ZC_IC; c.gcol = ZC_GC; c.lgld = 1024; c.mixcol = 0; c.lg = (const float*)(F.ws + WS_LG); c.gain = F.in[I_HGN] + i * DVC; c.sc = (bf16_t*)(F.ws + WS_SC); }
    else { c.H = HD_; c.V = DVD; c.qcol = ZC_QD; c.kcol = ZC_KD; c.vcol = ZC_VD; c.gcol = ZC_RD; c.lgld = 512; c.mixcol = 1024; c.lg = (const float*)(F.ws + WS_LG) + (size_t)MP * 1024; c.gain = F.in[I_GLN] + i * DVD; c.sc = (bf16_t*)(F.ws + WS_SC) + (size_t)NB * HC * NCHUNK * DVC * 128; }
    return c;
}
__device__ __forceinline__ void x2_unit(Frame& F, int i, int unit) {
    const int kind = unit >> 7; const int u = unit & 127; const GlaCfg c = gla_cfg(F, i, kind);
    const int nvs = c.V / 16; const int vs = u % nvs, hd = (u / nvs) % c.H, b = u / (nvs * c.H);
    const int lane = F.lane, w = F.wave, fr = lane & 15, g = lane >> 4;
    const bf16_t* Z = (const bf16_t*)(F.ws + WS_Z) + (size_t)b * SEQ * N_CDZ; const float* LG = c.lg + (size_t)b * SEQ * c.lgld + hd * 128 + 16 * w + fr;
    const bf16_t* Kp = Z + c.kcol + hd * 128 + 16 * w + fr; const bf16_t* Vp = Z + c.vcol + hd * c.V + 16 * vs + fr;
    bf16_t* SCp = c.sc + ((size_t)(b * c.H + hd) * NCHUNK) * c.V * 128 + (size_t)(16 * vs + fr) * 128 + 16 * w + 4 * g;
    f32x4 S = (f32x4){0.f, 0.f, 0.f, 0.f};
    float nlg[2][8]; unsigned short nkv[2][8], nvv[2][8];
#pragma unroll
    for (int ks = 0; ks < 2; ++ks)
#pragma unroll
        for (int j = 0; j < 8; ++j) { const size_t t = 32 * ks + 8 * g + j; nlg[ks][j] = LG[t * c.lgld]; nkv[ks][j] = Kp[t * N_CDZ]; nvv[ks][j] = Vp[t * N_CDZ]; }
#pragma unroll 1
    for (int ck = 0; ck < NCHUNK; ++ck) {
        float lg[2][8]; unsigned short kv[2][8], vv[2][8];
#pragma unroll
        for (int ks = 0; ks < 2; ++ks)
#pragma unroll
            for (int j = 0; j < 8; ++j) { lg[ks][j] = nlg[ks][j]; kv[ks][j] = nkv[ks][j]; vv[ks][j] = nvv[ks][j]; }
        if (ck + 1 < NCHUNK) { const size_t t0 = 64 * (ck + 1) + 8 * g;
            auto pl = launder(LG + t0 * c.lgld); auto pk = launder(Kp + t0 * N_CDZ); auto pv = launder(Vp + t0 * N_CDZ);
#pragma unroll
            for (int ks = 0; ks < 2; ++ks) {
#pragma unroll
                for (int j = 0; j < 8; ++j) { nlg[ks][j] = pl[(size_t)j * c.lgld]; nkv[ks][j] = pk[(size_t)j * N_CDZ]; nvv[ks][j] = pv[(size_t)j * N_CDZ]; }
                pl = launder(pl + (size_t)32 * c.lgld); pk = launder(pk + (size_t)32 * N_CDZ); pv = launder(pv + (size_t)32 * N_CDZ); } }
        { u32x2 wv; wv.x = cvt_pk_bf16(S[0], S[1]); wv.y = cvt_pk_bf16(S[2], S[3]); *(u32x2*)(SCp + (size_t)ck * c.V * 128) = wv; }
        float tot[2];
#pragma unroll
        for (int ks = 0; ks < 2; ++ks) {
#pragma unroll
            for (int j = 1; j < 8; ++j) lg[ks][j] += lg[ks][j - 1];
            float inc = lg[ks][7];
            { const float p = SHUP(inc, 16); if (g >= 1) inc += p; }
            { const float p = SHUP(inc, 32); if (g >= 2) inc += p; }
            float ex = SHUP(inc, 16); if (g == 0) ex = 0.f;
            tot[ks] = SHL(inc, 48 + fr);
#pragma unroll
            for (int j = 0; j < 8; ++j) lg[ks][j] += ex + (ks ? tot[0] : 0.f);
        }
        const float blast = tot[0] + tot[1];
        union { bf16x8 v; unsigned u[4]; } af[2], bf[2];
#pragma unroll
        for (int ks = 0; ks < 2; ++ks) { float kd[8];
#pragma unroll
            for (int j = 0; j < 8; ++j) kd[j] = bf2f(kv[ks][j]) * fast_exp(blast - lg[ks][j]);
#pragma unroll
            for (int j = 0; j < 4; ++j) { af[ks].u[j] = cvt_pk_bf16(kd[2 * j], kd[2 * j + 1]); bf[ks].u[j] = (unsigned)vv[ks][2 * j] | ((unsigned)vv[ks][2 * j + 1] << 16); } }
#pragma unroll
        for (int e = 0; e < 4; ++e) S[e] *= fast_exp(SHL(blast, 4 * g + e));
        S = __builtin_amdgcn_mfma_f32_16x16x32_bf16(af[0].v, bf[0].v, S, 0, 0, 0);
        S = __builtin_amdgcn_mfma_f32_16x16x32_bf16(af[1].v, bf[1].v, S, 0, 0, 0);
    }
    float* so = F.out + (kind == 0 ? O_HGP : O_GLP) + (((size_t)i * NB + b) * c.H + hd) * 128 * c.V + (size_t)(16 * w + 4 * g) * c.V + 16 * vs + fr;
#pragma unroll
    for (int e = 0; e < 4; ++e) so[(size_t)e * c.V] = S[e];
}

template <int V> __device__ __forceinline__ void scd_unit_t(Frame& F, int i, int kind, int b, int hd) {
    constexpr int KQ = 512 / V, KN = 128 / KQ;
    const int tid = F.tid; const float* zs = (const float*)(F.ws + WS_ZS);
    MK_LAS float* sq = (MK_LAS float*)F.lds;
    MK_LAS float* sk = sq + 1024;
    MK_LAS float* sl = sk + 1024;
    MK_LAS float* sv = sl + 1024;
    MK_LAS float* po = sv + 8 * V;
    MK_LAS float* rsd = po + KQ * 8 * V;
    const float* lb = (const float*)(F.ws + WS_LB) + i * 1024;
    for (int e = tid; e < 1024; e += 512) { const int k = e & 127, t = e >> 7; const float* zr = zs + (size_t)(b * 8 + t) * N_CD;
        if (kind == 0) { const float z = zr[ZC_KC + hd * 128 + k], l = lb[hd * 128 + k]; const float sg = sigmoid_f(z); sq[e] = zr[ZC_QC + hd * 128 + k]; sk[e] = (1.0f - l) * (1.0f - sg); sl[e] = l + (1.0f - l) * sg; }
        else { const float x = zr[N_CDZ + hd * 128 + k] + F.in[I_BG][i * 512 + hd * 128 + k]; const float ls = fminf(x, 0.f) - fast_ln(1.0f + fast_exp(-fabsf(x))); sq[e] = zr[ZC_QD + hd * 128 + k] * 0.08838834764831845f; sk[e] = zr[ZC_KD + hd * 128 + k]; sl[e] = fast_exp(ls * 0.0625f); } }
    for (int e = tid; e < 8 * V; e += 512) { const int v = e % V, t = e / V; sv[e] = zs[(size_t)(b * 8 + t) * N_CD + (kind == 0 ? ZC_IC : ZC_VD) + hd * V + v]; }
    __syncthreads();
    const int v = tid % V, kq = tid / V; const float* s0 = F.in[kind == 0 ? I_SHG : I_SGL] + ((((size_t)i * SB + b) * (kind == 0 ? HC : HD_) + hd) * 128) * V;
    float S[KN];
    { auto sp = launder(s0 + (size_t)(kq * KN) * V + v);
#pragma unroll
      for (int kk = 0; kk < KN; ++kk) { S[kk] = *sp; sp = launder(sp + V); } }
    for (int t = 0; t < 8; ++t) { const float vt = sv[t * V + v]; float acc = 0.f;
#pragma unroll
        for (int kk = 0; kk < KN; ++kk) { const int k = kq * KN + kk; S[kk] = sl[t * 128 + k] * S[kk] + sk[t * 128 + k] * vt; acc += sq[t * 128 + k] * S[kk]; }
        po[(kq * 8 + t) * V + v] = acc; }
    float* so = F.out + (kind == 0 ? O_HGS : O_GLS) + ((((size_t)i * SB + b) * (kind == 0 ? HC : HD_) + hd) * 128) * V;
    { auto sp = launder(so + (size_t)(kq * KN) * V + v);
#pragma unroll
      for (int kk = 0; kk < KN; ++kk) { *sp = S[kk]; sp = launder(sp + V); } }
    __syncthreads();
    for (int e = tid; e < 8 * V; e += 512) { float a = 0.f;
#pragma unroll
        for (int q = 0; q < KQ; ++q) a += po[q * 8 * V + e];
        po[e] = a; }
    __syncthreads();
    if (tid < 8) { float s = 0.f; for (int vv = 0; vv < V; ++vv) s += po[tid * V + vv] * po[tid * V + vv]; rsd[tid] = fast_rsq(s * (1.0f / V) + EPS); }
    __syncthreads();
    const float* gain = F.in[kind == 0 ? I_HGN : I_GLN] + i * V;
    for (int e = tid; e < 8 * V; e += 512) { const int vv = e % V, t = e / V; const float gt = zs[(size_t)(b * 8 + t) * N_CD + (kind == 0 ? ZC_GC : ZC_RD) + hd * V + vv];
        const float y = po[e] * rsd[t] * gain[vv] * silu_f(gt);
        ((bf16_t*)(F.ws + WS_MIX))[(size_t)(MP + b * 8 + t) * D + (kind == 0 ? 0 : 1024) + hd * V + vv] = (bf16_t)f2bf(y); }
    __syncthreads();
}
__device__ __forceinline__ void scd_unit(Frame& F, int i, int unit) {
    if (unit < 64) scd_unit_t<DVC>(F, i, 0, unit >> 3, unit & 7); else { const int u = unit - 64; scd_unit_t<DVD>(F, i, 1, u >> 2, u & 3); }
}

template <int V> __device__ __forceinline__ void x3_unit_t(Frame& F, const GlaCfg& c, int b, int hd, int ck) {
    constexpr int LDQ = 272, LDV = 2 * V + 32, LDA = 144;
    constexpr int NT = V / 32;
    MK_LAS unsigned char* QE = F.lds; MK_LAS unsigned char* QH = QE + 64 * LDQ; MK_LAS unsigned char* KH = QH + 64 * LDQ; MK_LAS unsigned char* VT = KH + 64 * LDQ;
    MK_LAS unsigned char* AM = VT + 64 * LDV; MK_LAS float* QT = (MK_LAS float*)(AM + 64 * LDA);
    MK_LAS float* SS = QT + 512;
    const int tid = F.tid, lane = F.lane, w = F.wave, fr = lane & 15, g = lane >> 4; const int tb = 64 * ck;
    const bf16_t* Z = (const bf16_t*)(F.ws + WS_Z) + ((size_t)b * SEQ + tb) * N_CDZ; const float* LG = c.lg + ((size_t)b * SEQ + tb) * c.lgld + hd * 128;
    { const int ch = tid & 127, tq = tid >> 7; float cum[16]; float run = 0.f;
        { auto pl = launder(LG + (size_t)(16 * tq) * c.lgld + ch);
#pragma unroll
          for (int j = 0; j < 16; ++j) { run += *pl; cum[j] = run; pl = launder(pl + c.lgld); } }
        QT[tq * 128 + ch] = run;
        unsigned short qv[16], kv[16];
        { auto pq = launder(Z + (size_t)(16 * tq) * N_CDZ + c.qcol + hd * 128 + ch); const int kdelta = c.kcol - c.qcol;
#pragma unroll
          for (int j = 0; j < 16; ++j) { qv[j] = pq[0]; kv[j] = pq[kdelta]; pq = launder(pq + N_CDZ); } }
        LDS_WAIT(); __syncthreads();
        const float q0 = QT[ch], q1 = QT[128 + ch], q2 = QT[256 + ch]; const float off = tq == 0 ? 0.f : (tq == 1 ? q0 : (tq == 2 ? q0 + q1 : q0 + q1 + q2)); const float bmid = q0 + q1;
#pragma unroll
        for (int j = 0; j < 16; ++j) { const float bb = cum[j] + off; const float qf = bf2f(qv[j]), kf = bf2f(kv[j]); const int t = 16 * tq + j;
            *(MK_LAS unsigned short*)(QE + t * LDQ + 2 * ch) = (unsigned short)f2bf(qf * fast_exp(bb));
            *(MK_LAS unsigned short*)(QH + t * LDQ + 2 * ch) = (unsigned short)f2bf(qf * fast_exp(fminf(bb - bmid, 80.f)));
            *(MK_LAS unsigned short*)(KH + t * LDQ + 2 * ch) = (unsigned short)f2bf(kf * fast_exp(fminf(bmid - bb, 80.f))); }
        constexpr int CPR = V / 8;
        for (int e = tid; e < 64 * CPR; e += 512) { const int t = e / CPR, chk = e % CPR; *(MK_LAS u32x4*)(VT + t * LDV + 16 * chk) = *(const u32x4*)(Z + (size_t)t * N_CDZ + c.vcol + hd * V + 8 * chk); }
    }
    LDS_WAIT(); __syncthreads();
    { const int ti = w >> 1;
#pragma unroll
        for (int jj = 0; jj < 2; ++jj) { const int sj = 2 * (w & 1) + jj; f32x4 a = (f32x4){0.f, 0.f, 0.f, 0.f};
            if (sj <= ti) {
#pragma unroll
                for (int ks = 0; ks < 4; ++ks) { const bf16x8 qa = *(const MK_LAS bf16x8*)(QH + (16 * ti + fr) * LDQ + 64 * ks + 16 * g), kb = *(const MK_LAS bf16x8*)(KH + (16 * sj + fr) * LDQ + 64 * ks + 16 * g);
                    a = __builtin_amdgcn_mfma_f32_16x16x32_bf16(qa, kb, a, 0, 0, 0); } }
#pragma unroll
            for (int e = 0; e < 4; ++e) { const int t = 16 * ti + 4 * g + e, s = 16 * sj + fr; *(MK_LAS unsigned short*)(AM + t * LDA + 2 * s) = (unsigned short)f2bf(s <= t ? a[e] : 0.f); } } }
    LDS_WAIT(); __syncthreads();
    const int mt = w & 3, vh = w >> 2; f32x4 o[NT];
#pragma unroll
    for (int n = 0; n < NT; ++n) o[n] = (f32x4){0.f, 0.f, 0.f, 0.f};
    const unsigned vtb = (unsigned)(size_t)VT; const int q4 = fr >> 2, p4 = fr & 3;
    const bf16_t* SCp = c.sc + (((size_t)(b * c.H + hd) * NCHUNK + ck) * V) * 128 + (size_t)((V / 2) * vh + fr) * 128 + 8 * g;
    bf16x8 sbA[NT], sbB[NT]; unsigned short gv[4][NT]; float gn[NT];
#pragma unroll
    for (int n = 0; n < NT; ++n) sbA[n] = *(const bf16x8*)(SCp + (size_t)(16 * n) * 128);
#pragma unroll
    for (int ks = 0; ks < 2; ++ks) { if (32 * ks <= 16 * mt + 15) { const bf16x8 aa = *(const MK_LAS bf16x8*)(AM + (16 * mt + fr) * LDA + 64 * ks + 16 * g);
            const unsigned a0 = vtb + (32 * ks + 8 * g + q4) * LDV + ((V / 2) * vh + 4 * p4) * 2;
            s16x4 ta[NT], tb2[NT];
            if constexpr (NT == 4) {
                asm volatile("ds_read_b64_tr_b16 %0, %8\n\tds_read_b64_tr_b16 %1, %8 offset:32\n\tds_read_b64_tr_b16 %2, %8 offset:64\n\tds_read_b64_tr_b16 %3, %8 offset:96\n\t"
                             "ds_read_b64_tr_b16 %4, %8 offset:1152\n\tds_read_b64_tr_b16 %5, %8 offset:1184\n\tds_read_b64_tr_b16 %6, %8 offset:1216\n\tds_read_b64_tr_b16 %7, %8 offset:1248\n\ts_waitcnt lgkmcnt(0)"
                             : "=&v"(ta[0]), "=&v"(ta[1]), "=&v"(ta[2]), "=&v"(ta[3]), "=&v"(tb2[0]), "=&v"(tb2[1]), "=&v"(tb2[2]), "=&v"(tb2[3]) : "v"(a0) : "memory");
            } else {
                asm volatile("ds_read_b64_tr_b16 %0, %16\n\tds_read_b64_tr_b16 %1, %16 offset:32\n\tds_read_b64_tr_b16 %2, %16 offset:64\n\tds_read_b64_tr_b16 %3, %16 offset:96\n\t"
                             "ds_read_b64_tr_b16 %4, %16 offset:128\n\tds_read_b64_tr_b16 %5, %16 offset:160\n\tds_read_b64_tr_b16 %6, %16 offset:192\n\tds_read_b64_tr_b16 %7, %16 offset:224\n\t"
                             "ds_read_b64_tr_b16 %8, %16 offset:2176\n\tds_read_b64_tr_b16 %9, %16 offset:2208\n\tds_read_b64_tr_b16 %10, %16 offset:2240\n\tds_read_b64_tr_b16 %11, %16 offset:2272\n\t"
                             "ds_read_b64_tr_b16 %12, %16 offset:2304\n\tds_read_b64_tr_b16 %13, %16 offset:2336\n\tds_read_b64_tr_b16 %14, %16 offset:2368\n\tds_read_b64_tr_b16 %15, %16 offset:2400\n\ts_waitcnt lgkmcnt(0)"
                             : "=&v"(ta[0]), "=&v"(ta[1]), "=&v"(ta[2]), "=&v"(ta[3]), "=&v"(ta[4]), "=&v"(ta[5]), "=&v"(ta[6]), "=&v"(ta[7]),
                               "=&v"(tb2[0]), "=&v"(tb2[1]), "=&v"(tb2[2]), "=&v"(tb2[3]), "=&v"(tb2[4]), "=&v"(tb2[5]), "=&v"(tb2[6]), "=&v"(tb2[7]) : "v"(a0) : "memory");
            }
#pragma unroll
            for (int n = 0; n < NT; ++n) { union { bf16x8 v; s16x4 h[2]; } vf; vf.h[0] = ta[n]; vf.h[1] = tb2[n]; o[n] = __builtin_amdgcn_mfma_f32_16x16x32_bf16(aa, vf.v, o[n], 0, 0, 0); } } }
    static_assert((V == 128 && 4 * LDV == 1152) || (V == 256 && 4 * LDV == 2176), "transposed-read offsets");
    {
#pragma unroll
        for (int n = 0; n < NT; ++n) { const int vc = (V / 2) * vh + 16 * n + fr; gn[n] = c.gain[vc];
#pragma unroll
            for (int e = 0; e < 4; ++e) gv[e][n] = Z[(size_t)(16 * mt + 4 * g + e) * N_CDZ + c.gcol + hd * V + vc]; }
#pragma unroll
        for (int ks = 0; ks < 4; ++ks) { const bf16x8 qa = *(const MK_LAS bf16x8*)(QE + (16 * mt + fr) * LDQ + 64 * ks + 16 * g);
            if (ks < 3) {
#pragma unroll
                for (int n = 0; n < NT; ++n) { const bf16x8 nx = *(const bf16x8*)(SCp + (size_t)(16 * n) * 128 + 32 * (ks + 1)); if (ks & 1) sbA[n] = nx; else sbB[n] = nx; } }
#pragma unroll
            for (int n = 0; n < NT; ++n) { const bf16x8 sb = (ks & 1) ? sbB[n] : sbA[n]; o[n] = __builtin_amdgcn_mfma_f32_16x16x32_bf16(qa, sb, o[n], 0, 0, 0); } } }
    float ss[4];
#pragma unroll
    for (int e = 0; e < 4; ++e) { float s = 0.f;
#pragma unroll
        for (int n = 0; n < NT; ++n) s += o[n][e] * o[n][e];
        s += SHX(s, 1); s += SHX(s, 2); s += SHX(s, 4); s += SHX(s, 8); ss[e] = s; }
    if (fr == 0) {
#pragma unroll
        for (int e = 0; e < 4; ++e) SS[vh * 64 + 16 * mt + 4 * g + e] = ss[e]; }
    LDS_WAIT(); __syncthreads();
    bf16_t* MIX = (bf16_t*)(F.ws + WS_MIX) + ((size_t)b * SEQ + tb) * D + c.mixcol + hd * V;
#pragma unroll
    for (int e = 0; e < 4; ++e) { const int t = 16 * mt + 4 * g + e; const float rs = fast_rsq((SS[t] + SS[64 + t]) * (1.0f / V) + EPS);
#pragma unroll
        for (int n = 0; n < NT; ++n) { const int vc = (V / 2) * vh + 16 * n + fr; const float gt = bf2f(gv[e][n]);
            MIX[(size_t)t * D + vc] = (bf16_t)f2bf(o[n][e] * rs * gn[n] * silu_f(gt)); } }
    __syncthreads();
}
__device__ __forceinline__ void x3_unit(Frame& F, int i, int unit) {
    if (unit < NB * HC * NCHUNK) { const GlaCfg c = gla_cfg(F, i, 0); x3_unit_t<DVC>(F, c, unit / (HC * NCHUNK), (unit / NCHUNK) % HC, unit % NCHUNK); }
    else { const int u = unit - NB * HC * NCHUNK; const GlaCfg c = gla_cfg(F, i, 1); x3_unit_t<DVD>(F, c, u / (HD_ * NCHUNK), (u / NCHUNK) % HD_, u % NCHUNK); }
}
__device__ __forceinline__ void mixer_cd_x2(Frame& F0, int i, int qid) {
    for (;;) { const int u = q_next(F0, qid); if (u >= 256 + 96) break; Frame F = F0; F.tid = opaque_tid(F0.wave); F.lane = F.tid & 63; if (u < 256) x2_unit(F, i, u); else scd_unit(F, i, u - 256); }
}
__device__ __forceinline__ void mixer_cd_x3(Frame& F, int i, int qid) {
    constexpr int NU = NB * HC * NCHUNK + NB * HD_ * NCHUNK;
    (void)qid; for (int u = F.vcu; u < NU; u += F.G) x3_unit(F, i, u);
}
}
#ifndef MK_TIME_A
#define MK_TIME_A -1
#endif
#ifndef MK_TIME_B
#define MK_TIME_B -1
#endif
namespace mk {
#if MK_TIME_A >= 0
#define TSTAMP(kind) do { if (opaque_bid() == 0 && F0.wave == 0 && lane_id() == 0) { volatile MK_LAS unsigned* tl = (volatile MK_LAS unsigned*)(F0.lds + MISC_OFF + 128); const unsigned t = (unsigned)wall_clock64(); tl[kind] += t - tl[15]; tl[15] = t; } } while (0)
#else
#define TSTAMP(kind) do { } while (0)
#endif
#define PHASE_FRAME(Fp) Frame Fp = F0; asm volatile("" : "+s"(Fp.wave)); Fp.tid = opaque_tid(Fp.wave); Fp.lane = Fp.tid & 63
__device__ __forceinline__ void ffn_part(Frame& F0, const XcdBarrier& bar, int layer, bool last) {
    { PHASE_FRAME(F); Gemm g{(const bf16_t*)(F.ws + WS_XB16), (const bf16_t*)(F.ws + WS_WUP + layer * SZ_WUP), MP, N_UP, D}; StaticOrder S; S.init(MP, N_UP, F.G, opaque_bid());
      EpiUp E{(bf16_t*)(F.ws + WS_Z), rss_ptr(F, 2 * layer + 1), F.in[I_FCW] + (size_t)layer * 3 * FF, F.in[I_FCB] + (size_t)layer * FF, (float*)(F.ws + WS_GHEAD), (float*)(F.ws + WS_GTAIL), F.out + O_FFP + (size_t)layer * NB * 2 * FF};
      gemm_phase<EpiUp>(F.lds, g, S, E, F.wave);
#if MK_PROBE == 9
      gemm_phase<EpiUp>(F.lds, g, S, E, F.wave);
#elif MK_PROBE == 19
      xcd_barrier(bar, F0.wave); gemm_phase<EpiUp>(F.lds, g, S, E, F.wave);
#endif
    }
    { PHASE_FRAME(F); const bf16_t* Bt = (const bf16_t*)(F.ws + WS_WUP + layer * SZ_WUP);
      sample_plain(F, Bt, rss_sptr(F, 2 * layer + 1), N_UP, 32 * (N_UP / 256), (float*)(F.ws + WS_GUS), N_UP, true); }
    xcd_barrier(bar, F0.wave); TSTAMP(5);
    { PHASE_FRAME(F); ffn_fixup(F, layer); }
    xcd_barrier(bar, F0.wave); TSTAMP(6);
#if MK_PROBE == 10
    { PHASE_FRAME(F); ffn_fixup(F, layer); } xcd_barrier(bar, F0.wave);
#endif
    { PHASE_FRAME(F); Gemm g{(const bf16_t*)(F.ws + WS_Z), (const bf16_t*)(F.ws + WS_WDN + layer * SZ_WDN), MP, D, FF}; StaticOrder S; S.init(MP, D, F.G, opaque_bid());
      EpiRes E{(bf16_t*)(F.ws + WS_XB16), last ? F.out + O_YP : nullptr, rss_ptr(F, 2 * layer + 2)};
      gemm_phase<EpiRes>(F.lds, g, S, E, F.wave);
#if MK_PROBE == 12
      { EpiRes E2{(bf16_t*)(F.ws + WS_LG), nullptr, (float*)(F.ws + WS_LG + 104 * MiB)}; gemm_phase<EpiRes>(F.lds, g, S, E2, F.wave); }
#endif
    }
    { PHASE_FRAME(F); const bf16_t* Bt = (const bf16_t*)(F.ws + WS_WDN + layer * SZ_WDN);
      sample_res(F, (const bf16_t*)(F.ws + WS_Z) + (size_t)MP * FF, Bt, FF, last ? F.out + O_YS : nullptr, rss_sptr(F, 2 * layer + 2)); }
    xcd_barrier(bar, F0.wave); TSTAMP(7);
}
__device__ __forceinline__ void out_part(Frame& F0, const XcdBarrier& bar, int layer, const bf16_t* Wt) {
    PHASE_FRAME(F);
    Gemm g{(const bf16_t*)(F.ws + WS_MIX), Wt, MP, D, D}; StaticOrder S; S.init(MP, D, F.G, opaque_bid());
    EpiRes E{(bf16_t*)(F.ws + WS_XB16), nullptr, rss_ptr(F, 2 * layer + 1)};
    gemm_phase<EpiRes>(F.lds, g, S, E, F.wave);
#if MK_PROBE == 11
    { EpiRes E2{(bf16_t*)(F.ws + WS_LG), nullptr, (float*)(F.ws + WS_LG + 104 * MiB)}; gemm_phase<EpiRes>(F.lds, g, S, E2, F.wave); }
#endif
    { PHASE_FRAME(F2); sample_res(F2, (const bf16_t*)(F2.ws + WS_MIX) + (size_t)MP * D, Wt, D, nullptr, rss_sptr(F2, 2 * layer + 1)); }
    xcd_barrier(bar, F0.wave); TSTAMP(4);
}

__global__ void __launch_bounds__(512, 2) mega_fwd(Args args) {
    extern __shared__ __attribute__((aligned(16))) unsigned char lds_raw[];
    Frame F0; Frame& F = F0; F.lds = (MK_LAS unsigned char*)lds_raw; F.ws = args.ws; F.out = args.out; F.in = args.in; F.ctl = (unsigned*)(args.ws + WS_CTL);
    F.wave = __builtin_amdgcn_readfirstlane((int)threadIdx.x >> 6); asm volatile("" : "+s"(F.wave));
    F.tid = opaque_tid(F.wave); F.lane = F.tid & 63;
    F.G = gridDim.x; { const int bx = opaque_bid(); F.vcu = (F.G % 8 == 0) ? (bx % 8) * (F.G / 8) + bx / 8 : bx; }
    for (int u = F.tid; u < (LDS_BYTES - MISC_OFF) / 4; u += 512) ((MK_LAS unsigned*)(F.lds + MISC_OFF))[u] = 0u;
    __syncthreads();
    const XcdBarrier bar = xcd_barrier_post(F.ctl + CW_BAR, (volatile MK_LAS unsigned*)(F.lds + MISC_OFF), F0.wave);
    TSTAMP(14);
    p0_prologue(F);
    xcd_barrier(bar, F0.wave); TSTAMP(0);
#if MK_PROBE == 7
    p0_prologue(F); xcd_barrier(bar, F0.wave);
#elif MK_PROBE == 6
    for (int r = 0; r < 32; ++r) xcd_barrier(bar, F0.wave);
#endif
    const int nl = args.nlayers;
    for (int lp = 0; lp < 2; ++lp) {
        { const int layer = 2 * lp, i = lp; if (layer >= nl) break;
          { PHASE_FRAME(F); Gemm g{(const bf16_t*)(F.ws + WS_XB16), (const bf16_t*)(F.ws + WS_WINAB + i * SZ_WINAB), MP, N_AB, D}; StaticOrder S; S.init(MP, N_AB, F.G, opaque_bid());
            EpiInAB E{(bf16_t*)(F.ws + WS_Z), rss_ptr(F, 2 * layer), F.in[I_QN] + i * DH, F.in[I_KN] + i * DH, F.out + O_KVP + (size_t)i * NB * LA * 2 * WA, F.out + O_CONVP + (size_t)i * NB * 3 * WB};
            gemm_phase<EpiInAB>(F.lds, g, S, E, F.wave);
#if MK_PROBE == 8
            gemm_phase<EpiInAB>(F.lds, g, S, E, F.wave);
#elif MK_PROBE == 18
            xcd_barrier(bar, F0.wave); gemm_phase<EpiInAB>(F.lds, g, S, E, F.wave);
#endif
          }
          { PHASE_FRAME(F); sample_in_ab(F, i, (const bf16_t*)(F.ws + WS_WINAB + i * SZ_WINAB), rss_sptr(F, 2 * layer)); }
          xcd_barrier(bar, F0.wave); TSTAMP(1);
          { PHASE_FRAME(F); mixer_ab<0>(F, i, 2 * layer); }
          xcd_barrier(bar, F0.wave); TSTAMP(2);
#if MK_PROBE == 21
          { PHASE_FRAME(F); mixer_ab<0>(F, i, 16 + 2 * layer); } xcd_barrier(bar, F0.wave);
#elif MK_PROBE == 22
          { PHASE_FRAME(F); mixer_ab<1>(F, i, 16 + 2 * layer); } xcd_barrier(bar, F0.wave);
#elif MK_PROBE == 23
          { PHASE_FRAME(F); mixer_ab<2>(F, i, 16 + 2 * layer); } xcd_barrier(bar, F0.wave);
#endif
          { PHASE_FRAME(F); mixer_ab_fix(F, i, 2 * layer + 1); }
          xcd_barrier(bar, F0.wave); TSTAMP(3);
#if MK_PROBE == 1
          { PHASE_FRAME(F); mixer_ab<0>(F, i, 16 + 2 * layer); } xcd_barrier(bar, F0.wave);
#elif MK_PROBE == 2
          { PHASE_FRAME(F); mixer_ab<1>(F, i, 16 + 2 * layer); } xcd_barrier(bar, F0.wave);
#elif MK_PROBE == 3
          { PHASE_FRAME(F); mixer_ab<2>(F, i, 16 + 2 * layer); } xcd_barrier(bar, F0.wave);
#endif
          if (args.pad && layer == nl - 1) return;
          out_part(F0, bar, layer, (const bf16_t*)(F.ws + WS_WOUTAB + i * SZ_WOUT));
          ffn_part(F0, bar, layer, layer == nl - 1); }
        { const int layer = 2 * lp + 1, i = lp; if (layer >= nl) break;
          { PHASE_FRAME(F); Gemm g{(const bf16_t*)(F.ws + WS_XB16), (const bf16_t*)(F.ws + WS_WINCD + i * SZ_WINCD), MP, N_CD, D}; StaticOrder S; S.init(MP, N_CD, F.G, opaque_bid());
            EpiInCD E{(bf16_t*)(F.ws + WS_Z), rss_ptr(F, 2 * layer), (const float*)(F.ws + WS_LB) + i * 1024, F.in[I_BG] + i * 512, (float*)(F.ws + WS_LG), (float*)(F.ws + WS_LG) + (size_t)MP * 1024};
            gemm_phase<EpiInCD>(F.lds, g, S, E, F.wave);
#if MK_PROBE == 8
            gemm_phase<EpiInCD>(F.lds, g, S, E, F.wave);
#elif MK_PROBE == 18
            xcd_barrier(bar, F0.wave); gemm_phase<EpiInCD>(F.lds, g, S, E, F.wave);
#endif
          }
          { PHASE_FRAME(F); sample_plain(F, (const bf16_t*)(F.ws + WS_WINCD + i * SZ_WINCD), rss_sptr(F, 2 * layer), N_CD, 32 * (N_CD / 256), (float*)(F.ws + WS_ZS), N_CD, false); }
          xcd_barrier(bar, F0.wave); TSTAMP(8);
          { PHASE_FRAME(F); mixer_cd_x2(F, i, 2 * layer); }
          xcd_barrier(bar, F0.wave); TSTAMP(9);
#if MK_PROBE == 4
          { PHASE_FRAME(F); mixer_cd_x2(F, i, 16 + 2 * layer); } xcd_barrier(bar, F0.wave);
#endif
          { PHASE_FRAME(F); mixer_cd_x3(F, i, 2 * layer + 1); }
          xcd_barrier(bar, F0.wave); TSTAMP(10);
#if MK_PROBE == 5
          { PHASE_FRAME(F); mixer_cd_x3(F, i, 16 + 2 * layer + 1); } xcd_barrier(bar, F0.wave);
#endif
          if (args.pad && layer == nl - 1) return;
          out_part(F0, bar, layer, (const bf16_t*)(F.ws + WS_WOUTCD + i * SZ_WOUT));
          ffn_part(F0, bar, layer, layer == nl - 1); }
    }
#if MK_TIME_A >= 0
    if (opaque_bid() == 0 && F0.wave == 0 && lane_id() == 0) { volatile MK_LAS unsigned* tl = (volatile MK_LAS unsigned*)(F0.lds + MISC_OFF + 128);
        constexpr unsigned UNIT[14] = {5, 5, 5, 1, 5, 20, 1, 10, 5, 5, 5, 50, 40, 20};
        { unsigned tot = 0; for (int k = 0; k < 11; ++k) tot += tl[k]; tl[11] = tot; tl[12] = tl[5]; tl[13] = tl[1]; }
        unsigned va = tl[MK_TIME_A] / (100u * UNIT[MK_TIME_A]); if (va > 99u) va = 99u; unsigned vb = 0u;
        if (MK_TIME_B >= 0) { vb = tl[MK_TIME_B >= 0 ? MK_TIME_B : 0] / (100u * UNIT[MK_TIME_B >= 0 ? MK_TIME_B : 0]); if (vb > 99u) vb = 99u; }
        const unsigned long long t0 = wall_clock64(), dt = 100ull * 100ull * (va + 100ull * vb);
        while (wall_clock64() - t0 < dt) __builtin_amdgcn_s_sleep(32); }
#endif
}

static int g_grid = 0;
inline void launch_mega(void* const* d_in, float* out, unsigned char* ws, int nlayers, hipStream_t stream, int stop_after_mixer = 0) {
    if (g_grid == 0) {
        int dev = 0, cus = 0;
        if (hipGetDevice(&dev) != hipSuccess || hipDeviceGetAttribute(&cus, hipDeviceAttributeMultiprocessorCount, dev) != hipSuccess) { g_grid = -1; return; }
        if (hipFuncSetAttribute((const void*)mega_fwd, hipFuncAttributeMaxDynamicSharedMemorySize, LDS_BYTES) != hipSuccess) { g_grid = -1; return; }
        int per_cu = 0; (void)hipOccupancyMaxActiveBlocksPerMultiprocessor(&per_cu, (const void*)mega_fwd, 512, LDS_BYTES); (void)hipGetLastError();
        g_grid = (per_cu >= 1) ? cus : -1;
    }
    if (g_grid < 0) return;
    (void)hipMemsetAsync(ws + WS_CTL, 0, CTL_BYTES, stream);
    Args a{}; for (int k = 0; k < 32; ++k) a.in[k] = (const float*)d_in[k];
    a.out = out; a.ws = ws; a.nlayers = nlayers; a.pad = stop_after_mixer;
    hipLaunchKernelGGL(mega_fwd, dim3(g_grid), dim3(512), LDS_BYTES, stream, a);
}
}
extern "C" void kernel_launch(void* const* d_in, const int* in_sizes, int n_in, void* d_out, int out_size, void* d_ws, size_t ws_size, hipStream_t stream) {
    if (n_in != 32 || ws_size < mk::WS_END || (size_t)out_size != mk::O_END) return;
    mk::launch_mega(d_in, (float*)d_out, (unsigned char*)d_ws, 4, stream);
}
```
